# Optimizing an MI355X kernel written in HIP

```python
import jax
import jax.numpy as jnp
from jax import lax
import numpy as np

D_MODEL = 1024
BATCH = 8
SEQ = 4096
DEPTH = 4

GRID_W = 64
CTX_LEN = 256
Q_BLOCK = 128
ROPE_THETA = 10000.0
NORM_EPS = 1e-6
N_MOD = 6

MLA_HEADS = 4
MLA_Q_RANK = 384
MLA_KV_RANK = 256
MLA_NOPE = 128
MLA_ROPE = 64
MLA_V = 128
MLA_SCALE = (MLA_NOPE + MLA_ROPE) ** -0.5
GQA_HEADS = 4
GQA_KV_HEADS = 2
GQA_GROUP = GQA_HEADS // GQA_KV_HEADS
GQA_HEAD_DIM = 128
GQA_SCALE = GQA_HEAD_DIM ** -0.5
_S1 = MLA_Q_RANK
_S2 = _S1 + MLA_KV_RANK
_S3 = _S2 + MLA_ROPE
_S4 = _S3 + GQA_HEADS * GQA_HEAD_DIM
_S5 = _S4 + GQA_KV_HEADS * GQA_HEAD_DIM
ATTN_SPLITS = (_S1, _S2, _S3, _S4, _S5)
ATTN_IN = _S5 + GQA_KV_HEADS * GQA_HEAD_DIM
ATTN_OUT = MLA_HEADS * MLA_V + GQA_HEADS * GQA_HEAD_DIM

RWKV_HEAD = 64
RWKV_HEADS = D_MODEL // RWKV_HEAD
DECAY_LORA = 64
ICLR_LORA = 64
VRES_LORA = 32
GATE_LORA = 128
RWKV_GN_EPS = 64e-5
N_MIX = 6

N_EXPERTS = 32
TOP_K = 4
EXPERT_FF = D_MODEL
SWIGLU_ALPHA = 1.702
SWIGLU_LIMIT = 7.0

N_EVEN = (DEPTH + 1) // 2
N_ODD = DEPTH // 2
N_VRES = max(N_ODD - 1, 0)

kernel_name = 'hybrid_mla_gqa_rwkv7_moe_dit_trunk'


def rmsnorm(x, g):
    xf = x.astype(jnp.float32)
    y = xf * lax.rsqrt(jnp.mean(xf * xf, axis=-1, keepdims=True) + NORM_EPS)
    return (y * g.astype(jnp.float32)).astype(x.dtype)


def modulate(h, shift, scale):
    return h * (1 + scale) + shift


def axial_angles(n_tokens, rot_dim):
    rows = n_tokens // GRID_W
    row = jnp.repeat(jnp.arange(rows, dtype=jnp.float32), GRID_W)
    col = jnp.tile(jnp.arange(GRID_W, dtype=jnp.float32), rows)
    half = rot_dim // 2
    inv_freq = ROPE_THETA ** (-jnp.arange(0, half, 2, dtype=jnp.float32) / half)
    return row[:, None] * inv_freq[None, :], col[:, None] * inv_freq[None, :]


def _rotate(x, ang):
    cos = jnp.cos(ang)[None, :, None, :].astype(x.dtype)
    sin = jnp.sin(ang)[None, :, None, :].astype(x.dtype)
    x1, x2 = jnp.split(x, 2, axis=-1)
    return jnp.concatenate([x1 * cos - x2 * sin, x2 * cos + x1 * sin], axis=-1)


def axial_rope(x, angles):
    if angles is None:
        return x
    x_row, x_col = jnp.split(x, 2, axis=-1)
    return jnp.concatenate([_rotate(x_row, angles[0]), _rotate(x_col, angles[1])], axis=-1)


def softmax_attend(q, k, v, scale):
    s = jnp.einsum('bqhgd,bkhd->bhgqk', q, k).astype(jnp.float32) * scale
    p = jax.nn.softmax(s, axis=-1).astype(v.dtype)
    return jnp.einsum('bhgqk,bkhd->bqhgd', p, v)


def latent_attention(q, k, v, k_ctx, v_ctx, scale):
    B, T = q.shape[:2]
    k_all = jnp.concatenate([k_ctx, k], axis=1)
    v_all = jnp.concatenate([v_ctx, v], axis=1)
    qb = jnp.swapaxes(q.reshape(B, T // Q_BLOCK, Q_BLOCK, *q.shape[2:]), 0, 1)
    ob = lax.map(lambda q_blk: softmax_attend(q_blk, k_all, v_all, scale), qb)
    return jnp.swapaxes(ob, 0, 1).reshape(B, T, *ob.shape[3:])


def attn_mixer(h_lat, h_ctx, p, ang_mla, ang_gqa, with_ctx):
    def project(h, a_mla, a_gqa):
        B, T, _ = h.shape
        zq, zkv, zr, gq, gk, gv = jnp.split(h @ p['w_in'], ATTN_SPLITS, axis=-1)
        q = (rmsnorm(zq, p['q_norm']) @ p['w_uq']).reshape(B, T, MLA_HEADS, MLA_NOPE + MLA_ROPE)
        kv = (rmsnorm(zkv, p['kv_norm']) @ p['w_ukv']).reshape(B, T, MLA_HEADS, MLA_NOPE + MLA_V)
        q_nope, q_rope = jnp.split(q, [MLA_NOPE], axis=-1)
        k_nope, v_mla = jnp.split(kv, [MLA_NOPE], axis=-1)
        q_mla = jnp.concatenate([rmsnorm(q_nope, p['qn_g']), axial_rope(rmsnorm(q_rope, p['qr_g']), a_mla)], axis=-1)
        k_rope = axial_rope(rmsnorm(zr, p['kr_g'])[:, :, None, :], a_mla)
        k_mla = jnp.concatenate([rmsnorm(k_nope, p['kn_g']), jnp.broadcast_to(k_rope, (B, T, MLA_HEADS, MLA_ROPE))], axis=-1)
        q_gqa = axial_rope(rmsnorm(gq.reshape(B, T, GQA_HEADS, GQA_HEAD_DIM), p['gq_g']), a_gqa)
        k_gqa = axial_rope(rmsnorm(gk.reshape(B, T, GQA_KV_HEADS, GQA_HEAD_DIM), p['gk_g']), a_gqa)
        v_gqa = gv.reshape(B, T, GQA_KV_HEADS, GQA_HEAD_DIM)
        return ((q_mla[:, :, :, None, :], k_mla, v_mla),
                (q_gqa.reshape(B, T, GQA_KV_HEADS, GQA_GROUP, GQA_HEAD_DIM), k_gqa, v_gqa))

    def merge(o_mla, o_gqa):
        B, T = o_mla.shape[:2]
        return jnp.concatenate([o_mla.reshape(B, T, -1), o_gqa.reshape(B, T, -1)], axis=-1) @ p['w_out']

    (mq, mk, mv), (gq, gk, gv) = project(h_lat, ang_mla, ang_gqa)
    (cmq, cmk, cmv), (cgq, cgk, cgv) = project(h_ctx, None, None)
    o_lat = merge(latent_attention(mq, mk, mv, cmk, cmv, MLA_SCALE),
                  latent_attention(gq, gk, gv, cgk, cgv, GQA_SCALE))
    o_ctx = None
    if with_ctx:
        o_ctx = merge(softmax_attend(cmq, cmk, cmv, MLA_SCALE), softmax_attend(cgq, cgk, cgv, GQA_SCALE))
    return o_lat, o_ctx


def centred_shift(h):
    prev = jnp.pad(h[:, :-1], ((0, 0), (1, 0), (0, 0)))
    nxt = jnp.pad(h[:, 1:], ((0, 0), (0, 1), (0, 0)))
    return 0.5 * (prev + nxt)


def rwkv_features(h, p, v_first):
    B, T, _ = h.shape
    heads = lambda t: t.reshape(B, T, RWKV_HEADS, RWKV_HEAD)
    xx = centred_shift(h) - h
    xr, xw, xk, xv, xa, xg = (h + xx * p['mix'][m] for m in range(N_MIX))
    k = xk @ p['w_k']
    v = xv @ p['w_v']
    v_raw = v
    if v_first is not None:
        v = v + (v_first - v) * jax.nn.sigmoid(p['v0'] + (xv @ p['v1']) @ p['v2'])
    kk = heads(k * p['k_k']).astype(jnp.float32)
    kk = kk * lax.rsqrt(jnp.maximum(jnp.sum(kk * kk, axis=-1, keepdims=True), 1e-24))
    decay, k_dir, b_dir = [], [], []
    for d in range(2):
        z = (p['w0'][d] + jnp.tanh(xw @ p['w1'][d]) @ p['w2'][d]).astype(jnp.float32)
        decay.append(heads(jnp.exp(-jnp.exp(-jax.nn.softplus(-z) - 0.5))))
        a = jax.nn.sigmoid(p['a0'][d] + (xa @ p['a1'][d]) @ p['a2'][d])
        k_dir.append(heads(k * (1 + (a - 1) * p['k_a'])))
        b_dir.append(kk * heads(a).astype(jnp.float32))
    return dict(r=heads(xr @ p['w_r']), v=heads(v), kk=kk, xg=xg, decay=decay, k=k_dir, b=b_dir, v_raw=v_raw)


def wkv7_scan(state0, f, d, reverse):
    xs = tuple(jnp.swapaxes(t.astype(jnp.float32), 0, 1)
               for t in (f['r'], f['decay'][d], f['k'][d], f['v'], f['kk'], f['b'][d]))

    def step(S, inp):
        r, w, k, v, kk, b = inp
        sa = jnp.einsum('bhvk,bhk->bhv', S, -kk)
        S = S * w[:, :, None, :] + sa[..., None] * b[:, :, None, :] + v[..., None] * k[:, :, None, :]
        return S, jnp.einsum('bhvk,bhk->bhv', S, r)

    state, y = lax.scan(step, state0, xs, reverse=reverse)
    return state, jnp.swapaxes(y, 0, 1)


def rwkv_output(y, f, p):
    B, T, H, N = y.shape
    mu = jnp.mean(y, axis=-1, keepdims=True)
    var = jnp.mean(jnp.square(y - mu), axis=-1, keepdims=True)
    yn = (y - mu) * lax.rsqrt(var + RWKV_GN_EPS)
    yn = (yn * p['ln_w'].reshape(H, N) + p['ln_b'].reshape(H, N)).astype(f['v'].dtype)
    bonus = jnp.sum(f['r'] * (f['k'][0] + f['k'][1]) * p['r_k'], axis=-1, keepdims=True) * f['v']
    g = jax.nn.sigmoid(f['xg'] @ p['g1']) @ p['g2']
    return ((yn + bonus).reshape(B, T, H * N) * g) @ p['w_o']


def rwkv_mixer(h_lat, h_ctx, p, vf_lat, vf_ctx, with_ctx):
    f_lat = rwkv_features(h_lat, p, vf_lat)
    f_ctx = rwkv_features(h_ctx, p, vf_ctx)
    state0 = jnp.zeros((h_lat.shape[0], RWKV_HEADS, RWKV_HEAD, RWKV_HEAD), jnp.float32)
    y_lat, y_ctx = 0.0, 0.0
    for d, rev in enumerate((False, True)):
        s_ctx, yc = wkv7_scan(state0, f_ctx, d, rev)
        _, yl = wkv7_scan(s_ctx, f_lat, d, rev)
        y_lat = y_lat + yl
        y_ctx = y_ctx + yc
    o_lat = rwkv_output(y_lat, f_lat, p)
    o_ctx = rwkv_output(y_ctx, f_ctx, p) if with_ctx else None
    return o_lat, o_ctx, f_lat['v_raw'], f_ctx['v_raw']


def clamped_swiglu(u):
    u_glu, u_lin = u[..., ::2], u[..., 1::2]
    u_glu = jnp.minimum(u_glu, SWIGLU_LIMIT)
    u_lin = jnp.clip(u_lin, -SWIGLU_LIMIT, SWIGLU_LIMIT)
    return u_glu * jax.nn.sigmoid(SWIGLU_ALPHA * u_glu) * (u_lin + 1)


def moe(h, router_w, router_b, w1, b1, w2, b2):
    logits = (h @ router_w + router_b).astype(jnp.float32)
    top_val, top_idx = lax.top_k(logits, TOP_K)
    top_p = jax.nn.softmax(top_val, axis=-1)
    gates = jnp.einsum('nk,nke->ne', top_p, jax.nn.one_hot(top_idx, N_EXPERTS, dtype=jnp.float32)).astype(h.dtype)
    out = jnp.zeros_like(h)
    for e in range(N_EXPERTS):
        y = clamped_swiglu(h @ w1[e] + b1[e]) @ w2[e] + b2[e]
        out = out + gates[:, e:e + 1] * y
    return out


def setup_inputs(seed: int = 0) -> dict:
    key = jax.random.key(seed)
    ks = iter(jax.random.split(key, 64))

    def nrm(shape, scale):
        return jax.random.normal(next(ks), shape, jnp.float32) * scale

    def gain(shape):
        return 1.0 + nrm(shape, 0.02)

    def unif(shape, lo, hi):
        return jax.random.uniform(next(ks), shape, jnp.float32, lo, hi)

    D, E, F = D_MODEL, N_EXPERTS, EXPERT_FF
    H, N = RWKV_HEADS, RWKV_HEAD
    return {
        'x': nrm((BATCH, SEQ, D), 1.0),
        'c': nrm((BATCH, D), 1.0),
        'ctx': nrm((BATCH, CTX_LEN, D), 1.0),
        'c_ctx': nrm((D,), 1.0),
        'ada_w': nrm((DEPTH, D, N_MOD * D), 0.5 * D ** -0.5),
        'ada_b': nrm((DEPTH, N_MOD * D), 0.02),
        'norm_mix': gain((DEPTH, D)),
        'norm_ffn': gain((DEPTH, D)),
        'attn_w_in': nrm((N_EVEN, D, ATTN_IN), D ** -0.5),
        'mla_q_norm': gain((N_EVEN, MLA_Q_RANK)),
        'mla_w_uq': nrm((N_EVEN, MLA_Q_RANK, MLA_HEADS * (MLA_NOPE + MLA_ROPE)), MLA_Q_RANK ** -0.5),
        'mla_kv_norm': gain((N_EVEN, MLA_KV_RANK)),
        'mla_w_ukv': nrm((N_EVEN, MLA_KV_RANK, MLA_HEADS * (MLA_NOPE + MLA_V)), MLA_KV_RANK ** -0.5),
        'mla_qn_g': gain((N_EVEN, MLA_NOPE)),
        'mla_qr_g': gain((N_EVEN, MLA_ROPE)),
        'mla_kn_g': gain((N_EVEN, MLA_NOPE)),
        'mla_kr_g': gain((N_EVEN, MLA_ROPE)),
        'gqa_q_g': gain((N_EVEN, GQA_HEAD_DIM)),
        'gqa_k_g': gain((N_EVEN, GQA_HEAD_DIM)),
        'attn_w_out': nrm((N_EVEN, ATTN_OUT, D), ATTN_OUT ** -0.5),
        'rwkv_mix': unif((N_ODD, N_MIX, D), 0.0, 1.0),
        'rwkv_w_r': nrm((N_ODD, D, D), D ** -0.5),
        'rwkv_w_k': nrm((N_ODD, D, D), D ** -0.5),
        'rwkv_w_v': nrm((N_ODD, D, D), D ** -0.5),
        'rwkv_w_o': nrm((N_ODD, D, D), D ** -0.5),
        'rwkv_w0': unif((N_ODD, 2, D), -5.0, -1.0),
        'rwkv_w1': nrm((N_ODD, 2, D, DECAY_LORA), D ** -0.5),
        'rwkv_w2': nrm((N_ODD, 2, DECAY_LORA, D), 0.5 * DECAY_LORA ** -0.5),
        'rwkv_a0': nrm((N_ODD, 2, D), 0.1),
        'rwkv_a1': nrm((N_ODD, 2, D, ICLR_LORA), D ** -0.5),
        'rwkv_a2': nrm((N_ODD, 2, ICLR_LORA, D), 0.5 * ICLR_LORA ** -0.5),
        'rwkv_v0': nrm((N_VRES, D), 0.1),
        'rwkv_v1': nrm((N_VRES, D, VRES_LORA), D ** -0.5),
        'rwkv_v2': nrm((N_VRES, VRES_LORA, D), 0.5 * VRES_LORA ** -0.5),
        'rwkv_g1': nrm((N_ODD, D, GATE_LORA), D ** -0.5),
        'rwkv_g2': nrm((N_ODD, GATE_LORA, D), GATE_LORA ** -0.5),
        'rwkv_k_k': 0.85 + nrm((N_ODD, D), 0.02),
        'rwkv_k_a': gain((N_ODD, D)),
        'rwkv_r_k': nrm((N_ODD, H, N), 0.1),
        'rwkv_ln_w': gain((N_ODD, D)),
        'rwkv_ln_b': nrm((N_ODD, D), 0.02),
        'moe_router_w': nrm((DEPTH, D, E), D ** -0.5),
        'moe_router_b': nrm((DEPTH, E), 0.01),
        'moe_w1': nrm((DEPTH, E, D, 2 * F), D ** -0.5),
        'moe_b1': nrm((DEPTH, E, 2 * F), 0.02),
        'moe_w2': nrm((DEPTH, E, F, D), F ** -0.5),
        'moe_b2': nrm((DEPTH, E, D), 0.02),
    }


def reference(x, c, ctx, c_ctx, ada_w, ada_b, norm_mix, norm_ffn,
              attn_w_in, mla_q_norm, mla_w_uq, mla_kv_norm, mla_w_ukv, mla_qn_g, mla_qr_g, mla_kn_g, mla_kr_g,
              gqa_q_g, gqa_k_g, attn_w_out,
              rwkv_mix, rwkv_w_r, rwkv_w_k, rwkv_w_v, rwkv_w_o, rwkv_w0, rwkv_w1, rwkv_w2,
              rwkv_a0, rwkv_a1, rwkv_a2, rwkv_v0, rwkv_v1, rwkv_v2, rwkv_g1, rwkv_g2,
              rwkv_k_k, rwkv_k_a, rwkv_r_k, rwkv_ln_w, rwkv_ln_b,
              moe_router_w, moe_router_b, moe_w1, moe_b1, moe_w2, moe_b2):
    n_lat = x.shape[1]
    ang_mla = axial_angles(n_lat, MLA_ROPE)
    ang_gqa = axial_angles(n_lat, GQA_HEAD_DIM)
    cond_lat = jax.nn.silu(c)[:, None, :]
    cond_ctx = jax.nn.silu(c_ctx)[None, None, :]
    vf_lat, vf_ctx = None, None
    for i in range(DEPTH):
        with_ctx = i < DEPTH - 1
        m_lat = jnp.split(cond_lat @ ada_w[i] + ada_b[i], N_MOD, axis=-1)
        m_ctx = jnp.split(cond_ctx @ ada_w[i] + ada_b[i], N_MOD, axis=-1)
        h_lat = modulate(rmsnorm(x, norm_mix[i]), m_lat[0], m_lat[1])
        h_ctx = modulate(rmsnorm(ctx, norm_mix[i]), m_ctx[0], m_ctx[1])
        if i % 2 == 0:
            e = i // 2
            p = dict(w_in=attn_w_in[e], q_norm=mla_q_norm[e], w_uq=mla_w_uq[e], kv_norm=mla_kv_norm[e],
                     w_ukv=mla_w_ukv[e], qn_g=mla_qn_g[e], qr_g=mla_qr_g[e], kn_g=mla_kn_g[e], kr_g=mla_kr_g[e],
                     gq_g=gqa_q_g[e], gk_g=gqa_k_g[e], w_out=attn_w_out[e])
            o_lat, o_ctx = attn_mixer(h_lat, h_ctx, p, ang_mla, ang_gqa, with_ctx)
        else:
            j = i // 2
            p = dict(mix=rwkv_mix[j], w_r=rwkv_w_r[j], w_k=rwkv_w_k[j], w_v=rwkv_w_v[j], w_o=rwkv_w_o[j],
                     w0=rwkv_w0[j], w1=rwkv_w1[j], w2=rwkv_w2[j], a0=rwkv_a0[j], a1=rwkv_a1[j], a2=rwkv_a2[j],
                     g1=rwkv_g1[j], g2=rwkv_g2[j], k_k=rwkv_k_k[j], k_a=rwkv_k_a[j], r_k=rwkv_r_k[j],
                     ln_w=rwkv_ln_w[j], ln_b=rwkv_ln_b[j])
            if j > 0:
                p.update(v0=rwkv_v0[j - 1], v1=rwkv_v1[j - 1], v2=rwkv_v2[j - 1])
            o_lat, o_ctx, v_lat, v_ctx = rwkv_mixer(h_lat, h_ctx, p, vf_lat, vf_ctx, with_ctx)
            if j == 0:
                vf_lat, vf_ctx = v_lat, v_ctx
        x = x + m_lat[2] * o_lat
        ffn_lat = modulate(rmsnorm(x, norm_ffn[i]), m_lat[3], m_lat[4])
        moe_args = (moe_router_w[i], moe_router_b[i], moe_w1[i], moe_b1[i], moe_w2[i], moe_b2[i])
        if with_ctx:
            ctx = ctx + m_ctx[2] * o_ctx
            ffn_ctx = modulate(rmsnorm(ctx, norm_ffn[i]), m_ctx[3], m_ctx[4])
            n_tok = ffn_lat.shape[0] * ffn_lat.shape[1]
            tokens = jnp.concatenate([ffn_lat.reshape(-1, D_MODEL), ffn_ctx.reshape(-1, D_MODEL)], axis=0)
            out = moe(tokens, *moe_args)
            x = x + m_lat[5] * out[:n_tok].reshape(x.shape)
            ctx = ctx + m_ctx[5] * out[n_tok:].reshape(ctx.shape)
        else:
            x = x + m_lat[5] * moe(ffn_lat.reshape(-1, D_MODEL), *moe_args).reshape(x.shape)
    return x
```

```cpp
#include <hip/hip_runtime.h>
#include <cstdio>
#include <cstdint>

#ifndef MK_PER_PHASE
#define MK_PER_PHASE 0
#endif
#ifndef MK_LAST_PHASE
#define MK_LAST_PHASE 9999
#endif

#define GAS __attribute__((address_space(1)))
#define LAS __attribute__((address_space(3)))
typedef unsigned short bf16_t;
typedef unsigned v4u __attribute__((ext_vector_type(4)));
typedef unsigned v2u __attribute__((ext_vector_type(2)));
typedef float f32x4 __attribute__((ext_vector_type(4)));
typedef float f32x2 __attribute__((ext_vector_type(2)));
typedef float f32x16 __attribute__((ext_vector_type(16)));
typedef short bf16x8 __attribute__((ext_vector_type(8)));
typedef short s16x4 __attribute__((ext_vector_type(4)));
typedef GAS unsigned gu32;
#define RLX_AGENT __ATOMIC_RELAXED, __HIP_MEMORY_SCOPE_AGENT
#define LDS_WAIT() asm volatile("s_waitcnt lgkmcnt(0)" ::: "memory")
#define VM_WAIT() asm volatile("s_waitcnt vmcnt(0)" ::: "memory")

constexpr int D = 1024, NB = 8, SEQ = 4096, CTXL = 256, DEPTH = 4;
constexpr int TPB = SEQ + CTXL;
constexpr int M = NB * TPB;
constexpr int NPANEL = M / 256;
constexpr int NMOD = 6;
constexpr int PROJ_LD = 1792;
constexpr int C_ZQ = 0, C_ZKV = 384, C_ZR = 640, C_GQ = 704, C_GK = 1216, C_GV = 1472;
constexpr int NE = 32, TOPK = 4, FF = 1024;
constexpr int CAP = M;
constexpr float NORM_EPS = 1e-6f, GN_EPS = 64e-5f;
constexpr float MLA_SCALE = 0.07216878364870322f;
constexpr float GQA_SCALE = 0.08838834764831845f;
constexpr int NWAVES = 8, NTHREADS = 512;

enum { I_X = 0, I_C, I_CTX, I_CCTX, I_ADA_W, I_ADA_B, I_NORM_MIX, I_NORM_FFN, I_ATTN_W_IN, I_MLA_Q_NORM, I_MLA_W_UQ, I_MLA_KV_NORM, I_MLA_W_UKV,
       I_MLA_QN_G, I_MLA_QR_G, I_MLA_KN_G, I_MLA_KR_G, I_GQA_Q_G, I_GQA_K_G, I_ATTN_W_OUT, I_RWKV_MIX, I_RWKV_W_R, I_RWKV_W_K, I_RWKV_W_V, I_RWKV_W_O,
       I_RWKV_W0, I_RWKV_W1, I_RWKV_W2, I_RWKV_A0, I_RWKV_A1, I_RWKV_A2, I_RWKV_V0, I_RWKV_V1, I_RWKV_V2, I_RWKV_G1, I_RWKV_G2, I_RWKV_K_K, I_RWKV_K_A,
       I_RWKV_R_K, I_RWKV_LN_W, I_RWKV_LN_B, I_MOE_ROUTER_W, I_MOE_ROUTER_B, I_MOE_W1, I_MOE_B1, I_MOE_W2, I_MOE_B2, N_IN };

constexpr size_t MiB = 1u << 20;
constexpr size_t WS_CTL = 0, CTL_BYTES = 1 * MiB;
constexpr size_t WS_MOD = WS_CTL + CTL_BYTES;
constexpr size_t WS_SMALLW = WS_MOD + 1 * MiB;
constexpr size_t EV_WIN = 0, EV_WUQ = EV_WIN + (size_t)1792 * 1024 * 2, EV_WUKV = EV_WUQ + (size_t)768 * 384 * 2, EV_WOUT = EV_WUKV + (size_t)1024 * 256 * 2,
                 EV_BYTES = EV_WOUT + (size_t)1024 * 1024 * 2;
constexpr size_t OD_WR = 0, OD_WK = OD_WR + 2 * MiB, OD_WV = OD_WK + 2 * MiB, OD_WO = OD_WV + 2 * MiB, OD_W1C = OD_WO + 2 * MiB, OD_A1C = OD_W1C + 512 * 1024,
                 OD_G1 = OD_A1C + 512 * 1024, OD_V1 = OD_G1 + 512 * 1024, OD_W2C = OD_V1 + 512 * 1024, OD_A2C = OD_W2C + 512 * 1024, OD_G2 = OD_A2C + 512 * 1024,
                 OD_V2 = OD_G2 + 256 * 1024, OD_BYTES = OD_V2 + 256 * 1024;
constexpr size_t RT_BYTES = (size_t)256 * 1024 * 2;
constexpr size_t SW_EV = 0, SW_OD = SW_EV + 2 * EV_BYTES, SW_RT = SW_OD + 2 * OD_BYTES, SMALLW_BYTES = ((SW_RT + 4 * RT_BYTES + MiB - 1) / MiB) * MiB;
constexpr size_t WS_W1T = WS_SMALLW + SMALLW_BYTES;
constexpr size_t WS_W2T = WS_W1T + (size_t)128 * 2048 * 1024 * 2;
constexpr size_t WS_XR = WS_W2T + (size_t)128 * 1024 * 1024 * 2;
constexpr size_t ROWB2 = (size_t)M * 1024 * 2;
constexpr size_t WS_HB = WS_XR + 2 * ROWB2;
constexpr size_t WS_OB = WS_HB + ROWB2;
constexpr size_t WS_LOGITS = WS_OB + ROWB2;
constexpr size_t WS_TOPI = WS_LOGITS + (size_t)M * 32 * 4;
constexpr size_t WS_TOPG = WS_TOPI + (size_t)M * 16;
constexpr size_t WS_ROWIDX = WS_TOPG + (size_t)M * 16;
constexpr size_t WS_ACT = ((WS_ROWIDX + (size_t)NE * CAP * 4 + MiB - 1) / MiB) * MiB;
constexpr size_t WS_YB = WS_ACT + 4 * ROWB2;
constexpr size_t WS_MIX = WS_YB + 4 * ROWB2;
constexpr size_t WS_PROJ = WS_MIX;
constexpr size_t WS_QM = WS_PROJ + (size_t)M * PROJ_LD * 2;
constexpr size_t WS_KVM = WS_QM + (size_t)M * 768 * 2;
constexpr size_t WS_ATT_END = WS_KVM + ROWB2;
constexpr size_t WS_XMIX = WS_MIX;
constexpr size_t WS_RB = WS_XMIX + 6 * ROWB2, WS_KB = WS_RB + ROWB2, WS_VB = WS_KB + ROWB2;
constexpr size_t WS_LW = WS_VB + ROWB2, LORA_B = (size_t)M * 128 * 2, WS_LA = WS_LW + LORA_B, WS_LG = WS_LA + LORA_B, WS_LV = WS_LG + LORA_B;
constexpr size_t WS_WDEC = WS_LV + LORA_B;
constexpr size_t WS_AD = WS_WDEC + 4 * ROWB2;
constexpr size_t WS_GB = WS_AD + 2 * ROWB2, WS_VGT = WS_GB + ROWB2;
constexpr size_t WS_KK = WS_VGT + ROWB2, WS_KD = WS_KK + ROWB2, WS_BD = WS_KD + 2 * ROWB2, WS_V2 = WS_BD + 2 * ROWB2;
constexpr size_t WS_YS = WS_V2 + ROWB2;
constexpr size_t WS_RWKV_END = WS_YS + 4 * ROWB2;
constexpr size_t WS_VFIRST = WS_RWKV_END;
constexpr size_t WS_END = WS_VFIRST + ROWB2;
static_assert(WS_ATT_END <= WS_RWKV_END, "mixer scratch overlay");
static_assert(WS_END <= (size_t)4096 * MiB, "d_ws map must fit 4 GiB");

constexpr int CW_TMO = 0, CW_CODE = 1;
constexpr int CW_ECNT = 1024;
constexpr int CW_BAR = 16384;
constexpr int MAX_BAR_REGIONS = 64;
static_assert(CW_ECNT + 4 * 32 * 64 <= CW_BAR && (CW_BAR + MAX_BAR_REGIONS * 3456) * 4 <= (int)CTL_BYTES, "CTL words inside the memset region");

constexpr int RING_OFF = 0, RING_BYTES = 153600;
constexpr int LDSCTL_OFF = RING_BYTES, MISC_OFF = LDSCTL_OFF + 320;
constexpr int LDS_BYTES = RING_BYTES + 4096;
static_assert(MISC_OFF + 128 <= LDS_BYTES, "LDS map");

__device__ __forceinline__ unsigned f2bf(float f) { unsigned u = __builtin_bit_cast(unsigned, f); return (u + 0x7fffu + ((u >> 16) & 1u)) >> 16; }
typedef __bf16 bf16x2_t __attribute__((ext_vector_type(2)));
__device__ __forceinline__ unsigned pk2(float lo, float hi) { const f32x2 v = {lo, hi}; const bf16x2_t b = __builtin_convertvector(v, bf16x2_t); return __builtin_bit_cast(unsigned, b); }
__device__ __forceinline__ float bf2f(unsigned short h) { return __builtin_bit_cast(float, (unsigned)h << 16); }
__device__ __forceinline__ float bflo(unsigned w) { return __builtin_bit_cast(float, w << 16); }
__device__ __forceinline__ float bfhi(unsigned w) { return __builtin_bit_cast(float, w & 0xffff0000u); }
__device__ __forceinline__ int lane_now() { int l; asm volatile("v_mbcnt_lo_u32_b32 %0, -1, 0\n\tv_mbcnt_hi_u32_b32 %0, -1, %0" : "=v"(l)); return l; }
__device__ __forceinline__ int opaque_tid(int wave) { int t = wave * 64 + lane_now(); asm volatile("" : "+v"(t)); return t; }
__device__ __forceinline__ int lanes_get(int v, int src_lane) { return __builtin_amdgcn_ds_bpermute(src_lane << 2, v); }
__device__ __forceinline__ float lanes_xor(float v, int m) { return __builtin_bit_cast(float, __builtin_amdgcn_ds_bpermute((lane_now() ^ m) << 2, __builtin_bit_cast(int, v))); }
__device__ __forceinline__ float dpp_xor1(float x) { return __builtin_bit_cast(float, __builtin_amdgcn_update_dpp(0, __builtin_bit_cast(int, x), 0xB1, 0xF, 0xF, true)); }
__device__ __forceinline__ float dpp_xor2(float x) { return __builtin_bit_cast(float, __builtin_amdgcn_update_dpp(0, __builtin_bit_cast(int, x), 0x4E, 0xF, 0xF, true)); }
__device__ __forceinline__ float dpp_hmir(float x) { return __builtin_bit_cast(float, __builtin_amdgcn_update_dpp(0, __builtin_bit_cast(int, x), 0x141, 0xF, 0xF, true)); }
__device__ __forceinline__ float sum8(float x) { x += dpp_xor1(x); x += dpp_xor2(x); x += dpp_hmir(x); return x; }
__device__ __forceinline__ float dpp_rmir(float x) { return __builtin_bit_cast(float, __builtin_amdgcn_update_dpp(0, __builtin_bit_cast(int, x), 0x140, 0xF, 0xF, true)); }
__device__ __forceinline__ float sum16(float x) { x += dpp_xor1(x); x += dpp_xor2(x); x += dpp_hmir(x); x += dpp_rmir(x); return x; }
__device__ __forceinline__ float wave_sum(float v) {
    const int s = __builtin_bit_cast(int, sum16(v));
    return (__builtin_bit_cast(float, __builtin_amdgcn_readlane(s, 0)) + __builtin_bit_cast(float, __builtin_amdgcn_readlane(s, 16))) + (__builtin_bit_cast(float, __builtin_amdgcn_readlane(s, 32)) + __builtin_bit_cast(float, __builtin_amdgcn_readlane(s, 48)));
}
__device__ __forceinline__ float sigmoidf_(float x) { return __builtin_amdgcn_rcpf(1.f + __expf(-x)); }
__device__ __forceinline__ float siluf_(float x) { return x * __builtin_amdgcn_rcpf(1.f + __expf(-x)); }
#define XB_TMO      128
#define XB_XCNT(j)  (256  + 64 * (j))
#define XB_XSUB(j)  (1280 + 64 * (j))
#define XB_XGEN(j)  (2304 + 64 * (j))
#define XB_TOP      3328
#define XB_TOPGEN   3392
#define XCD_BAR_WORDS 3456
#define XB_SPIN_CAP (1u << 18)

__device__ __forceinline__ unsigned xb_ld(unsigned* p)              { return __hip_atomic_load(p, __ATOMIC_RELAXED, __HIP_MEMORY_SCOPE_AGENT); }
__device__ __forceinline__ unsigned xb_add(unsigned* p, unsigned v) { return __hip_atomic_fetch_add(p, v, __ATOMIC_RELAXED, __HIP_MEMORY_SCOPE_AGENT); }
__device__ __forceinline__ unsigned xb_xcc_id() { return (unsigned)__builtin_amdgcn_s_getreg((3 << 11) | 20) & 0xFu; }
#define XB_SPIN(cond, bar) do { unsigned _sp = 0; while (cond) { __builtin_amdgcn_s_sleep(1); \
    if ((++_sp & 255u) == 0u) { if (xb_ld(&(bar)[XB_TMO])) break; if (_sp > XB_SPIN_CAP) { atomicAdd(&(bar)[XB_TMO], 1u); break; } } } } while (0)

struct XcdBarrier {
    unsigned* bar; unsigned x; int w;
    volatile LAS unsigned* st;
};

__device__ __forceinline__ XcdBarrier xcd_barrier_post(unsigned* bar, volatile LAS unsigned* st) {
    XcdBarrier b; b.bar = bar; b.x = xb_xcc_id(); b.st = st; b.w = __builtin_amdgcn_readfirstlane((int)threadIdx.x >> 6);
    if (threadIdx.x == 0) (void)xb_add(&bar[XB_XCNT(b.x)], 1u);
    return b;
}
__device__ __forceinline__ void xcd_barrier_complete(unsigned* bar, unsigned x, unsigned& nloc, unsigned& nx) {
    const unsigned G = gridDim.x * gridDim.y * gridDim.z;
    unsigned sum, cnt, mine, sp = 0u;
    for (;;) {
        sum = 0u; cnt = 0u; mine = 0u;
#pragma unroll
        for (unsigned j = 0; j < 16; ++j) { const unsigned c = xb_ld(&bar[XB_XCNT(j)]); sum += c; cnt += (c > 0u) ? 1u : 0u; mine = (j == x) ? c : mine; }
        if (sum == G) break;
        __builtin_amdgcn_s_sleep(1);
        if ((++sp & 255u) == 0u) { if (xb_ld(&bar[XB_TMO])) break; if (sp > XB_SPIN_CAP) { atomicAdd(&bar[XB_TMO], 1u); break; } }
    }
    nloc = mine > 0u ? mine : 1u; nx = cnt > 0u ? cnt : 1u;
}

__device__ __forceinline__ void xcd_barrier(const XcdBarrier& b) {
    asm volatile("s_waitcnt vmcnt(0)" ::: "memory");
    __syncthreads();
    if (b.w == 0 && lane_now() == 0) {
        unsigned* bar = b.bar;
        __builtin_amdgcn_s_waitcnt(0);
        unsigned nloc = b.st[0], nx = b.st[1];
        if (nloc == 0u) { xcd_barrier_complete(bar, b.x, nloc, nx); b.st[0] = nloc; b.st[1] = nx; }
        const unsigned old = xb_add(&bar[XB_XSUB(b.x)], 1u);
        const unsigned gen = old / nloc;
        if (old + 1u == (gen + 1u) * nloc) {
            __builtin_amdgcn_fence(__ATOMIC_RELEASE, "agent");
            asm volatile("s_waitcnt vmcnt(0)" ::: "memory");
            const unsigned og = xb_add(&bar[XB_TOP], 1u);
            const unsigned tg = og / nx;
            if (og + 1u == (tg + 1u) * nx) xb_add(&bar[XB_TOPGEN], 1u);
            else XB_SPIN(xb_ld(&bar[XB_TOPGEN]) == tg, bar);
            __builtin_amdgcn_fence(__ATOMIC_ACQUIRE, "agent");
            xb_add(&bar[XB_XGEN(b.x)], 1u);
            asm volatile("s_waitcnt vmcnt(0)" ::: "memory");
        } else {
            XB_SPIN(xb_ld(&bar[XB_XGEN(b.x)]) == gen, bar);
            __builtin_amdgcn_fence(__ATOMIC_ACQUIRE, "agent");
            asm volatile("s_waitcnt vmcnt(0)" ::: "memory");
        }
    }
    __syncthreads();
}
namespace pg8 {
constexpr int BM = 256, BK = 64, HALF = 128, HTB = HALF * BK * 2  , STAGE_BYTES = 8 * HTB, IDX_OFF = STAGE_BYTES  ,
              TAB_OFF = IDX_OFF + 16384  ;

__host__ __device__ __forceinline__ int lds_byte(int r, int c) { const int st = (r >> 4) * 2 + (c >> 5), rr = r & 15, cc = c & 31, ob = rr * 64 + cc * 2; return st * 1024 + (ob ^ (((ob >> 9) & 1) << 5)); }
__host__ __device__ __forceinline__ void stage_rc(int b, int& R, int& C) { const int st = b / 1024, sb = b % 1024, swz = sb ^ (((sb >> 9) & 1) << 5); R = (st >> 1) * 16 + swz / 64; C = (st & 1) * 32 + (swz % 64) / 2; }
__host__ __device__ __forceinline__ int perm32(int rho) { const int n = rho >> 4, i = rho & 15; return 8 * (i >> 2) + 4 * n + (i & 3); }

struct Unit {
    const char* A; const char* B;
    int lda;
    int K;
    int pm, pn;
    int kind;
    int e;
    int nrows;
    const int* ridx;
};

__device__ __forceinline__ int rfl(int v) { return __builtin_amdgcn_readfirstlane(v); }
template <class T> __device__ __forceinline__ T* rflp(T* p) { const unsigned long long v = (unsigned long long)p; const unsigned lo = __builtin_amdgcn_readfirstlane((unsigned)v), hi = __builtin_amdgcn_readfirstlane((unsigned)(v >> 32));
    return (T*)(((unsigned long long)hi << 32) | lo); }
__device__ __forceinline__ void uniformize(Unit& u) { u.A = rflp(u.A); u.B = rflp(u.B); u.lda = rfl(u.lda); u.K = rfl(u.K); u.pm = rfl(u.pm); u.pn = rfl(u.pn); u.kind = rfl(u.kind); u.e = rfl(u.e); u.nrows = rfl(u.nrows); u.ridx = rflp(u.ridx); }
__device__ __forceinline__ unsigned cvt_pk_bf16(float lo, float hi) { unsigned r; asm volatile("v_cvt_pk_bf16_f32 %0, %1, %2" : "=v"(r) : "v"(lo), "v"(hi)); return r; }

template <class T, class = void> struct epi_has_tab { static constexpr bool value = false; };
template <class T> struct epi_has_tab<T, decltype((void)T::HAS_TAB)> { static constexpr bool value = true; };
template <class Epi, bool PRE = false>
__device__ __forceinline__ void run_epilogue(const Epi& E, const f32x4 (&acc)[2][2][4][2], const Unit& u, int wr, int wc, int fr, int fq, const LAS unsigned char* tab = nullptr) {
    typename Epi::Ctx c;
    const int lrow0 = wr * 64 + fr, lcol0 = wc * 32 + 8 * fq;
    if constexpr (PRE) E.begin_pre(c, u, lrow0, lcol0, tab); else E.begin(c, u, lrow0, lcol0);
#pragma unroll
    for (int ai = 0; ai < 2; ++ai) {
        E.begin_half(c, u, ai, lrow0, lcol0);
#pragma unroll
        for (int m = 0; m < 4; ++m)
#pragma unroll
            for (int bj = 0; bj < 2; ++bj) E.row8(c, u, ai * 4 + m, bj, lrow0 + ai * HALF + m * 16, lcol0 + bj * HALF, acc[ai][bj][m][0], acc[ai][bj][m][1]);
    }
}

template <class Epi, class Sched, int GSH = -1>
__device__ __forceinline__ void gemm_phase(LAS unsigned char* lds, const Sched& S, const Epi& E, int wave_) {
    const int tid = opaque_tid(wave_), wid = __builtin_amdgcn_readfirstlane(tid >> 6), lane = tid & 63, wr = wid >> 2, wc = wid & 3, fr = lane & 15, fq = lane >> 4;
    int R0, C0, R1, C1; stage_rc(tid * 16, R0, C0); stage_rc(tid * 16 + 8192, R1, C1);
    const int Rb0 = (R0 & ~31) + perm32(R0 & 31), Rb1 = (R1 & ~31) + perm32(R1 & 31);
    const unsigned ldsw = (unsigned)wid * 1024u;
    const int aoff = lds_byte(wr * 64 + fr, fq * 8), boff = lds_byte(wc * 32 + fr, fq * 8);
#define PG8_SA(b, h) (((b) * 2 + (h)) * HTB)
#define PG8_SB(b, h) ((4 + (b) * 2 + (h)) * HTB)
#define PG8_STAGE2(bufoff, gbase, o0, o1) do { \
        __builtin_amdgcn_global_load_lds((const unsigned*)((const char*)(gbase) + (o0)), (LAS unsigned*)(lds + (bufoff) + ldsw), 16, 0, 0); \
        __builtin_amdgcn_global_load_lds((const unsigned*)((const char*)(gbase) + (o1)), (LAS unsigned*)(lds + (bufoff) + ldsw + 8192), 16, 0, 0); } while (0)
#define PG8_LDA(dst, b, h) do { _Pragma("unroll") for (int m = 0; m < 4; ++m) _Pragma("unroll") for (int k = 0; k < 2; ++k) dst[m][k] = *(const LAS bf16x8*)(lds + PG8_SA(b, h) + aoff + m * 2048 + k * 1024); } while (0)
#define PG8_LDB(dst, b, h) do { _Pragma("unroll") for (int n = 0; n < 2; ++n) _Pragma("unroll") for (int k = 0; k < 2; ++k) dst[n][k] = *(const LAS bf16x8*)(lds + PG8_SB(b, h) + boff + n * 2048 + k * 1024); } while (0)
#define PG8_MMA(ai, bj, At, Bt) do { __builtin_amdgcn_s_setprio(1); _Pragma("unroll") for (int m = 0; m < 4; ++m) _Pragma("unroll") for (int n = 0; n < 2; ++n) _Pragma("unroll") for (int k = 0; k < 2; ++k) \
        acc[ai][bj][m][n] = __builtin_amdgcn_mfma_f32_16x16x32_bf16(Bt[n][k], At[m][k], acc[ai][bj][m][n], 0, 0, 0); __builtin_amdgcn_s_setprio(0); } while (0)
#define PG8_WAIT_V(n) asm volatile("s_waitcnt vmcnt(" #n ")" ::: "memory")
#define PG8_WAIT_L(n) asm volatile("s_waitcnt lgkmcnt(" #n ")" ::: "memory")
#define PG8_BAR __builtin_amdgcn_s_barrier()
#define PG8_SCHED __builtin_amdgcn_sched_barrier(0)
#define PG8_OFFS(u, a00, a01, a10, a11, b0, b1, hs) do { \
        if constexpr (GSH >= 0) { \
            const int i00 = (R0 < (u).nrows) ? (u).ridx[R0] : 0, i01 = (R1 < (u).nrows) ? (u).ridx[R1] : 0; \
            const int i10 = (HALF + R0 < (u).nrows) ? (u).ridx[HALF + R0] : 0, i11 = (HALF + R1 < (u).nrows) ? (u).ridx[HALF + R1] : 0; \
            a00 = (unsigned)(i00 >> GSH) * (unsigned)(u).lda + C0 * 2; a01 = (unsigned)(i01 >> GSH) * (unsigned)(u).lda + C1 * 2; \
            a10 = (unsigned)(i10 >> GSH) * (unsigned)(u).lda + C0 * 2; a11 = (unsigned)(i11 >> GSH) * (unsigned)(u).lda + C1 * 2; \
        } else { \
            const unsigned rb = (unsigned)((u).pm * BM) * (unsigned)(u).lda; \
            a00 = rb + (unsigned)R0 * (unsigned)(u).lda + C0 * 2; a01 = rb + (unsigned)R1 * (unsigned)(u).lda + C1 * 2; \
            a10 = a00 + (unsigned)HALF * (unsigned)(u).lda; a11 = a01 + (unsigned)HALF * (unsigned)(u).lda; } \
        b0 = (unsigned)(Rb0 * (u).K + C0) * 2u; b1 = (unsigned)(Rb1 * (u).K + C1) * 2u; hs = (unsigned)HALF * (unsigned)(u).K * 2u; } while (0)
    Unit cur, nxt; int ui = 0;
    if (!S.next(0, cur)) return;
    uniformize(cur);
    f32x4 acc[2][2][4][2];
#pragma unroll
    for (int a = 0; a < 2; ++a)
#pragma unroll
        for (int b = 0; b < 2; ++b)
#pragma unroll
            for (int m = 0; m < 4; ++m)
#pragma unroll
                for (int n = 0; n < 2; ++n) acc[a][b][m][n] = (f32x4){0.f, 0.f, 0.f, 0.f};
    bf16x8 At[4][2], B0[2][2], B1[2][2];
    unsigned ca00, ca01, ca10, ca11, cb0, cb1, chs;
    unsigned na00, na01, na10, na11, nb0, nb1, nhs;
    PG8_OFFS(cur, ca00, ca01, ca10, ca11, cb0, cb1, chs);
    const char* cA = cur.A; const char* cB = cur.B;
    constexpr unsigned kstep = BK * 2;
    PG8_STAGE2(PG8_SB(0, 0), cB, cb0, cb1); PG8_STAGE2(PG8_SB(0, 1), cB + chs, cb0, cb1); PG8_STAGE2(PG8_SA(0, 0), cA, ca00, ca01); PG8_STAGE2(PG8_SA(0, 1), cA, ca10, ca11);
    if (wr == 1) PG8_BAR;
    PG8_WAIT_V(2); PG8_BAR;
    PG8_STAGE2(PG8_SB(1, 0), cB + kstep, cb0, cb1); PG8_STAGE2(PG8_SA(1, 0), cA + kstep, ca00, ca01); PG8_STAGE2(PG8_SB(1, 1), cB + chs + kstep, cb0, cb1);
    PG8_WAIT_V(6); PG8_BAR;
    for (;;) {
        if constexpr (GSH >= 0) {
            LAS unsigned char* tb = lds + TAB_OFF + (ui & 1) * 2048;
            if (wid < 4) __builtin_amdgcn_global_load_lds((const unsigned*)(cur.ridx + wid * 64 + lane), (LAS unsigned*)(tb + wid * 256), 4, 0, 0);
            else __builtin_amdgcn_global_load_lds((const unsigned*)(E.bias_of(cur) + (wid - 4) * 64 + lane), (LAS unsigned*)(tb + 1024 + (wid - 4) * 256), 4, 0, 0);
        }
        else if constexpr (epi_has_tab<Epi>::value) {
            if (wid >= 4) __builtin_amdgcn_global_load_lds((const unsigned*)(E.bias_of(cur) + (wid - 4) * 64 + lane), (LAS unsigned*)(lds + TAB_OFF + (ui & 1) * 2048 + 1024 + (wid - 4) * 256), 4, 0, 0);
        }
        const bool has_next = S.next(ui + 1, nxt); uniformize(nxt);
        const char* nA = cA; const char* nB = cB; na00 = ca00; na01 = ca01; na10 = ca10; na11 = ca11; nb0 = cb0; nb1 = cb1; nhs = chs;
        if (has_next) { nA = nxt.A; nB = nxt.B;
            if constexpr (GSH >= 0) {
                nb0 = (unsigned)(Rb0 * nxt.K + C0) * 2u; nb1 = (unsigned)(Rb1 * nxt.K + C1) * 2u; nhs = (unsigned)HALF * (unsigned)nxt.K * 2u;
                LAS unsigned char* ib = lds + IDX_OFF + (ui & 1) * 8192 + wid * 1024;
                __builtin_amdgcn_global_load_lds((const unsigned*)(nxt.ridx + R0), (LAS unsigned*)(ib), 4, 0, 0);
                __builtin_amdgcn_global_load_lds((const unsigned*)(nxt.ridx + R1), (LAS unsigned*)(ib + 256), 4, 0, 0);
                __builtin_amdgcn_global_load_lds((const unsigned*)(nxt.ridx + HALF + R0), (LAS unsigned*)(ib + 512), 4, 0, 0);
                __builtin_amdgcn_global_load_lds((const unsigned*)(nxt.ridx + HALF + R1), (LAS unsigned*)(ib + 768), 4, 0, 0);
            } else { PG8_OFFS(nxt, na00, na01, na10, na11, nb0, nb1, nhs); } }
        const int nt = cur.K / BK;
        for (int t = 0; t < nt; t += 2) {
            const bool last = (t == nt - 2);
            if constexpr (GSH >= 0) { if (last && has_next) {
                const LAS unsigned char* ib = lds + IDX_OFF + (ui & 1) * 8192 + wid * 1024 + lane * 4;
                int i00 = *(const LAS int*)(ib), i01 = *(const LAS int*)(ib + 256), i10 = *(const LAS int*)(ib + 512), i11 = *(const LAS int*)(ib + 768);
                i00 = (R0 < nxt.nrows) ? i00 : 0; i01 = (R1 < nxt.nrows) ? i01 : 0; i10 = (HALF + R0 < nxt.nrows) ? i10 : 0; i11 = (HALF + R1 < nxt.nrows) ? i11 : 0;
                na00 = (unsigned)(i00 >> GSH) * (unsigned)nxt.lda + C0 * 2; na01 = (unsigned)(i01 >> GSH) * (unsigned)nxt.lda + C1 * 2;
                na10 = (unsigned)(i10 >> GSH) * (unsigned)nxt.lda + C0 * 2; na11 = (unsigned)(i11 >> GSH) * (unsigned)nxt.lda + C1 * 2; } }
            const char* a1 = cA + (size_t)(t + 1) * kstep;
            const char* a2 = last ? nA : cA + (size_t)(t + 2) * kstep; const char* b2 = last ? nB : cB + (size_t)(t + 2) * kstep;
            const char* a3 = a2 + kstep; const char* b3 = b2 + kstep;
            const unsigned xa00 = last ? na00 : ca00, xa01 = last ? na01 : ca01, xa10 = last ? na10 : ca10, xa11 = last ? na11 : ca11;
            const unsigned xb0 = last ? nb0 : cb0, xb1 = last ? nb1 : cb1, xhs = last ? nhs : chs;
            PG8_LDB(B0, 0, 0); PG8_LDB(B1, 0, 1); PG8_SCHED; PG8_LDA(At, 0, 0); PG8_STAGE2(PG8_SA(1, 1), a1, ca10, ca11);
            PG8_WAIT_V(8); PG8_WAIT_L(0); PG8_BAR; PG8_MMA(0, 0, At, B0); PG8_MMA(0, 1, At, B1); PG8_BAR; PG8_SCHED;
            PG8_LDA(At, 0, 1); PG8_STAGE2(PG8_SB(0, 0), b2, xb0, xb1); PG8_STAGE2(PG8_SB(0, 1), b2 + xhs, xb0, xb1); PG8_STAGE2(PG8_SA(0, 0), a2, xa00, xa01);
            PG8_WAIT_V(8); PG8_WAIT_L(0); PG8_BAR; PG8_MMA(1, 0, At, B0); PG8_MMA(1, 1, At, B1); PG8_BAR; PG8_SCHED;
            PG8_LDB(B0, 1, 0); PG8_LDB(B1, 1, 1); PG8_SCHED; PG8_LDA(At, 1, 0); PG8_STAGE2(PG8_SA(0, 1), a2, xa10, xa11);
            PG8_WAIT_V(8); PG8_WAIT_L(0); PG8_BAR; PG8_MMA(0, 0, At, B0); PG8_MMA(0, 1, At, B1); PG8_BAR; PG8_SCHED;
            PG8_LDA(At, 1, 1); PG8_STAGE2(PG8_SB(1, 0), b3, xb0, xb1); PG8_STAGE2(PG8_SB(1, 1), b3 + xhs, xb0, xb1); PG8_STAGE2(PG8_SA(1, 0), a3, xa00, xa01);
            PG8_WAIT_V(8); PG8_WAIT_L(0); PG8_BAR; PG8_MMA(1, 0, At, B0); PG8_MMA(1, 1, At, B1); PG8_BAR; PG8_SCHED;
        }
        if (wr == 0) PG8_BAR;
        if constexpr (GSH >= 0 || epi_has_tab<Epi>::value) run_epilogue<Epi, true>(E, acc, cur, wr, wc, fr, fq, lds + TAB_OFF + (ui & 1) * 2048); else run_epilogue(E, acc, cur, wr, wc, fr, fq);
        if (!has_next) break;
#pragma unroll
        for (int a = 0; a < 2; ++a)
#pragma unroll
            for (int b = 0; b < 2; ++b)
#pragma unroll
                for (int m = 0; m < 4; ++m)
#pragma unroll
                    for (int n = 0; n < 2; ++n) acc[a][b][m][n] = (f32x4){0.f, 0.f, 0.f, 0.f};
        cur = nxt; cA = nA; cB = nB; ca00 = na00; ca01 = na01; ca10 = na10; ca11 = na11; cb0 = nb0; cb1 = nb1; chs = nhs; ++ui;
        if (wr == 1) PG8_BAR;
    }
    PG8_WAIT_V(0);
    PG8_BAR;
#undef PG8_SA
#undef PG8_SB
#undef PG8_STAGE2
#undef PG8_LDA
#undef PG8_LDB
#undef PG8_MMA
#undef PG8_WAIT_V
#undef PG8_WAIT_L
#undef PG8_BAR
#undef PG8_SCHED
#undef PG8_OFFS
}
}
namespace att {
constexpr int NW = 8, QBLK = 32, KVBLK = 64;
constexpr float THR = 8.f;
constexpr int SHM_V = KVBLK * 128 * 2, SHM_K = KVBLK * 128 * 2, SHM_R = KVBLK * 64 * 2;
constexpr int OFF_V = 0, OFF_K = 2 * SHM_V, OFF_R = OFF_K + 2 * SHM_K, OFF_WS = OFF_R + 2 * SHM_R, OFF_QR = OFF_WS + NW * 64 * 4, ATTN_LDS_GQA = OFF_QR, QL_MAX = 8, ATTN_LDS = OFF_QR + NW * QL_MAX * 1024;
#define KSWZ(row, colB) ((row) * 256 + ((colB) ^ (((row) & 7) << 4)))
#define RSWZ(row, colB) ((row) * 128 + ((colB) ^ ((((row) >> 1) & 7) << 4)))
#define SBAR() __builtin_amdgcn_sched_barrier(0)
__device__ __forceinline__ int crow(int r, int hi) { return (r & 3) + 8 * (r >> 2) + 4 * hi; }
__device__ __forceinline__ unsigned cvtpk(float lo, float hi) { unsigned r; asm volatile("v_cvt_pk_bf16_f32 %0, %1, %2" : "=v"(r) : "v"(lo), "v"(hi)); return r; }

template <int DK>
__device__ __forceinline__ void partialSM(f32x16& p0, f32x16& p1, float& m_reg, float& mn, float& alpha) {
  constexpr float SCALE = (DK == 192) ? MLA_SCALE : GQA_SCALE;
  constexpr float C = SCALE * 1.4426950408889634f;
  float pmax = p0[0];
#pragma unroll
  for (int r = 1; r < 16; ++r) pmax = fmaxf(pmax, p0[r]);
#pragma unroll
  for (int r = 0; r < 16; ++r) pmax = fmaxf(pmax, p1[r]);
  { auto rr = __builtin_amdgcn_permlane32_swap(__float_as_uint(pmax), __float_as_uint(pmax), false, false);
    pmax = fmaxf(__uint_as_float(rr[0]), __uint_as_float(rr[1])); }
  if (__builtin_expect(__all(pmax - m_reg <= THR / SCALE), 1)) { mn = m_reg; alpha = 1.f; }
  else { mn = fmaxf(m_reg, pmax); alpha = __builtin_amdgcn_exp2f((m_reg - mn) * C); m_reg = mn; }
  float mnC = -mn * C;
#pragma unroll
  for (int r = 0; r < 16; ++r) p0[r] = fmaf(p0[r], C, mnC);
#pragma unroll
  for (int r = 0; r < 16; ++r) p1[r] = fmaf(p1[r], C, mnC);
#pragma unroll
  for (int r = 0; r < 16; ++r) p0[r] = __builtin_amdgcn_exp2f(p0[r]);
}
__device__ __forceinline__ void finishSM(f32x16& p0, f32x16& p1, float alpha, float& l_reg, bf16x8& pa0, bf16x8& pa1, bf16x8& pa2, bf16x8& pa3) {
#pragma unroll
  for (int r = 0; r < 16; ++r) p1[r] = __builtin_amdgcn_exp2f(p1[r]);
  float ps = 0;
#pragma unroll
  for (int r = 0; r < 16; ++r) ps += p0[r];
#pragma unroll
  for (int r = 0; r < 16; ++r) ps += p1[r];
  { auto rr = __builtin_amdgcn_permlane32_swap(__float_as_uint(ps), __float_as_uint(ps), false, false);
    ps = __uint_as_float(rr[0]) + __uint_as_float(rr[1]); }
  l_reg = l_reg * alpha + ps;
#define PK4(P, BASE, OUT) do { unsigned a0 = cvtpk(P[BASE + 0], P[BASE + 1]), a1 = cvtpk(P[BASE + 2], P[BASE + 3]);   \
    unsigned b0 = cvtpk(P[BASE + 4], P[BASE + 5]), b1 = cvtpk(P[BASE + 6], P[BASE + 7]);                              \
    auto r0 = __builtin_amdgcn_permlane32_swap(a0, b0, false, false); auto r1 = __builtin_amdgcn_permlane32_swap(a1, b1, false, false); \
    v4u w = {r0[0], r1[0], r0[1], r1[1]}; OUT = __builtin_bit_cast(bf16x8, w); } while (0)
  PK4(p0, 0, pa0); PK4(p0, 8, pa1); PK4(p1, 0, pa2); PK4(p1, 8, pa3);
#undef PK4
}
template <int DK, int QREG, bool QSB = (DK == 192)>
__device__ __forceinline__ void qkt(f32x16& p0, f32x16& p1, const char* Ks, const char* Rs, const bf16x8* qr, const char* Qrl, int r32, int hi) {
  p0 = f32x16{}; p1 = f32x16{};
#pragma unroll
  for (int d0 = 0; d0 < 8; ++d0) { const int cb = (d0 * 16 + hi * 8) * 2;
    bf16x8 b0 = *reinterpret_cast<const bf16x8*>(Ks + KSWZ(r32, cb));
    bf16x8 b1 = *reinterpret_cast<const bf16x8*>(Ks + KSWZ(32 + r32, cb));
    bf16x8 qf; if constexpr (true) { if (d0 < QREG) qf = qr[d0 < QREG ? d0 : 0]; else qf = *reinterpret_cast<const bf16x8*>(Qrl + (d0 - QREG) * (NW * 1024)); }
    p0 = __builtin_amdgcn_mfma_f32_32x32x16_bf16(b0, qf, p0, 0, 0, 0);
    p1 = __builtin_amdgcn_mfma_f32_32x32x16_bf16(b1, qf, p1, 0, 0, 0);
    if (QSB && (d0 & 3) == 3) SBAR(); }
  if constexpr (DK == 192) {
#pragma unroll
    for (int d0 = 0; d0 < 4; ++d0) { const int cb = (d0 * 16 + hi * 8) * 2;
      bf16x8 b0 = *reinterpret_cast<const bf16x8*>(Rs + RSWZ(r32, cb));
      bf16x8 b1 = *reinterpret_cast<const bf16x8*>(Rs + RSWZ(32 + r32, cb));
      const bf16x8 qf = *reinterpret_cast<const bf16x8*>(Qrl + (8 + d0 - QREG) * (NW * 1024));
      p0 = __builtin_amdgcn_mfma_f32_32x32x16_bf16(b0, qf, p0, 0, 0, 0);
      p1 = __builtin_amdgcn_mfma_f32_32x32x16_bf16(b1, qf, p1, 0, 0, 0); }
  }
}
__device__ __forceinline__ int v_st(int k, int c) { const int kk = (k & ~0xC) | ((k & 4) << 1) | ((k & 8) >> 1); return ((kk >> 3) * 4 + (c >> 5)) * 512 + ((kk & 7) * 32 + (c & 31)) * 2; }
__device__ __forceinline__ int v_rd_base(int lane) { return ((lane & 3) << 3) | (((lane >> 2) & 3) << 6) | (((lane >> 4) & 1) << 5) | (((lane >> 5) & 1) << 8); }
constexpr int v_rd_off(int d0, int ks, int half) { return d0 * 512 + ks * 4096 + half * 2048; }
template <int OFF> __device__ __forceinline__ s16x4 tr_read(int vb) {
  s16x4 r; asm volatile("ds_read_b64_tr_b16 %0, %1 offset:%2" : "=&v"(r) : "v"(vb), "i"(OFF) : "memory"); return r;
}
template <int D0> __device__ __forceinline__ void pv_one(f32x16& od, int vb, bf16x8 pa0, bf16x8 pa1, bf16x8 pa2, bf16x8 pa3) {
  const s16x4 l0 = tr_read<v_rd_off(D0, 0, 0)>(vb), h0 = tr_read<v_rd_off(D0, 0, 1)>(vb), l1 = tr_read<v_rd_off(D0, 1, 0)>(vb), h1 = tr_read<v_rd_off(D0, 1, 1)>(vb);
  const s16x4 l2 = tr_read<v_rd_off(D0, 2, 0)>(vb), h2 = tr_read<v_rd_off(D0, 2, 1)>(vb), l3 = tr_read<v_rd_off(D0, 3, 0)>(vb), h3 = tr_read<v_rd_off(D0, 3, 1)>(vb);
  asm volatile("s_waitcnt lgkmcnt(0)" ::: "memory"); SBAR();
#define PK(L, H) (bf16x8){L[0], L[1], L[2], L[3], H[0], H[1], H[2], H[3]}
  od = __builtin_amdgcn_mfma_f32_32x32x16_bf16(pa0, PK(l0, h0), od, 0, 0, 0);
  od = __builtin_amdgcn_mfma_f32_32x32x16_bf16(pa1, PK(l1, h1), od, 0, 0, 0);
  od = __builtin_amdgcn_mfma_f32_32x32x16_bf16(pa2, PK(l2, h2), od, 0, 0, 0);
  od = __builtin_amdgcn_mfma_f32_32x32x16_bf16(pa3, PK(l3, h3), od, 0, 0, 0);
#undef PK
}
__device__ __forceinline__ void pv_d0(f32x16* o, int vb, bf16x8 pa0, bf16x8 pa1, bf16x8 pa2, bf16x8 pa3) {
  pv_one<0>(o[0], vb, pa0, pa1, pa2, pa3); pv_one<1>(o[1], vb, pa0, pa1, pa2, pa3); pv_one<2>(o[2], vb, pa0, pa1, pa2, pa3); pv_one<3>(o[3], vb, pa0, pa1, pa2, pa3);
}

template <int DK, int SDEPTH, int QREG, int LDQ, int LDK, int LDR, int LDV, int LDO>
__device__ __forceinline__ void attn_unit(const bf16_t* __restrict__ Qb, const bf16_t* __restrict__ Kh, const bf16_t* __restrict__ Rh,
                                          const bf16_t* __restrict__ Vh, bf16_t* __restrict__ Ob, int seq, char* lds, int wave_) {
  const int tid = opaque_tid(wave_), wid = tid >> 6, lane = tid & 63, r32 = lane & 31, hi = lane >> 5;
  char* V_lds = lds + OFF_V; char* K_lds = lds + OFF_K; char* R_lds = lds + OFF_R;
  float* ws = (float*)(lds + OFF_WS) + wid * 64; float* li_l = ws; float* al_l = ws + 32;
  float m_reg = -1e30f, l_reg = 0; f32x16 o[4] = {}; bf16x8 qr[QREG];
  static_assert(DK / 16 - QREG <= QL_MAX, "q fragments in LDS");
  char* Qrl = lds + OFF_QR + wid * 1024 + lane * 16;
  const bf16_t* Qw = Qb + (long)(wid * QBLK + r32) * LDQ + hi * 8;
#pragma unroll
  for (int d0 = 0; d0 < QREG; ++d0) qr[d0] = *reinterpret_cast<const bf16x8*>(Qw + d0 * 16);
#pragma unroll
  for (int d0 = QREG; d0 < DK / 16; ++d0) *reinterpret_cast<bf16x8*>(Qrl + (d0 - QREG) * (NW * 1024)) = *reinterpret_cast<const bf16x8*>(Qw + d0 * 16);
  const int sr = tid >> 4, sc = (tid & 15) * 8, vst0 = v_st(sr, sc), vst1 = v_st(32 + sr, sc);
  const int rr_ = tid >> 3, rc_ = (tid & 7) * 8;
  const int vb0 = (int)(uintptr_t)V_lds + v_rd_base(lane);
  struct { bf16x8 vs0, vs1, ks0, ks1; } sr_[SDEPTH];
  bf16x8 rs_[SDEPTH];
  const unsigned voV = (unsigned)(sr * LDV + sc) * 2u, voK = (unsigned)(sr * LDK + sc) * 2u, voR = (unsigned)(rr_ * LDR + rc_) * 2u;
#define GLD(base, uoff, voff) (*reinterpret_cast<const bf16x8*>((const char*)(base) + (size_t)(uoff) + (voff)))
#define SLOAD(i, k0) do { sr_[i].vs0 = GLD(Vh, (size_t)(k0) * LDV * 2, voV); sr_[i].vs1 = GLD(Vh, (size_t)((k0) + 32) * LDV * 2, voV); \
    sr_[i].ks0 = GLD(Kh, (size_t)(k0) * LDK * 2, voK); sr_[i].ks1 = GLD(Kh, (size_t)((k0) + 32) * LDK * 2, voK); \
    if constexpr (DK == 192) rs_[i] = GLD(Rh, (size_t)(k0) * LDR * 2, voR); } while (0)
#define SWRITE(b, i) do { *(bf16x8*)(V_lds + (b) * SHM_V + vst0) = sr_[i].vs0;          \
    *(bf16x8*)(V_lds + (b) * SHM_V + vst1) = sr_[i].vs1; const int kc = sc * 2;               \
    *(bf16x8*)(K_lds + (b) * SHM_K + KSWZ(sr, kc)) = sr_[i].ks0;                       \
    *(bf16x8*)(K_lds + (b) * SHM_K + KSWZ(32 + sr, kc)) = sr_[i].ks1;                  \
    if constexpr (DK == 192) *(bf16x8*)(R_lds + (b) * SHM_R + RSWZ(rr_, rc_ * 2)) = rs_[i]; } while (0)
#define SWAIT() do { if constexpr (SDEPTH == 2) { if constexpr (DK == 192) asm volatile("s_waitcnt vmcnt(5)" ::: "memory"); else asm volatile("s_waitcnt vmcnt(4)" ::: "memory"); } \
    else asm volatile("s_waitcnt vmcnt(0)" ::: "memory"); } while (0)
#define RESC(a) do { if (__any((a) < 1.f)) { if (hi == 0) al_l[r32] = (a); asm volatile("s_waitcnt lgkmcnt(0)" ::: "memory"); \
    _Pragma("unroll") for (int d = 0; d < 4; ++d) _Pragma("unroll") for (int r = 0; r < 16; ++r) o[d][r] *= al_l[crow(r, hi)]; } } while (0)
  f32x16 pA0, pA1, pB0, pB1; float mnA, mnB, alA, alB; bf16x8 pa0, pa1, pa2, pa3; const int NT = seq / KVBLK;
  constexpr int SE = 0, SO = SDEPTH - 1;
  SLOAD(SE, 0); asm volatile("s_waitcnt vmcnt(0)" ::: "memory"); SWRITE(0, SE); __syncthreads();
  qkt<DK, QREG>(pA0, pA1, K_lds, R_lds, qr, Qrl, r32, hi); partialSM<DK>(pA0, pA1, m_reg, mnA, alA);
  SLOAD(SO, KVBLK); if constexpr (SDEPTH == 2) { if (2 < NT) SLOAD(SE, 2 * KVBLK); }
  SWAIT(); SWRITE(1, SO); __syncthreads();
  for (int j = 1; j + 1 < NT; j += 2) {
    SBAR(); qkt<DK, QREG>(pB0, pB1, K_lds + SHM_K, R_lds + SHM_R, qr, Qrl, r32, hi);
    finishSM(pA0, pA1, alA, l_reg, pa0, pa1, pa2, pa3); SBAR();
    SLOAD(SO, (j + SDEPTH) * KVBLK); SBAR();
    pv_d0(o, vb0, pa0, pa1, pa2, pa3); partialSM<DK>(pB0, pB1, m_reg, mnB, alB);
    __syncthreads(); SWAIT(); SWRITE(0, SE);
    RESC(alB); __syncthreads();
    SBAR(); qkt<DK, QREG>(pA0, pA1, K_lds, R_lds, qr, Qrl, r32, hi);
    finishSM(pB0, pB1, alB, l_reg, pa0, pa1, pa2, pa3); SBAR();
    if (SDEPTH == 1 || j + 3 < NT) SLOAD(SE, (j + 1 + SDEPTH) * KVBLK); SBAR();
    pv_d0(o, vb0 + (int)SHM_V, pa0, pa1, pa2, pa3); partialSM<DK>(pA0, pA1, m_reg, mnA, alA);
    __syncthreads(); SWAIT(); SWRITE(1, SO);
    RESC(alA); __syncthreads();
  }
  SBAR(); qkt<DK, QREG>(pB0, pB1, K_lds + SHM_K, R_lds + SHM_R, qr, Qrl, r32, hi);
  finishSM(pA0, pA1, alA, l_reg, pa0, pa1, pa2, pa3); SBAR();
  pv_d0(o, vb0, pa0, pa1, pa2, pa3); partialSM<DK>(pB0, pB1, m_reg, mnB, alB);
  __syncthreads(); RESC(alB);
  finishSM(pB0, pB1, alB, l_reg, pa0, pa1, pa2, pa3); SBAR();
  pv_d0(o, vb0 + (int)SHM_V, pa0, pa1, pa2, pa3);
  if (hi == 0) li_l[r32] = l_reg; asm volatile("s_waitcnt lgkmcnt(0)" ::: "memory");
  float rli[16];
#pragma unroll
  for (int r = 0; r < 16; ++r) rli[r] = __builtin_amdgcn_rcpf(li_l[crow(r, hi)]);
  bf16_t* Ow = Ob + (long)(wid * QBLK) * LDO;
#pragma unroll
  for (int r = 0; r < 16; ++r) { const int orow = crow(r, hi);
#pragma unroll
    for (int d0 = 0; d0 < 4; ++d0) Ow[(long)orow * LDO + d0 * 32 + r32] = (bf16_t)f2bf(o[d0][r] * rli[r]); }
  __syncthreads();
#undef SLOAD
#undef GLD
#undef SWRITE
#undef SWAIT
#undef RESC
}
#undef KSWZ
#undef RSWZ
#undef SBAR
}
struct Args { const float* in[N_IN]; float* out; unsigned char* ws; int ph_lo, ph_hi, bli, pad; };
struct Frame {
    LAS unsigned char* lds;
    volatile LAS unsigned* MISC;
    gu32* ctl;
    int tid, lane, wave, bid, G, gw, NGW;
    GAS unsigned char* ws;
};
#define WSP(T, off) ((T*)(GAS T*)(F.ws + (off)))
constexpr int PTR_OFF = LDSCTL_OFF + 1024;
__device__ __forceinline__ const float* inp(const Frame& F, int i) {
    int z = 0; asm volatile("" : "+s"(z));
    const LAS unsigned* t = (const LAS unsigned*)(F.lds + PTR_OFF + z) + 2 * i;
    const unsigned lo = __builtin_amdgcn_readfirstlane(t[0]), hi = __builtin_amdgcn_readfirstlane(t[1]);
    return (const float*)(GAS const float*)(((unsigned long long)hi << 32) | lo);
}
#define INP(i) inp(F, (i))
__device__ __forceinline__ bool phase_fence(Frame& F) { asm volatile("" : "+s"(F.ws), "+s"(F.ctl), "+s"(F.G), "+s"(F.bid), "+s"(F.wave));
    F.tid = opaque_tid(F.wave); F.lane = F.tid & 63; F.gw = F.bid * NWAVES + F.wave; F.NGW = F.G * NWAVES; return true; }

__device__ __forceinline__ void row_bj(int r, int& b, int& j) { b = r / TPB; j = r - b * TPB; }
__device__ __forceinline__ const float* mod_ptr(const Frame& F, int layer, int mrow, int which) { return WSP(const float, WS_MOD) + ((size_t)(layer * 9 + mrow) * NMOD + which) * D; }

__device__ __forceinline__ void ld_row_f32(const float* p, int lane, f32x4 (&v)[4]) {
#pragma unroll
    for (int j = 0; j < 4; ++j) v[j] = ((const f32x4*)p)[lane + 64 * j];
}
__device__ __forceinline__ void st_row_f32(float* p, int lane, const f32x4 (&v)[4]) {
#pragma unroll
    for (int j = 0; j < 4; ++j) ((f32x4*)p)[lane + 64 * j] = v[j];
}
__device__ __forceinline__ void ld_row_bf16(const bf16_t* p, int lane, f32x4 (&v)[4]) {
#pragma unroll
    for (int j = 0; j < 4; ++j) { const v2u w = ((const v2u*)p)[lane + 64 * j]; v[j] = (f32x4){bflo(w.x), bfhi(w.x), bflo(w.y), bfhi(w.y)}; }
}
__device__ __forceinline__ void st_row_bf16(bf16_t* p, int lane, const f32x4 (&v)[4]) {
#pragma unroll
    for (int j = 0; j < 4; ++j) { v2u w; w.x = pk2(v[j].x, v[j].y); w.y = pk2(v[j].z, v[j].w); ((v2u*)p)[lane + 64 * j] = w; }
}
__device__ __forceinline__ void rms_mod(f32x4 (&v)[4], int lane, const float* gain, const float* shift, const float* scale) {
    float ss = 0.f;
#pragma unroll
    for (int j = 0; j < 4; ++j) ss += (v[j].x * v[j].x + v[j].y * v[j].y) + (v[j].z * v[j].z + v[j].w * v[j].w);
    const float rs = rsqrtf(wave_sum(ss) * (1.f / D) + NORM_EPS);
#pragma unroll
    for (int j = 0; j < 4; ++j) {
        const f32x4 g = ((const f32x4*)gain)[lane + 64 * j], sh = ((const f32x4*)shift)[lane + 64 * j], sc = ((const f32x4*)scale)[lane + 64 * j];
        v[j] = (v[j] * rs) * g * (sc + 1.f) + sh;
    }
}

__device__ __forceinline__ void p0_transpose_item(const float* W, int K, int N, bf16_t* WT, int ld, LAS float* scr, int item, int lane) {
    const int nblk = N / 32, kb = item / nblk, nb = item - kb * nblk, k0 = 64 * kb, n0 = 32 * nb;
#pragma unroll 8
    for (int i = 0; i < 32; ++i) { const int kk = 2 * i + (lane >> 5); scr[kk * 33 + (lane & 31)] = (k0 + kk < K) ? W[(size_t)(k0 + kk) * N + n0 + (lane & 31)] : 0.f; }
    LDS_WAIT(); asm volatile("" ::: "memory");
    const int c = lane & 7;
    if (k0 + 8 * c < K) {
#pragma unroll
        for (int j = 0; j < 4; ++j) { const int n = (lane >> 3) + 8 * j; const LAS float* s = scr + (8 * c) * 33 + n;
            v4u o; o.x = pk2(s[0 * 33], s[1 * 33]); o.y = pk2(s[2 * 33], s[3 * 33]); o.z = pk2(s[4 * 33], s[5 * 33]); o.w = pk2(s[6 * 33], s[7 * 33]);
            *(GAS v4u*)(WT + (size_t)(n0 + n) * ld + k0 + 8 * c) = o; }
    }
    LDS_WAIT(); asm volatile("" ::: "memory");
}
__device__ __forceinline__ void p0_transpose_item64(const float* W, int N, bf16_t* WT, int ld, LAS float* scr, int kb, int nb, int lane) {
    const int k0 = 64 * kb, n0 = 64 * nb, lr = lane >> 4, lc = 4 * (lane & 15);
    const float* src = W + (size_t)(k0 + lr) * N + n0 + lc;
    f32x4 v[16];
#pragma unroll
    for (int q = 0; q < 16; ++q) v[q] = __builtin_nontemporal_load((const f32x4*)(src + (size_t)(4 * q) * N));
#pragma unroll
    for (int q = 0; q < 16; ++q) *(LAS f32x4*)(scr + (4 * q + lr) * 68 + lc) = v[q];
    LDS_WAIT(); asm volatile("" ::: "memory");
    const int ln = lane >> 3, kc = lane & 7;
#pragma unroll
    for (int rr = 0; rr < 8; ++rr) { const int n = 8 * rr + ln; const LAS float* s = scr + (8 * kc) * 68 + n;
        v4u o; o.x = pk2(s[0 * 68], s[1 * 68]); o.y = pk2(s[2 * 68], s[3 * 68]); o.z = pk2(s[4 * 68], s[5 * 68]); o.w = pk2(s[6 * 68], s[7 * 68]);
        *(GAS v4u*)(WT + (size_t)(n0 + n) * ld + k0 + 8 * kc) = o; }
    LDS_WAIT(); asm volatile("" ::: "memory");
}
struct TJob { int in_idx; unsigned src_off; int K, N; unsigned long long dst_off; int ld; int count; unsigned src_stride; unsigned dst_stride; };
constexpr unsigned long long SWE(int e, size_t o) { return WS_SMALLW + SW_EV + (size_t)e * EV_BYTES + o; }
constexpr unsigned long long SWO(int j, size_t o) { return WS_SMALLW + SW_OD + (size_t)j * OD_BYTES + o; }
constexpr int NJOBS = 33;
__device__ const TJob g_jobs[NJOBS] = {
    {I_MOE_W1, 0, 1024, 2048, WS_W1T, 1024, 128, 1024u * 2048u, 2048u * 1024u},
    {I_MOE_W2, 0, 1024, 1024, WS_W2T, 1024, 128, 1024u * 1024u, 1024u * 1024u},
    {I_ATTN_W_IN, 0, 1024, 1728, SWE(0, EV_WIN), 1024, 2, 1024u * 1728u, (unsigned)(EV_BYTES / 2)},
    {I_MLA_W_UQ, 0, 384, 768, SWE(0, EV_WUQ), 384, 2, 384u * 768u, (unsigned)(EV_BYTES / 2)},
    {I_MLA_W_UKV, 0, 256, 1024, SWE(0, EV_WUKV), 256, 2, 256u * 1024u, (unsigned)(EV_BYTES / 2)},
    {I_ATTN_W_OUT, 0, 1024, 1024, SWE(0, EV_WOUT), 1024, 2, 1024u * 1024u, (unsigned)(EV_BYTES / 2)},
    {I_RWKV_W_R, 0, 1024, 1024, SWO(0, OD_WR), 1024, 2, 1024u * 1024u, (unsigned)(OD_BYTES / 2)},
    {I_RWKV_W_K, 0, 1024, 1024, SWO(0, OD_WK), 1024, 2, 1024u * 1024u, (unsigned)(OD_BYTES / 2)},
    {I_RWKV_W_V, 0, 1024, 1024, SWO(0, OD_WV), 1024, 2, 1024u * 1024u, (unsigned)(OD_BYTES / 2)},
    {I_RWKV_W_O, 0, 1024, 1024, SWO(0, OD_WO), 1024, 2, 1024u * 1024u, (unsigned)(OD_BYTES / 2)},
    {I_RWKV_W1, 0 * 65536u, 1024, 64, SWO(0, OD_W1C) + 0 * 64 * 2048, 1024, 1, 0, 0},
    {I_RWKV_W1, 1 * 65536u, 1024, 64, SWO(0, OD_W1C) + 1 * 64 * 2048, 1024, 1, 0, 0},
    {I_RWKV_W1, 2 * 65536u, 1024, 64, SWO(1, OD_W1C) + 0 * 64 * 2048, 1024, 1, 0, 0},
    {I_RWKV_W1, 3 * 65536u, 1024, 64, SWO(1, OD_W1C) + 1 * 64 * 2048, 1024, 1, 0, 0},
    {I_RWKV_A1, 0 * 65536u, 1024, 64, SWO(0, OD_A1C) + 0 * 64 * 2048, 1024, 1, 0, 0},
    {I_RWKV_A1, 1 * 65536u, 1024, 64, SWO(0, OD_A1C) + 1 * 64 * 2048, 1024, 1, 0, 0},
    {I_RWKV_A1, 2 * 65536u, 1024, 64, SWO(1, OD_A1C) + 0 * 64 * 2048, 1024, 1, 0, 0},
    {I_RWKV_A1, 3 * 65536u, 1024, 64, SWO(1, OD_A1C) + 1 * 64 * 2048, 1024, 1, 0, 0},
    {I_RWKV_G1, 0, 1024, 128, SWO(0, OD_G1), 1024, 2, 1024u * 128u, (unsigned)(OD_BYTES / 2)},
    {I_RWKV_V1, 0, 1024, 32, SWO(1, OD_V1), 1024, 1, 0, 0},
    {I_RWKV_W2, 0 * 65536u, 64, 1024, SWO(0, OD_W2C) + (0 * 1024 * 128 + 0 * 64) * 2, 128, 1, 0, 0},
    {I_RWKV_W2, 1 * 65536u, 64, 1024, SWO(0, OD_W2C) + (1 * 1024 * 128 + 1 * 64) * 2, 128, 1, 0, 0},
    {I_RWKV_W2, 2 * 65536u, 64, 1024, SWO(1, OD_W2C) + (0 * 1024 * 128 + 0 * 64) * 2, 128, 1, 0, 0},
    {I_RWKV_W2, 3 * 65536u, 64, 1024, SWO(1, OD_W2C) + (1 * 1024 * 128 + 1 * 64) * 2, 128, 1, 0, 0},
    {I_RWKV_A2, 0 * 65536u, 64, 1024, SWO(0, OD_A2C) + (0 * 1024 * 128 + 0 * 64) * 2, 128, 1, 0, 0},
    {I_RWKV_A2, 1 * 65536u, 64, 1024, SWO(0, OD_A2C) + (1 * 1024 * 128 + 1 * 64) * 2, 128, 1, 0, 0},
    {I_RWKV_A2, 2 * 65536u, 64, 1024, SWO(1, OD_A2C) + (0 * 1024 * 128 + 0 * 64) * 2, 128, 1, 0, 0},
    {I_RWKV_A2, 3 * 65536u, 64, 1024, SWO(1, OD_A2C) + (1 * 1024 * 128 + 1 * 64) * 2, 128, 1, 0, 0},
    {I_RWKV_G2, 0, 128, 1024, SWO(0, OD_G2), 128, 2, 128u * 1024u, (unsigned)(OD_BYTES / 2)},
    {I_RWKV_V2, 0, 32, 1024, SWO(1, OD_V2), 128, 1, 0, 0},
    {I_MOE_ROUTER_W, 0, 1024, 32, WS_SMALLW + SW_RT, 1024, 4, 1024u * 32u, (unsigned)(RT_BYTES / 2)},
    {-1, 0, 64, 32, 0, 0, 0, 0, 0},
    {-1, 0, 64, 32, 0, 0, 0, 0, 0},
};
__device__ __forceinline__ bool job_fast(const TJob& j) { return (j.K % 64 == 0) && (j.N % 64 == 0); }
__device__ __forceinline__ int job_per(const TJob& j) { return job_fast(j) ? (j.K / 64) * (j.N / 64) : ((j.K + 63) / 64) * (j.N / 32); }
__device__ __forceinline__ int job_items(const TJob& j) { return j.count * job_per(j); }

struct TItem { const float* W; bf16_t* WT; int K, N, ld, item; bool fast; };
__device__ __forceinline__ TItem p0_decode(const Frame& F, int jlo, int it) {
    int r = it, j = jlo;
    for (;; ++j) { if (g_jobs[j].in_idx < 0) continue; const int n = job_items(g_jobs[j]); if (r < n) break; r -= n; }
    const TJob jb = g_jobs[j];
    const int per = job_per(jb), mi = r / per;
    TItem t; t.W = INP(jb.in_idx) + jb.src_off + (size_t)mi * jb.src_stride; t.WT = (bf16_t*)(GAS bf16_t*)(F.ws + jb.dst_off) + (size_t)mi * jb.dst_stride; t.K = jb.K; t.N = jb.N; t.ld = jb.ld; t.item = r - mi * per; t.fast = job_fast(jb);
    return t;
}
__device__ __forceinline__ void p0_load64(const TItem& t, int lane, f32x4 (&v)[16]) {
    const int nblk = t.N / 64, kb = t.item / nblk, nb = t.item - kb * nblk;
    const float* src = t.W + (size_t)(64 * kb + (lane >> 4)) * t.N + 64 * nb + 4 * (lane & 15);
#pragma unroll
    for (int q = 0; q < 16; ++q) v[q] = __builtin_nontemporal_load((const f32x4*)(src + (size_t)(4 * q) * t.N));
}
__device__ __forceinline__ void p0_finish64(const TItem& t, int lane, const f32x4 (&v)[16], LAS float* scr) {
    const int nblk = t.N / 64, kb = t.item / nblk, nb = t.item - kb * nblk, k0 = 64 * kb, n0 = 64 * nb, lr = lane >> 4, lc = 4 * (lane & 15);
#pragma unroll
    for (int q = 0; q < 16; ++q) *(LAS f32x4*)(scr + (4 * q + lr) * 68 + lc) = v[q];
    LDS_WAIT(); asm volatile("" ::: "memory");
    const int ln = lane >> 3, kc = lane & 7;
#pragma unroll
    for (int rr = 0; rr < 8; ++rr) { const int n = 8 * rr + ln; const LAS float* s = scr + (8 * kc) * 68 + n;
        v4u o; o.x = pk2(s[0 * 68], s[1 * 68]); o.y = pk2(s[2 * 68], s[3 * 68]); o.z = pk2(s[4 * 68], s[5 * 68]); o.w = pk2(s[6 * 68], s[7 * 68]);
        __builtin_nontemporal_store(o, (GAS v4u*)(t.WT + (size_t)(n0 + n) * t.ld + k0 + 8 * kc)); }
    LDS_WAIT(); asm volatile("" ::: "memory");
}
__device__ __forceinline__ void p0_transposes_fast(Frame& F, int jlo, int jhi, int first, int stride) {
    LAS float* scr = (LAS float*)(F.lds + RING_OFF + F.wave * 17408);
    int total = 0;
    for (int j = jlo; j < jhi; ++j) if (g_jobs[j].in_idx >= 0) total += job_items(g_jobs[j]);
    if (first >= total) return;
    f32x4 va[16], vb[16];
    TItem ta = p0_decode(F, jlo, first), tb = ta; p0_load64(ta, F.lane, va);
    for (int it = first; it < total; it += 2 * stride) {
        const bool hb = it + stride < total, ha2 = it + 2 * stride < total;
        if (hb) { tb = p0_decode(F, jlo, it + stride); p0_load64(tb, F.lane, vb); }
        p0_finish64(ta, F.lane, va, scr);
        if (ha2) { ta = p0_decode(F, jlo, it + 2 * stride); p0_load64(ta, F.lane, va); }
        if (hb) p0_finish64(tb, F.lane, vb, scr);
    }
}
__device__ __forceinline__ void p0_transposes(Frame& F, int jlo, int jhi, int first, int stride) {
    LAS float* scr = (LAS float*)(F.lds + RING_OFF + F.wave * 17408);
    int total = 0;
    for (int j = jlo; j < jhi; ++j) if (g_jobs[j].in_idx >= 0) total += job_items(g_jobs[j]);
    for (int it = first; it < total; it += stride) {
        const TItem t = p0_decode(F, jlo, it);
        if (t.fast) { const int nblk = t.N / 64; p0_transpose_item64(t.W, t.N, t.WT, t.ld, scr, t.item / nblk, t.item % nblk, F.lane); }
        else p0_transpose_item(t.W, t.K, t.N, t.WT, t.ld, scr, t.item, F.lane);
    }
}
__device__ __forceinline__ void p0_prologue(Frame& F, const Args& args) {
    {
        LAS float* Ssil = (LAS float*)(F.lds + RING_OFF);
        LAS float* Part = (LAS float*)(F.lds + RING_OFF + 40960);
        bool have = false;
        for (int it = F.bid; it < 96; it += F.G) {
            if (!have) {
                for (int idx = F.tid; idx < 9 * 1024; idx += NTHREADS) { const int r = idx >> 10, k = idx & 1023; const float cv = (r < 8) ? INP(I_C)[r * 1024 + k] : INP(I_CCTX)[k]; Ssil[idx] = siluf_(cv); }
                __syncthreads(); have = true;
            }
            const int l = it / 24, n0 = (it % 24) * 256;
            const float* Wb = INP(I_ADA_W) + (size_t)l * 1024 * 6144 + n0 + 4 * F.lane;
            f32x4 acc[9];
#pragma unroll
            for (int r = 0; r < 9; ++r) acc[r] = (f32x4){0.f, 0.f, 0.f, 0.f};
            const int kb = F.wave * 128;
            for (int k = 0; k < 128; k += 8) {
                f32x4 wv[8];
#pragma unroll
                for (int u = 0; u < 8; ++u) wv[u] = *(const f32x4*)(Wb + (size_t)(kb + k + u) * 6144);
#pragma unroll
                for (int u = 0; u < 8; ++u)
#pragma unroll
                    for (int r = 0; r < 9; ++r) acc[r] = acc[r] + wv[u] * Ssil[r * 1024 + kb + k + u];
            }
#pragma unroll
            for (int r = 0; r < 9; ++r) *(LAS f32x4*)(Part + (F.wave * 9 + r) * 256 + 4 * F.lane) = acc[r];
            __syncthreads();
            for (int idx = F.tid; idx < 9 * 256; idx += NTHREADS) {
                const int r = idx >> 8, n = idx & 255; float s = INP(I_ADA_B)[l * 6144 + n0 + n];
#pragma unroll
                for (int w = 0; w < 8; ++w) s += Part[(w * 9 + r) * 256 + n];
                WSP(float, WS_MOD)[(size_t)(l * 9 + r) * 6144 + n0 + n] = s;
            }
            __syncthreads();
        }
        __syncthreads();
    }
    if (F.G > 2 * 96) { if (F.bid >= 96) p0_transposes(F, 2, NJOBS, (F.bid - 96) * NWAVES + F.wave, (F.G - 96) * NWAVES); }
    else p0_transposes(F, 2, NJOBS, F.gw, F.NGW);
}
__device__ __forceinline__ void p1_init(Frame& F, const Args& args) {
    const float* gain = INP(I_NORM_MIX);
    f32x4 raw[4];
#define P1_LOAD(r_) do { int b_, j_; row_bj((r_), b_, j_); const float* src_ = (j_ < CTXL) ? INP(I_CTX) + ((size_t)b_ * CTXL + j_) * D : INP(I_X) + ((size_t)b_ * SEQ + (j_ - CTXL)) * D; ld_row_f32(src_, F.lane, raw); } while (0)
    if (F.gw < M) P1_LOAD(F.gw);
    for (int r = F.gw; r < M; r += F.NGW) {
        int b, j; row_bj(r, b, j);
        f32x4 v[4];
#pragma unroll
        for (int q = 0; q < 4; ++q) v[q] = raw[q];
        asm volatile("" : "+v"(v[0]), "+v"(v[1]), "+v"(v[2]), "+v"(v[3]));
        if (r + F.NGW < M) P1_LOAD(r + F.NGW);
        st_row_bf16(WSP(bf16_t, WS_XR) + (size_t)r * D, F.lane, v);
        const int mrow = (j < CTXL) ? 8 : b;
        rms_mod(v, F.lane, gain, mod_ptr(F, 0, mrow, 0), mod_ptr(F, 0, mrow, 1));
        st_row_bf16(WSP(bf16_t, WS_HB) + (size_t)r * D, F.lane, v);
    }
#undef P1_LOAD
}
__device__ __forceinline__ void p_copy_out(Frame& F, const Args& args) {
    for (int r = F.gw; r < M; r += F.NGW) {
        int b, j; row_bj(r, b, j); if (j < CTXL) continue;
        f32x4 v[4]; ld_row_bf16(WSP(const bf16_t, WS_XR) + (size_t)r * D, F.lane, v);
        st_row_f32(((float*)INP(N_IN)) + ((size_t)b * SEQ + (j - CTXL)) * D, F.lane, v);
    }
}
struct SubGemm { const char* A; const char* Bt; int lda; int K; int ntn; int kind; };
template <int NS>
struct MultiOrder {
    SubGemm s[NS]; int ntn_total, nwg, G, c, submajor;
    __device__ __forceinline__ void init(int G_, int c_, int submajor_ = 0) { ntn_total = 0; submajor = submajor_;
#pragma unroll
        for (int i = 0; i < NS; ++i) ntn_total += s[i].ntn;
        nwg = NPANEL * ntn_total; G = G_; c = c_; }
    __device__ __forceinline__ bool next(int i, pg8::Unit& u) const {
        const long L = (long)i * G + c; if (L >= nwg) return false;
        int wgid = (int)L; { const int q = nwg / 8, r = nwg % 8, xcd = wgid % 8, off = wgid / 8; wgid = (xcd < r ? xcd * (q + 1) : r * (q + 1) + (xcd - r) * q) + off; }
        const char* A = s[0].A; const char* Bt = s[0].Bt; int lda = s[0].lda, K = s[0].K, kind = s[0].kind; int pm, pn;
        if (submajor) {
            int nN = s[0].ntn, base = 0, acc = NPANEL * s[0].ntn;
#pragma unroll
            for (int k = 1; k < NS; ++k) { const bool ge = wgid >= acc; A = ge ? s[k].A : A; Bt = ge ? s[k].Bt : Bt; lda = ge ? s[k].lda : lda; K = ge ? s[k].K : K; kind = ge ? s[k].kind : kind; nN = ge ? s[k].ntn : nN; base = ge ? acc : base; acc += NPANEL * s[k].ntn; }
            const int lid = wgid - base, nig = 8 * nN, gid = lid / nig, fm = gid * 8, gsz = (NPANEL - fm) < 8 ? (NPANEL - fm) : 8;
            pm = fm + ((lid % nig) % gsz); pn = (lid % nig) / gsz;
        } else {
            const int nig = 8 * ntn_total, gid = wgid / nig, fm = gid * 8, gsz = (NPANEL - fm) < 8 ? (NPANEL - fm) : 8;
            pm = fm + ((wgid % nig) % gsz); const int vpn = (wgid % nig) / gsz; pn = vpn; int base = 0;
#pragma unroll
            for (int k = 1; k < NS; ++k) { base += s[k - 1].ntn; const bool ge = vpn >= base; A = ge ? s[k].A : A; Bt = ge ? s[k].Bt : Bt; lda = ge ? s[k].lda : lda; K = ge ? s[k].K : K; kind = ge ? s[k].kind : kind; pn = ge ? vpn - base : pn; }
        }
        u.A = A; u.B = Bt + (size_t)pn * 256 * K * 2; u.lda = lda; u.K = K; u.pm = pm; u.pn = pn; u.kind = kind; u.e = 0; u.nrows = 256; u.ridx = nullptr;
        return true;
    }
};

__device__ __forceinline__ v4u pack8(f32x4 v0, f32x4 v1) { v4u w; w.x = pk2(v0[0], v0[1]); w.y = pk2(v0[2], v0[3]); w.z = pk2(v1[0], v1[1]); w.w = pk2(v1[2], v1[3]); return w; }
struct NoCtx {};
struct EpiStoreBf16 {
    typedef NoCtx Ctx;
    bf16_t* O; int ldc; int ncols;
    __device__ __forceinline__ void begin(Ctx&, const pg8::Unit&, int, int) const {}
    __device__ __forceinline__ void begin_half(Ctx&, const pg8::Unit&, int, int, int) const {}
    __device__ __forceinline__ void row8(const Ctx&, const pg8::Unit& u, int, int, int lrow, int lcol, f32x4 v0, f32x4 v1) const {
        const int col = u.pn * 256 + lcol; if (col >= ncols) return;
        *(v4u*)(O + (size_t)(u.pm * 256 + lrow) * ldc + col) = pack8(v0, v1);
    }
};
struct EpiStore2 {
    typedef NoCtx Ctx;
    bf16_t* O0; int ld0; bf16_t* O1; int ld1;
    __device__ __forceinline__ void begin(Ctx&, const pg8::Unit&, int, int) const {}
    __device__ __forceinline__ void begin_half(Ctx&, const pg8::Unit&, int, int, int) const {}
    __device__ __forceinline__ void row8(const Ctx&, const pg8::Unit& u, int, int, int lrow, int lcol, f32x4 v0, f32x4 v1) const {
        bf16_t* O = u.kind ? O1 : O0; const int ld = u.kind ? ld1 : ld0;
        *(v4u*)(O + (size_t)(u.pm * 256 + lrow) * ld + u.pn * 256 + lcol) = pack8(v0, v1);
    }
};
struct EpiResidual {
    struct Ctx { f32x4 g[2][2]; v4u x[8][2]; };
    bf16_t* XR; const float* mod_base;
    __device__ __forceinline__ void begin(Ctx& c, const pg8::Unit& u, int lrow0, int lcol0) const {
        const int b = u.pm / 17, mrow = (u.pm - b * 17 == 0) ? 8 : b;
        const float* g = mod_base + (size_t)mrow * 6144 + u.pn * 256 + lcol0;
#pragma unroll
        for (int bj = 0; bj < 2; ++bj) { c.g[bj][0] = *(const f32x4*)(g + bj * 128); c.g[bj][1] = *(const f32x4*)(g + bj * 128 + 4); }
#pragma unroll
        for (int ai = 0; ai < 2; ++ai) {
            const bf16_t* x = XR + (size_t)(u.pm * 256 + lrow0 + ai * 128) * D + u.pn * 256 + lcol0;
#pragma unroll
            for (int m = 0; m < 4; ++m)
#pragma unroll
                for (int bj = 0; bj < 2; ++bj) c.x[ai * 4 + m][bj] = *(const v4u*)(x + (size_t)m * 16 * D + bj * 128); }
    }
    __device__ __forceinline__ void begin_half(Ctx&, const pg8::Unit&, int, int, int) const {}
    __device__ __forceinline__ void row8(const Ctx& c, const pg8::Unit& u, int slot, int bj, int lrow, int lcol, f32x4 v0, f32x4 v1) const {
        bf16_t* x = XR + (size_t)(u.pm * 256 + lrow) * D + u.pn * 256 + lcol; const v4u xo = c.x[slot][bj];
        const f32x4 x0 = (f32x4){bflo(xo.x), bfhi(xo.x), bflo(xo.y), bfhi(xo.y)}, x1 = (f32x4){bflo(xo.z), bfhi(xo.z), bflo(xo.w), bfhi(xo.w)};
        const f32x4 r0 = x0 + c.g[bj][0] * v0, r1 = x1 + c.g[bj][1] * v1;
        v4u w; w.x = pk2(r0[0], r0[1]); w.y = pk2(r0[2], r0[3]); w.z = pk2(r1[0], r1[1]); w.w = pk2(r1[2], r1[3]);
        *(v4u*)x = w;
    }
};
struct EpiRouter {
    struct Ctx { f32x4 b0, b1; };
    float* L; const float* bias;
    __device__ __forceinline__ void begin(Ctx& c, const pg8::Unit&, int, int lcol0) const { const int lc = lcol0 < 32 ? lcol0 : 0; c.b0 = *(const f32x4*)(bias + lc); c.b1 = *(const f32x4*)(bias + lc + 4); }
    __device__ __forceinline__ void begin_half(Ctx&, const pg8::Unit&, int, int, int) const {}
    __device__ __forceinline__ void row8(const Ctx& c, const pg8::Unit& u, int, int, int lrow, int lcol, f32x4 v0, f32x4 v1) const {
        if (lcol >= 32) return;
        float* o = L + (size_t)(u.pm * 256 + lrow) * 32 + lcol;
        *(f32x4*)o = v0 + c.b0; *(f32x4*)(o + 4) = v1 + c.b1;
    }
};
struct MoeCtx { int orow[8]; f32x4 b[2][2]; };
__device__ __forceinline__ void moe_begin(MoeCtx& c, const pg8::Unit& u, int lrow0, int lcol0, const float* bias_e) {
#pragma unroll
    for (int s = 0; s < 8; ++s) { const int lr = lrow0 + (s >> 2) * 128 + (s & 3) * 16; c.orow[s] = (lr < u.nrows) ? u.ridx[lr] : -1; }
    const float* bb = bias_e + u.pn * 256 + lcol0;
#pragma unroll
    for (int bj = 0; bj < 2; ++bj) { c.b[bj][0] = *(const f32x4*)(bb + bj * 128); c.b[bj][1] = *(const f32x4*)(bb + bj * 128 + 4); }
}
__device__ __forceinline__ void moe_begin_pre(MoeCtx& c, const pg8::Unit& u, int lrow0, int lcol0, const LAS unsigned char* tab) {
#pragma unroll
    for (int s = 0; s < 8; ++s) { const int lr = lrow0 + (s >> 2) * 128 + (s & 3) * 16; const int v = ((const LAS int*)tab)[lr]; c.orow[s] = (lr < u.nrows) ? v : -1; }
    const LAS float* bb = (const LAS float*)(tab + 1024) + lcol0;
#pragma unroll
    for (int bj = 0; bj < 2; ++bj) { c.b[bj][0] = *(const LAS f32x4*)(bb + bj * 128); c.b[bj][1] = *(const LAS f32x4*)(bb + bj * 128 + 4); }
}
struct EpiSwiglu {
    typedef MoeCtx Ctx;
    bf16_t* ACT; const float* b1;
    __device__ __forceinline__ void begin(Ctx& c, const pg8::Unit& u, int lrow0, int lcol0) const { moe_begin(c, u, lrow0, lcol0, b1 + (size_t)u.e * 2048); }
    __device__ __forceinline__ const float* bias_of(const pg8::Unit& u) const { return b1 + (size_t)u.e * 2048 + u.pn * 256; }
    __device__ __forceinline__ void begin_pre(Ctx& c, const pg8::Unit& u, int lrow0, int lcol0, const LAS unsigned char* tab) const { moe_begin_pre(c, u, lrow0, lcol0, tab); }
    __device__ __forceinline__ void begin_half(Ctx&, const pg8::Unit&, int, int, int) const {}
    __device__ __forceinline__ void row8(const Ctx& c, const pg8::Unit& u, int slot, int bj, int, int lcol, f32x4 v0, f32x4 v1) const {
        const int orow = c.orow[slot]; if (orow < 0) return;
        const int col = u.pn * 256 + lcol;
        v0 = v0 + c.b[bj][0]; v1 = v1 + c.b[bj][1];
        float o[4];
#pragma unroll
        for (int p = 0; p < 4; ++p) {
            float g = (p < 2) ? v0[2 * p] : v1[2 * (p - 2)], l = (p < 2) ? v0[2 * p + 1] : v1[2 * (p - 2) + 1];
            g = fminf(g, 7.f); l = fminf(fmaxf(l, -7.f), 7.f);
            o[p] = g * sigmoidf_(1.702f * g) * (l + 1.f);
        }
        v2u w; w.x = pk2(o[0], o[1]); w.y = pk2(o[2], o[3]);
        *(v2u*)(ACT + (size_t)orow * FF + (col >> 1)) = w;
    }
};
struct EpiMoeDown {
    typedef MoeCtx Ctx;
    bf16_t* Y; const float* b2;
    __device__ __forceinline__ void begin(Ctx& c, const pg8::Unit& u, int lrow0, int lcol0) const { moe_begin(c, u, lrow0, lcol0, b2 + (size_t)u.e * 1024); }
    __device__ __forceinline__ const float* bias_of(const pg8::Unit& u) const { return b2 + (size_t)u.e * 1024 + u.pn * 256; }
    __device__ __forceinline__ void begin_pre(Ctx& c, const pg8::Unit& u, int lrow0, int lcol0, const LAS unsigned char* tab) const { moe_begin_pre(c, u, lrow0, lcol0, tab); }
    __device__ __forceinline__ void begin_half(Ctx&, const pg8::Unit&, int, int, int) const {}
    __device__ __forceinline__ void row8(const Ctx& c, const pg8::Unit& u, int slot, int bj, int, int lcol, f32x4 v0, f32x4 v1) const {
        const int orow = c.orow[slot]; if (orow < 0) return;
        *(v4u*)(Y + (size_t)orow * D + u.pn * 256 + lcol) = pack8(v0 + c.b[bj][0], v1 + c.b[bj][1]);
    }
};

__device__ __forceinline__ void rope_pair(float& v, int lane, int half  , float cs, float sn) {
    const unsigned x_ = __builtin_bit_cast(unsigned, v);
    float p;
    if (half == 16) { const auto r_ = __builtin_amdgcn_permlane16_swap(x_, x_, false, false); p = __builtin_bit_cast(float, (unsigned)((lane & 16) ? r_[0] : r_[1])); }
    else { const auto r_ = __builtin_amdgcn_permlane32_swap(x_, x_, false, false); p = __builtin_bit_cast(float, (unsigned)((lane & 32) ? r_[0] : r_[1])); }
    v = ((lane & half) == 0) ? (v * cs - p * sn) : (v * cs + p * sn);
}
__device__ __forceinline__ void pA2_proj_norms(Frame& F, const Args& args, int e) {
    const float* q_norm = INP(I_MLA_Q_NORM) + e * 384; const float* kv_norm = INP(I_MLA_KV_NORM) + e * 256; const float* kr_g = INP(I_MLA_KR_G) + e * 64;
    const float* gq_g = INP(I_GQA_Q_G) + e * 128; const float* gk_g = INP(I_GQA_K_G) + e * 128;
    const int lane = F.lane;
    float gqn[6], gkvn[4];
#pragma unroll
    for (int g = 0; g < 6; ++g) gqn[g] = q_norm[64 * g + lane];
#pragma unroll
    for (int g = 0; g < 4; ++g) gkvn[g] = kv_norm[64 * g + lane];
    const float gkr = kr_g[lane], gq0 = gq_g[lane], gq1 = gq_g[64 + lane], gk0 = gk_g[lane], gk1 = gk_g[64 + lane];
    const float LOG2_THETA = 13.287712379549449f;
    const float ifm = __builtin_amdgcn_exp2f(-(float)(2 * (lane & 15)) * (1.f / 32.f) * LOG2_THETA);
    const float ifg = __builtin_amdgcn_exp2f(-(float)(2 * (lane & 31)) * (1.f / 64.f) * LOG2_THETA);
    unsigned short raw[23];
#define A2_LOAD(r_) do { const bf16_t* p_ = WSP(const bf16_t, WS_PROJ) + (size_t)(r_) * PROJ_LD; _Pragma("unroll") for (int g = 0; g < 23; ++g) raw[g] = p_[64 * g + lane]; } while (0)
    if (F.gw < M) A2_LOAD(F.gw);
    for (int r = F.gw; r < M; r += F.NGW) {
        int b, j; row_bj(r, b, j);
        bf16_t* p = WSP(bf16_t, WS_PROJ) + (size_t)r * PROJ_LD;
        float v[23];
#pragma unroll
        for (int g = 0; g < 23; ++g) v[g] = bf2f(raw[g]);
        if (r + F.NGW < M) A2_LOAD(r + F.NGW);
        const bool lat = j >= CTXL; const int t = j - CTXL; const float prow = (float)(t >> 6), pcol = (float)(t & 63);
        { float ss = 0.f;
#pragma unroll
          for (int g = 0; g < 6; ++g) ss += v[g] * v[g];
          const float rs = rsqrtf(wave_sum(ss) * (1.f / 384.f) + NORM_EPS);
#pragma unroll
          for (int g = 0; g < 6; ++g) v[g] = v[g] * rs * gqn[g]; }
        { float ss = 0.f;
#pragma unroll
          for (int g = 0; g < 4; ++g) ss += v[6 + g] * v[6 + g];
          const float rs = rsqrtf(wave_sum(ss) * (1.f / 256.f) + NORM_EPS);
#pragma unroll
          for (int g = 0; g < 4; ++g) v[6 + g] = v[6 + g] * rs * gkvn[g]; }
        { const float rs = rsqrtf(wave_sum(v[10] * v[10]) * (1.f / 64.f) + NORM_EPS); v[10] = v[10] * rs * gkr;
          if (lat) { const float ang = ((lane < 32) ? prow : pcol) * ifm; rope_pair(v[10], lane, 16, __cosf(ang), __sinf(ang)); } }
        float c0 = 1.f, s0 = 0.f, c1 = 1.f, s1 = 0.f;
        if (lat) { const float a0 = prow * ifg, a1 = pcol * ifg; c0 = __cosf(a0); s0 = __sinf(a0); c1 = __cosf(a1); s1 = __sinf(a1); }
#pragma unroll
        for (int h = 0; h < 6; ++h) {
            const int g0 = 11 + 2 * h; const float w0 = (h < 4) ? gq0 : gk0, w1 = (h < 4) ? gq1 : gk1;
            const float rs = rsqrtf(wave_sum(v[g0] * v[g0] + v[g0 + 1] * v[g0 + 1]) * (1.f / 128.f) + NORM_EPS);
            v[g0] = v[g0] * rs * w0; v[g0 + 1] = v[g0 + 1] * rs * w1;
            if (lat) { rope_pair(v[g0], lane, 32, c0, s0); rope_pair(v[g0 + 1], lane, 32, c1, s1); }
        }
#pragma unroll
        for (int g = 0; g < 23; ++g) p[64 * g + lane] = (bf16_t)f2bf(v[g]);
    }
#undef A2_LOAD
}
__device__ __forceinline__ void pA4_mla_norms(Frame& F, const Args& args, int e) {
    const float* qn_g = INP(I_MLA_QN_G) + e * 128; const float* qr_g = INP(I_MLA_QR_G) + e * 64; const float* kn_g = INP(I_MLA_KN_G) + e * 128;
    const int lane = F.lane;
    const float qn0 = qn_g[lane], qn1 = qn_g[64 + lane], qr = qr_g[lane], kn0 = kn_g[lane], kn1 = kn_g[64 + lane];
    const float LOG2_THETA = 13.287712379549449f;
    const float ifm = __builtin_amdgcn_exp2f(-(float)(2 * (lane & 15)) * (1.f / 32.f) * LOG2_THETA);
    unsigned short rq[12], rk[8];
#define A4_LOAD(r_) do { const bf16_t* q_ = WSP(const bf16_t, WS_QM) + (size_t)(r_) * 768; const bf16_t* kv_ = WSP(const bf16_t, WS_KVM) + (size_t)(r_) * 1024; \
        _Pragma("unroll") for (int g = 0; g < 12; ++g) rq[g] = q_[64 * g + lane]; _Pragma("unroll") for (int h = 0; h < 4; ++h) { rk[2 * h] = kv_[256 * h + lane]; rk[2 * h + 1] = kv_[256 * h + 64 + lane]; } } while (0)
    if (F.gw < M) A4_LOAD(F.gw);
    for (int r = F.gw; r < M; r += F.NGW) {
        int b, j; row_bj(r, b, j);
        const bool lat = j >= CTXL; const int t = j - CTXL;
        float cs = 1.f, sn = 0.f;
        if (lat) { const float ang = ((lane < 32) ? (float)(t >> 6) : (float)(t & 63)) * ifm; cs = __cosf(ang); sn = __sinf(ang); }
        bf16_t* q = WSP(bf16_t, WS_QM) + (size_t)r * 768;
        bf16_t* kv = WSP(bf16_t, WS_KVM) + (size_t)r * 1024;
        float vq[12], vk[8];
#pragma unroll
        for (int g = 0; g < 12; ++g) vq[g] = bf2f(rq[g]);
#pragma unroll
        for (int h = 0; h < 8; ++h) vk[h] = bf2f(rk[h]);
        if (r + F.NGW < M) A4_LOAD(r + F.NGW);
#pragma unroll
        for (int h = 0; h < 4; ++h) {
            float rs = rsqrtf(wave_sum(vq[3 * h] * vq[3 * h] + vq[3 * h + 1] * vq[3 * h + 1]) * (1.f / 128.f) + NORM_EPS);
            vq[3 * h] = vq[3 * h] * rs * qn0; vq[3 * h + 1] = vq[3 * h + 1] * rs * qn1;
            rs = rsqrtf(wave_sum(vq[3 * h + 2] * vq[3 * h + 2]) * (1.f / 64.f) + NORM_EPS);
            vq[3 * h + 2] = vq[3 * h + 2] * rs * qr;
            if (lat) rope_pair(vq[3 * h + 2], lane, 16, cs, sn);
            rs = rsqrtf(wave_sum(vk[2 * h] * vk[2 * h] + vk[2 * h + 1] * vk[2 * h + 1]) * (1.f / 128.f) + NORM_EPS);
            vk[2 * h] = vk[2 * h] * rs * kn0; vk[2 * h + 1] = vk[2 * h + 1] * rs * kn1;
        }
#pragma unroll
        for (int g = 0; g < 12; ++g) q[64 * g + lane] = (bf16_t)f2bf(vq[g]);
#pragma unroll
        for (int h = 0; h < 4; ++h) { kv[256 * h + lane] = (bf16_t)f2bf(vk[2 * h]); kv[256 * h + 64 + lane] = (bf16_t)f2bf(vk[2 * h + 1]); }
    }
#undef A4_LOAD
}
template <bool MLA>
__device__ __forceinline__ void attn_one(Frame& F, int b, int h, int qb) {
    static_assert(att::ATTN_LDS <= RING_BYTES, "attention LDS");
    char* lds = (char*)(F.lds + RING_OFF);
    const bf16_t* PROJ = WSP(const bf16_t, WS_PROJ); bf16_t* OB = WSP(bf16_t, WS_OB);
    const size_t row0 = (size_t)b * TPB + (size_t)qb * 256, krow0 = (size_t)b * TPB; const int seq = qb ? TPB : CTXL;
    if constexpr (MLA) { const bf16_t* QM = WSP(const bf16_t, WS_QM); const bf16_t* KVM = WSP(const bf16_t, WS_KVM);
        att::attn_unit<192, 1, 8, 768, 1024, PROJ_LD, 1024, D>(QM + row0 * 768 + 192 * h, KVM + krow0 * 1024 + 256 * h, PROJ + krow0 * PROJ_LD + C_ZR,
                                          KVM + krow0 * 1024 + 256 * h + 128, OB + row0 * D + 128 * h, seq, lds, F.wave);
    } else { const int g = h - 4, kvh = g >> 1;
        att::attn_unit<128, 1, 8, PROJ_LD, PROJ_LD, PROJ_LD, PROJ_LD, D>(PROJ + row0 * PROJ_LD + C_GQ + 128 * g, PROJ + krow0 * PROJ_LD + C_GK + 128 * kvh, nullptr,
                                      PROJ + krow0 * PROJ_LD + C_GV + 128 * kvh, OB + row0 * D + 512 + 128 * g, seq, lds, F.wave); }
}
__device__ __forceinline__ void moe_convert_share(Frame& F, bool doit) {
    if (!doit) return;
    p0_transposes_fast(F, 0, 2, F.gw, F.NGW);
    __syncthreads();
}
template <bool MLA>
__device__ __forceinline__ void pA5_attention_half(Frame& F, int conv_phase  ) {
    const int x = F.bid & 7, lc = F.bid >> 3;
    const int nunits = NB * 4 * 17, niter = (F.G == 256) ? 3 : (nunits + F.G - 1) / F.G;
#pragma unroll 1
    for (int i = 0; i < niter; ++i) {
        if (i < 2) moe_convert_share(F, conv_phase == (MLA ? 0 : 3) + i);
        int b, h, qb;
        if (F.G == 256) { b = x; if (i < 2) { h = 2 * i + (lc >> 4); qb = 1 + (lc & 15); } else { if (lc >= 4) break; h = lc; qb = 0; } }
        else { const int u = i * F.G + F.bid; if (u >= nunits) break; b = u / (4 * 17); h = (u / 17) % 4; qb = u % 17; }
        attn_one<MLA>(F, b, (MLA ? 0 : 4) + h, qb);
    }
}
__device__ __forceinline__ void pA5_attention(Frame& F, bool convert) {
    const int cp = convert ? (F.bid % 5) : -1;
    pA5_attention_half<true>(F, cp); moe_convert_share(F, cp == 2); pA5_attention_half<false>(F, cp);
#ifdef MK_PROBE_REP_MLA
    pA5_attention_half<true>(F, -1);
#endif
#ifdef MK_PROBE_REP_GQA
    pA5_attention_half<false>(F, -1);
#endif
}
__device__ __forceinline__ void pF1_ffn_norm(Frame& F, const Args& args, int layer) {
    const float* gain = INP(I_NORM_FFN) + layer * D;
    for (int r = F.gw; r < M; r += F.NGW) {
        int b, j; row_bj(r, b, j); const int mrow = (j < CTXL) ? 8 : b;
        f32x4 v[4]; ld_row_bf16(WSP(const bf16_t, WS_XR) + (size_t)r * D, F.lane, v);
        rms_mod(v, F.lane, gain, mod_ptr(F, layer, mrow, 3), mod_ptr(F, layer, mrow, 4));
        st_row_bf16(WSP(bf16_t, WS_HB) + (size_t)r * D, F.lane, v);
    }
}
__device__ __forceinline__ void route_lane_tokens(Frame& F, int layer, int r, bool valid, const float (&l)[32]);
__device__ __forceinline__ void pF1R_norm_router(Frame& F, const Args& args, int layer) {
    constexpr int RP = 2048 + 16;
    const LAS unsigned char* WR = F.lds + RING_OFF;
    LAS unsigned char* SL = F.lds + RING_OFF + 32 * RP + F.wave * (4 * RP);
    constexpr int RPW = 17;
    LAS float* LT = (LAS float*)(F.lds + RING_OFF + 32 * RP + NWAVES * 4 * RP);
    static_assert(32 * RP + NWAVES * 4 * RP + NWAVES * RPW * 32 * 4 <= RING_BYTES, "F1R LDS");
    const bool fused = (F.G * NWAVES * RPW >= M);
    { const bf16_t* wr = (const bf16_t*)(F.ws + WS_SMALLW + SW_RT + (size_t)layer * RT_BYTES);
      __syncthreads();
      for (int i = F.tid; i < 32 * 128; i += NTHREADS) { const int row = i >> 7, ch = i & 127; *(LAS v4u*)((LAS unsigned char*)WR + row * RP + ch * 16) = *(const v4u*)(wr + (size_t)row * 1024 + ch * 8); }
      __syncthreads(); }
    const float* gain = INP(I_NORM_FFN) + layer * D; const float* rb = INP(I_MOE_ROUTER_B) + layer * 32; float* LG = WSP(float, WS_LOGITS);
    const int lane = F.lane, l15 = lane & 15, g = lane >> 4;
    const float rb0 = rb[l15], rb1 = rb[16 + l15];
    int grp = 0;
    v2u raw[4][4];
#define F1R_LOAD(rb_) do { _Pragma("unroll") for (int i = 0; i < 4; ++i) { const int r = (rb_) + i * F.NGW; if (r < M) { _Pragma("unroll") for (int q = 0; q < 4; ++q) raw[i][q] = ((const v2u*)(WSP(const bf16_t, WS_XR) + (size_t)r * D))[lane + 64 * q]; } } } while (0)
    F1R_LOAD(F.gw);
    for (int r0 = F.gw; r0 < M; r0 += 4 * F.NGW, ++grp) {
        f32x4 v[4][4];
#pragma unroll
        for (int i = 0; i < 4; ++i)
#pragma unroll
            for (int q = 0; q < 4; ++q) v[i][q] = (f32x4){bflo(raw[i][q].x), bfhi(raw[i][q].x), bflo(raw[i][q].y), bfhi(raw[i][q].y)};
#pragma unroll
        for (int i = 0; i < 4; ++i) { const int r = r0 + i * F.NGW; if (r < M) {
            int b, j; row_bj(r, b, j); const int mrow = (j < CTXL) ? 8 : b;
            rms_mod(v[i], lane, gain, mod_ptr(F, layer, mrow, 3), mod_ptr(F, layer, mrow, 4));
#pragma unroll
            for (int q = 0; q < 4; ++q) { v2u w; w.x = pk2(v[i][q].x, v[i][q].y); w.y = pk2(v[i][q].z, v[i][q].w);
                ((v2u*)(WSP(bf16_t, WS_HB) + (size_t)r * D))[lane + 64 * q] = w; *(LAS v2u*)(SL + i * RP + (lane + 64 * q) * 8) = w; } } }
        if (r0 + 4 * F.NGW < M) F1R_LOAD(r0 + 4 * F.NGW);
        f32x4 acc0 = (f32x4){0.f, 0.f, 0.f, 0.f}, acc1 = acc0;
        const LAS unsigned char* ap = SL + (l15 & 3) * RP + g * 16; const LAS unsigned char* bp = WR + l15 * RP + g * 16;
#pragma unroll 8
        for (int s2 = 0; s2 < 32; ++s2) { const bf16x8 a = *(const LAS bf16x8*)(ap + s2 * 64), b0 = *(const LAS bf16x8*)(bp + s2 * 64), b1 = *(const LAS bf16x8*)(bp + 16 * RP + s2 * 64);
            acc0 = __builtin_amdgcn_mfma_f32_16x16x32_bf16(a, b0, acc0, 0, 0, 0); acc1 = __builtin_amdgcn_mfma_f32_16x16x32_bf16(a, b1, acc1, 0, 0, 0); }
        if (g == 0) {
#pragma unroll
            for (int i = 0; i < 4; ++i) { const int r = r0 + i * F.NGW; if (r < M) {
                if (fused) { LAS float* lt = LT + (F.wave * RPW + grp * 4 + i) * 32; lt[l15] = acc0[i] + rb0; lt[16 + l15] = acc1[i] + rb1; }
                else { LG[(size_t)r * 32 + l15] = acc0[i] + rb0; LG[(size_t)r * 32 + 16 + l15] = acc1[i] + rb1; } } } }
    }
#undef F1R_LOAD
    if (fused) {
        __syncthreads();
        if (F.wave < (NWAVES * RPW + 63) / 64) {
            const int t = F.wave * 64 + lane, w = t / RPW, idx = t - w * RPW, r = F.bid * NWAVES + w + idx * F.NGW;
            bool valid = (t < NWAVES * RPW) && (r < M);
            if (valid) { int b, j; row_bj(r, b, j); valid = !((layer == DEPTH - 1) && j < CTXL); }
            const LAS float* lt = LT + ((t < NWAVES * RPW) ? t : 0) * 32;
            float l[32];
#pragma unroll
            for (int q = 0; q < 8; ++q) { const f32x4 x = ((const LAS f32x4*)lt)[q]; l[4 * q] = x[0]; l[4 * q + 1] = x[1]; l[4 * q + 2] = x[2]; l[4 * q + 3] = x[3]; }
            route_lane_tokens(F, layer, r, valid, l);
        }
    }
}
__device__ __forceinline__ void route_lane_tokens(Frame& F, int layer, int r, bool valid, const float (&l)[32]) {
    float* TG = WSP(float, WS_TOPG); int* RI = WSP(int, WS_ROWIDX);
    unsigned* cnt = (unsigned*)(F.ctl + CW_ECNT + layer * 32 * 64);
    const int lane = F.lane;
    int sel[4]; float val[4]; unsigned used = 0u;
#pragma unroll
    for (int k = 0; k < 4; ++k) { float best = -3.0e38f; int bi = 0;
#pragma unroll
        for (int e = 0; e < 32; ++e) { const bool ok = !((used >> e) & 1u) && (l[e] > best); best = ok ? l[e] : best; bi = ok ? e : bi; }
        sel[k] = bi; val[k] = best; used |= 1u << bi; }
    float p[4], ps = 0.f;
#pragma unroll
    for (int k = 0; k < 4; ++k) { p[k] = __expf(val[k] - val[0]); ps += p[k]; }
    const float inv = 1.f / ps;
    int pre[4] = {0, 0, 0, 0}; unsigned mycnt = 0u;
    const unsigned long long below = (lane == 0) ? 0ull : (~0ull >> (64 - lane));
#pragma unroll
    for (int e = 0; e < 32; ++e) {
        const bool has = valid && ((used >> e) & 1u);
        const unsigned long long m = __ballot(has);
        const int c = __popcll(m), pf = __popcll(m & below);
        if (lane == e) mycnt = (unsigned)c;
#pragma unroll
        for (int k = 0; k < 4; ++k) if (sel[k] == e) pre[k] = pf;
    }
    unsigned base = 0u;
    if (lane < 32 && mycnt) base = __hip_atomic_fetch_add(cnt + lane * 64, mycnt, RLX_AGENT);
    unsigned be[4];
#pragma unroll
    for (int k = 0; k < 4; ++k) be[k] = (unsigned)lanes_get((int)base, sel[k]);
    if (valid) {
#pragma unroll
        for (int k = 0; k < 4; ++k) RI[(size_t)sel[k] * CAP + be[k] + pre[k]] = r * 4 + k;
        *(f32x4*)(TG + (size_t)r * 4) = (f32x4){p[0] * inv, p[1] * inv, p[2] * inv, p[3] * inv};
    }
}
__device__ __forceinline__ void pF3_route(Frame& F, int layer) {
    const float* LG = WSP(const float, WS_LOGITS);
    const int lane = F.lane; const bool lastl = (layer == DEPTH - 1);
    for (int t0 = F.gw * 64; t0 < M; t0 += F.NGW * 64) {
        const int r = t0 + lane; int b, j; row_bj(r, b, j);
        const bool valid = !(lastl && j < CTXL);
        float l[32];
#pragma unroll
        for (int q = 0; q < 8; ++q) { const f32x4 x = ((const f32x4*)(LG + (size_t)r * 32))[q]; l[4 * q] = x[0]; l[4 * q + 1] = x[1]; l[4 * q + 2] = x[2]; l[4 * q + 3] = x[3]; }
        route_lane_tokens(F, layer, r, valid, l);
    }
}
template <int NPN, int GM, int GSH>
struct MoeOrder {
    const LAS int* tb;
    const char* A; const char* W; const int* RI; int G, c, nwg;
    __device__ __forceinline__ bool next(int i, pg8::Unit& u) const {
        const long L = (long)i * G + c;
        int wgid = (int)L;
        if ((G & 7) == 0) {
            const int ng = nwg / (GM * NPN), qg = ng / 8, rg = ng % 8, xcd = wgid % 8, off = wgid / 8;
            const int ngx = qg + (xcd < rg ? 1 : 0), gs = (xcd < rg) ? xcd * (qg + 1) : rg * (qg + 1) + (xcd - rg) * qg;
            if (off >= ngx * (GM * NPN)) return false;
            wgid = gs * (GM * NPN) + off;
        } else {
            if (L >= nwg) return false;
            const int q = nwg / 8, r = nwg % 8, xcd = wgid % 8, off = wgid / 8; wgid = (xcd < r ? xcd * (q + 1) : r * (q + 1) + (xcd - r) * q) + off;
        }
        const int grp = wgid / (GM * NPN), l = wgid % (GM * NPN), mt = grp * GM + (l % GM), pn = l / GM;
        const int ln = lane_now() & 31;
        const int e = __popcll(__ballot(mt >= tb[ln]) & 0xffffffffull) - 1;
        const int total = tb[32];
        const int lt = mt - tb[e], cnt = tb[33 + e];
        u.A = A; u.B = W + ((size_t)e * NPN * 256 + (size_t)pn * 256) * 1024 * 2; u.lda = 2048; u.K = 1024; u.pm = mt; u.pn = pn; u.kind = 0; u.e = e;
        int nr = (mt < total) ? cnt - lt * 256 : 0; nr = nr > 256 ? 256 : nr; u.nrows = nr;
        u.ridx = RI + (size_t)e * CAP + (size_t)lt * 256;
        return true;
    }
};
__device__ __forceinline__ int moe_table(Frame& F, int layer) {
    int z = 0; asm volatile("" : "+s"(z));
    LAS int* tb = (LAS int*)(F.lds + LDSCTL_OFF + z);
    __syncthreads();
    if (F.wave == 0) {
        const int e = F.lane & 31;
        const int c = (int)__hip_atomic_load((unsigned*)(F.ctl + CW_ECNT + (layer * 32 + e) * 64), RLX_AGENT);
        const int t = (c + 255) >> 8; int incl = t;
#pragma unroll
        for (int o = 1; o < 32; o <<= 1) { const int v = lanes_get(incl, (lane_now() - o) & 63); if (e >= o) incl += v; }
        if (F.lane < 32) { tb[e] = incl - t; tb[33 + e] = c; if (e == 31) tb[32] = incl; }
    }
    __syncthreads();
    return tb[32];
}
__device__ __forceinline__ void pF6_combine(Frame& F, const Args& args, int layer) {
    const bool lastl = (layer == DEPTH - 1);
    const bf16_t* Y = WSP(const bf16_t, WS_YB); const float* TG = WSP(const float, WS_TOPG);
    v2u rx[4], ry[4][4]; f32x4 rg;
#define F6_LOAD(r_) do { _Pragma("unroll") for (int q = 0; q < 4; ++q) rx[q] = ((const v2u*)(WSP(const bf16_t, WS_XR) + (size_t)(r_) * D))[F.lane + 64 * q]; rg = *(const f32x4*)(TG + (size_t)(r_) * 4); \
        _Pragma("unroll") for (int k = 0; k < 4; ++k) _Pragma("unroll") for (int q = 0; q < 4; ++q) ry[k][q] = ((const v2u*)(Y + ((size_t)(r_) * 4 + k) * D))[F.lane + 64 * q]; } while (0)
    if (F.gw < M) F6_LOAD(F.gw);
    for (int r = F.gw; r < M; r += F.NGW) {
        int b, j; row_bj(r, b, j);
        const int mrow = (j < CTXL) ? 8 : b;
        f32x4 x[4], acc[4]; const f32x4 g = rg;
#pragma unroll
        for (int q = 0; q < 4; ++q) { x[q] = (f32x4){bflo(rx[q].x), bfhi(rx[q].x), bflo(rx[q].y), bfhi(rx[q].y)}; acc[q] = (f32x4){0.f, 0.f, 0.f, 0.f}; }
#pragma unroll
        for (int k = 0; k < 4; ++k)
#pragma unroll
            for (int q = 0; q < 4; ++q) acc[q] = acc[q] + (f32x4){bflo(ry[k][q].x), bfhi(ry[k][q].x), bflo(ry[k][q].y), bfhi(ry[k][q].y)} * g[k];
        if (r + F.NGW < M) F6_LOAD(r + F.NGW);
        if (lastl && j < CTXL) continue;
        const float* m5 = mod_ptr(F, layer, mrow, 5);
#pragma unroll
        for (int q = 0; q < 4; ++q) x[q] = x[q] + ((const f32x4*)m5)[F.lane + 64 * q] * acc[q];
        if (lastl) { st_row_f32(((float*)INP(N_IN)) + ((size_t)b * SEQ + (j - CTXL)) * D, F.lane, x); continue; }
        st_row_bf16(WSP(bf16_t, WS_XR) + (size_t)r * D, F.lane, x);
        rms_mod(x, F.lane, INP(I_NORM_MIX) + (layer + 1) * D, mod_ptr(F, layer + 1, mrow, 0), mod_ptr(F, layer + 1, mrow, 1));
        st_row_bf16(WSP(bf16_t, WS_HB) + (size_t)r * D, F.lane, x);
    }
#undef F6_LOAD
}
__device__ __forceinline__ void pR1_mix(Frame& F, int jj) {
    const float* mix = INP(I_RWKV_MIX) + (size_t)jj * 6 * D;
    const bf16_t* HB = WSP(const bf16_t, WS_HB);
    v2u rh[4], rp[4], rn[4];
#define R1_LOAD(r_) do { int b_, j_; row_bj((r_), b_, j_); const bool hp_ = (j_ != 0) && (j_ != CTXL), hn_ = (j_ != CTXL - 1) && (j_ != TPB - 1); \
        _Pragma("unroll") for (int q = 0; q < 4; ++q) { rh[q] = ((const v2u*)(HB + (size_t)(r_) * D))[F.lane + 64 * q]; \
            rp[q] = hp_ ? ((const v2u*)(HB + (size_t)((r_) - 1) * D))[F.lane + 64 * q] : (v2u){0u, 0u}; rn[q] = hn_ ? ((const v2u*)(HB + (size_t)((r_) + 1) * D))[F.lane + 64 * q] : (v2u){0u, 0u}; } } while (0)
#define R1_UNP(w_) ((f32x4){bflo((w_).x), bfhi((w_).x), bflo((w_).y), bfhi((w_).y)})
    if (F.gw < M) R1_LOAD(F.gw);
    for (int r = F.gw; r < M; r += F.NGW) {
        f32x4 h[4], xx[4];
#pragma unroll
        for (int q = 0; q < 4; ++q) { h[q] = R1_UNP(rh[q]); xx[q] = (R1_UNP(rp[q]) + R1_UNP(rn[q])) * 0.5f - h[q]; }
        if (r + F.NGW < M) R1_LOAD(r + F.NGW);
#pragma unroll
        for (int m = 0; m < 6; ++m) {
            f32x4 o[4];
#pragma unroll
            for (int q = 0; q < 4; ++q) o[q] = h[q] + xx[q] * ((const f32x4*)(mix + m * D))[F.lane + 64 * q];
            st_row_bf16(WSP(bf16_t, WS_XMIX) + ((size_t)m * M + r) * D, F.lane, o);
        }
    }
#undef R1_LOAD
#undef R1_UNP
}
#ifndef MK_SCAN_SEQ
#define MK_SCAN_SEQ 0
#endif
#if MK_SCAN_SEQ
#define SC_DECAY(z) __expf(-0.6065306597126334f * sigmoidf_(z))
#else
#define SC_DECAY(z) (-0.6065306597126334f * sigmoidf_(z))
#endif
struct EpiR2 {
    typedef NoCtx Ctx;
    bf16_t* dst[7];
    __device__ __forceinline__ void begin(Ctx&, const pg8::Unit&, int, int) const {}
    __device__ __forceinline__ void begin_half(Ctx&, const pg8::Unit&, int, int, int) const {}
    __device__ __forceinline__ void row8(const Ctx&, const pg8::Unit& u, int, int, int lrow, int lcol, f32x4 v0, f32x4 v1) const {
        const int row = u.pm * 256 + lrow;
        if (u.kind < 3) { bf16_t* O = (u.kind == 0) ? dst[0] : (u.kind == 1) ? dst[1] : dst[2]; *(v4u*)(O + (size_t)row * D + u.pn * 256 + lcol) = pack8(v0, v1); return; }
        if (lcol >= 128) return;
        bf16_t* O = (u.kind == 3) ? dst[3] : (u.kind == 4) ? dst[4] : (u.kind == 5) ? dst[5] : dst[6];
        if (u.kind == 3) {
#pragma unroll
            for (int q = 0; q < 4; ++q) { v0[q] = 1.f - 2.f * __builtin_amdgcn_rcpf(1.f + __expf(2.f * v0[q])); v1[q] = 1.f - 2.f * __builtin_amdgcn_rcpf(1.f + __expf(2.f * v1[q])); } }
        else if (u.kind == 5) {
#pragma unroll
            for (int q = 0; q < 4; ++q) { v0[q] = sigmoidf_(v0[q]); v1[q] = sigmoidf_(v1[q]); } }
        *(v4u*)(O + (size_t)row * 128 + lcol) = pack8(v0, v1);
    }
};
struct EpiR3 {
    struct Ctx { f32x4 b00, b01, b10, b11; };
    bf16_t* WDEC; bf16_t* AD; bf16_t* GB; bf16_t* VGT; const float* w0; const float* a0; const float* v0b;
    __device__ __forceinline__ void begin(Ctx& c, const pg8::Unit& u, int, int lcol0) const {
        const float* p0 = w0; const float* p1 = a0; const float* p2 = v0b; asm volatile("" : "+s"(p0), "+s"(p1), "+s"(p2));
        const float* bp = (u.kind == 0) ? p0 : (u.kind == 1) ? p1 : p2; const int col = u.pn * 256 + lcol0;
        const float* bb = bp + ((u.kind == 2) ? 0 : col);
        c.b00 = *(const f32x4*)(bb); c.b01 = *(const f32x4*)(bb + 4); c.b10 = *(const f32x4*)(bb + 128); c.b11 = *(const f32x4*)(bb + 132);
    }
    static constexpr bool HAS_TAB = true;
    __device__ __forceinline__ const float* bias_of(const pg8::Unit& u) const {
        const float* p0 = w0; const float* p1 = a0; const float* p2 = v0b; asm volatile("" : "+s"(p0), "+s"(p1), "+s"(p2));
        const float* bp = (u.kind == 0) ? p0 : (u.kind == 1) ? p1 : p2; return bp + ((u.kind == 2) ? 0 : u.pn * 256); }
    __device__ __forceinline__ void begin_pre(Ctx& c, const pg8::Unit&, int, int lcol0, const LAS unsigned char* tab) const {
        const LAS float* bb = (const LAS float*)(tab + 1024) + lcol0;
        c.b00 = *(const LAS f32x4*)(bb); c.b01 = *(const LAS f32x4*)(bb + 4); c.b10 = *(const LAS f32x4*)(bb + 128); c.b11 = *(const LAS f32x4*)(bb + 132); }
    __device__ __forceinline__ void begin_half(Ctx&, const pg8::Unit&, int, int, int) const {}
    __device__ __forceinline__ void row8(const Ctx& c, const pg8::Unit& u, int, int bj, int lrow, int lcol, f32x4 v0, f32x4 v1) const {
        const int row = u.pm * 256 + lrow, col = u.pn * 256 + lcol;
        const f32x4 cb0 = bj ? c.b10 : c.b00, cb1 = bj ? c.b11 : c.b01;
        if (u.kind == 0) {
            bf16_t* o = WDEC + ((size_t)(col >> 10) * M + row) * D + (col & 1023);
            f32x4 z0 = v0 + cb0, z1 = v1 + cb1;
#pragma unroll
            for (int q = 0; q < 4; ++q) { z0[q] = SC_DECAY(z0[q]); z1[q] = SC_DECAY(z1[q]); }
            *(v4u*)o = pack8(z0, z1);
        } else if (u.kind == 1) {
            f32x4 z0 = v0 + cb0, z1 = v1 + cb1;
#pragma unroll
            for (int q = 0; q < 4; ++q) { z0[q] = sigmoidf_(z0[q]); z1[q] = sigmoidf_(z1[q]); }
            *(v4u*)(AD + ((size_t)(col >> 10) * M + row) * D + (col & 1023)) = pack8(z0, z1);
        } else if (u.kind == 2) {
            *(v4u*)(GB + (size_t)row * D + col) = pack8(v0, v1);
        } else {
            f32x4 z0 = v0 + cb0, z1 = v1 + cb1;
#pragma unroll
            for (int q = 0; q < 4; ++q) { z0[q] = sigmoidf_(z0[q]); z1[q] = sigmoidf_(z1[q]); }
            *(v4u*)(VGT + (size_t)row * D + col) = pack8(z0, z1);
        }
    }
};
__device__ __forceinline__ float head_sum(float v) { return sum16(v); }
__device__ __forceinline__ void pR4_scan_prep(Frame& F, int jj) {
    const float* k_k = INP(I_RWKV_K_K) + jj * D; const float* k_a = INP(I_RWKV_K_A) + jj * D;
    for (int r = F.gw; r < M; r += F.NGW) {
        f32x4 k[4], kk[4];
        ld_row_bf16(WSP(const bf16_t, WS_KB) + (size_t)r * D, F.lane, k);
#pragma unroll
        for (int q = 0; q < 4; ++q) {
            kk[q] = k[q] * ((const f32x4*)k_k)[F.lane + 64 * q];
            const float ss = head_sum((kk[q].x * kk[q].x + kk[q].y * kk[q].y) + (kk[q].z * kk[q].z + kk[q].w * kk[q].w));
            kk[q] = kk[q] * rsqrtf(fmaxf(ss, 1e-24f));
        }
        st_row_bf16(WSP(bf16_t, WS_KK) + (size_t)r * D, F.lane, kk);
#pragma unroll
        for (int d = 0; d < 2; ++d) {
            f32x4 a[4], o[4];
            ld_row_bf16(WSP(const bf16_t, WS_AD) + ((size_t)d * M + r) * D, F.lane, a);
#pragma unroll
            for (int q = 0; q < 4; ++q) o[q] = k[q] * ((a[q] - 1.f) * ((const f32x4*)k_a)[F.lane + 64 * q] + 1.f);
            st_row_bf16(WSP(bf16_t, WS_KD) + ((size_t)d * M + r) * D, F.lane, o);
#pragma unroll
            for (int q = 0; q < 4; ++q) o[q] = kk[q] * a[q];
            st_row_bf16(WSP(bf16_t, WS_BD) + ((size_t)d * M + r) * D, F.lane, o);
        }
        if (jj > 0) {
            f32x4 v[4], vf[4], vg[4];
            ld_row_bf16(WSP(const bf16_t, WS_VB) + (size_t)r * D, F.lane, v);
            ld_row_bf16(WSP(const bf16_t, WS_VFIRST) + (size_t)r * D, F.lane, vf);
            ld_row_bf16(WSP(const bf16_t, WS_VGT) + (size_t)r * D, F.lane, vg);
#pragma unroll
            for (int q = 0; q < 4; ++q) v[q] = v[q] + (vf[q] - v[q]) * vg[q];
            st_row_bf16(WSP(bf16_t, WS_V2) + (size_t)r * D, F.lane, v);
        }
    }
}
constexpr int SC_CH = 32;
constexpr int SC_STEP_F = 6 * 64;
constexpr int SC_BUF_F = SC_CH * SC_STEP_F;
constexpr int SC_YOFF = 2 * SC_BUF_F * 4;
static_assert(SC_YOFF + 2 * SC_CH * 64 * 4 <= RING_BYTES, "scan LDS");
#if MK_SCAN_SEQ
struct ScanOps { f32x4 w0, w1, k0, k1, b0, b1, q0, q1, r0, r1; float v; };
__device__ __forceinline__ float fma_s(float a, float b, float c) { float d; asm("v_fma_f32 %0, %1, %2, %3" : "=v"(d) : "v"(a), "v"(b), "v"(c)); return d; }
__device__ __forceinline__ float mul_s(float a, float b) { float d; asm("v_mul_f32_e32 %0, %1, %2" : "=v"(d) : "v"(a), "v"(b)); return d; }
__device__ __forceinline__ float add_s(float a, float b) { float d; asm("v_add_f32_e32 %0, %1, %2" : "=v"(d) : "v"(a), "v"(b)); return d; }
__device__ __forceinline__ float fnma_s(float a, float b, float c) { float d; asm("v_fma_f32 %0, -%1, %2, %3" : "=v"(d) : "v"(a), "v"(b), "v"(c)); return d; }
__device__ __forceinline__ void scan_step(f32x4& Sa, f32x4& Sb, const ScanOps& o, float& y) {
    float a0 = mul_s(Sa[0], o.q0[0]), a1 = mul_s(Sb[0], o.q1[0]);
    a0 = fma_s(Sa[1], o.q0[1], a0); a1 = fma_s(Sb[1], o.q1[1], a1); a0 = fma_s(Sa[2], o.q0[2], a0); a1 = fma_s(Sb[2], o.q1[2], a1); a0 = fma_s(Sa[3], o.q0[3], a0); a1 = fma_s(Sb[3], o.q1[3], a1);
    float sa = add_s(a0, a1);
    f32x4 pa, pb;
#pragma unroll
    for (int j = 0; j < 4; ++j) { pa[j] = mul_s(o.v, o.k0[j]); pb[j] = mul_s(o.v, o.k1[j]); }
#pragma unroll
    for (int j = 0; j < 4; ++j) { pa[j] = fma_s(Sa[j], o.w0[j], pa[j]); pb[j] = fma_s(Sb[j], o.w1[j], pb[j]); }
    sa += dpp_xor1(sa); sa += dpp_xor2(sa); sa += dpp_hmir(sa);
#pragma unroll
    for (int j = 0; j < 4; ++j) { Sa[j] = fnma_s(sa, o.b0[j], pa[j]); Sb[j] = fnma_s(sa, o.b1[j], pb[j]); }
    a0 = mul_s(Sa[0], o.r0[0]); a1 = mul_s(Sb[0], o.r1[0]);
    a0 = fma_s(Sa[1], o.r0[1], a0); a1 = fma_s(Sb[1], o.r1[1], a1); a0 = fma_s(Sa[2], o.r0[2], a0); a1 = fma_s(Sb[2], o.r1[2], a1); a0 = fma_s(Sa[3], o.r0[3], a0); a1 = fma_s(Sb[3], o.r1[3], a1);
    y = add_s(a0, a1);
    y += dpp_xor1(y); y += dpp_xor2(y); y += dpp_hmir(y);
}
__device__ __forceinline__ void pR5_scan(Frame& F, int jj) {
    LAS float* lbuf = (LAS float*)(F.lds + RING_OFF);
    LAS float* ybuf = (LAS float*)(F.lds + RING_OFF + SC_YOFF);
    const int tid = F.tid, vrow = tid >> 3, kq = tid & 7;
    const int sstep = tid >> 4, spart = tid & 15;
    const bf16_t* Vsrc = WSP(const bf16_t, (jj == 0) ? WS_VFIRST : WS_V2);
    for (int u = F.bid; u < NB * 16 * 2; u += F.G) {
        const int dir = u & 1, hh = (u >> 1) & 15, b = u >> 5;
        const size_t rowb = (size_t)b * TPB; const int colh = hh * 64 + 4 * spart;
        const float* Wd = WSP(const float, WS_WDEC) + (size_t)dir * M * D; const bf16_t* Kd = WSP(const bf16_t, WS_KD) + (size_t)dir * M * D; const bf16_t* Bd = WSP(const bf16_t, WS_BD) + (size_t)dir * M * D;
        const bf16_t* Kk = WSP(const bf16_t, WS_KK); const bf16_t* Rb = WSP(const bf16_t, WS_RB);
        float* Yd = WSP(float, WS_YS) + (size_t)dir * M * D;
        f32x4 Sa = (f32x4){0.f, 0.f, 0.f, 0.f}, Sb = (f32x4){0.f, 0.f, 0.f, 0.f};
        constexpr int NCH = TPB / SC_CH;
        f32x4 gw_; v2u gk_, gb_, gkk_, gr_, gv_;
#define SC_ROW(c, s) ((dir == 0) ? ((c) * SC_CH + (s)) : (((c) < CTXL / SC_CH) ? (CTXL - 1 - ((c) * SC_CH + (s))) : (TPB - 1 - ((c) * SC_CH + (s) - CTXL))))
#define SC_GLOAD(c) do { const size_t ro = (rowb + (size_t)SC_ROW(c, sstep)) * D + colh; gw_ = *(const f32x4*)(Wd + ro); gk_ = *(const v2u*)(Kd + ro); gb_ = *(const v2u*)(Bd + ro); \
        gkk_ = *(const v2u*)(Kk + ro); gr_ = *(const v2u*)(Rb + ro); gv_ = *(const v2u*)(Vsrc + ro); } while (0)
#define SC_BF4(w) (f32x4){bflo((w).x), bfhi((w).x), bflo((w).y), bfhi((w).y)}
#define SC_LWRITE(bufi) do { LAS float* d_ = lbuf + (bufi) * SC_BUF_F + sstep * SC_STEP_F + 4 * spart; *(LAS f32x4*)(d_) = gw_; *(LAS f32x4*)(d_ + 64) = SC_BF4(gk_); *(LAS f32x4*)(d_ + 128) = SC_BF4(gb_); \
        *(LAS f32x4*)(d_ + 192) = SC_BF4(gkk_); *(LAS f32x4*)(d_ + 256) = SC_BF4(gr_); *(LAS f32x4*)(d_ + 320) = SC_BF4(gv_); } while (0)
#define SC_LDOPS(o, sb) do { (o).w0 = *(const LAS f32x4*)(sb); (o).w1 = *(const LAS f32x4*)((sb) + 4); (o).k0 = *(const LAS f32x4*)((sb) + 64); (o).k1 = *(const LAS f32x4*)((sb) + 68); \
        (o).b0 = *(const LAS f32x4*)((sb) + 128); (o).b1 = *(const LAS f32x4*)((sb) + 132); (o).q0 = *(const LAS f32x4*)((sb) + 192); (o).q1 = *(const LAS f32x4*)((sb) + 196); \
        (o).r0 = *(const LAS f32x4*)((sb) + 256); (o).r1 = *(const LAS f32x4*)((sb) + 260); (o).v = (sb)[320 - 8 * kq + vrow]; } while (0)
        __syncthreads();
        SC_GLOAD(0); SC_LWRITE(0); __syncthreads();
        for (int c = 0; c < NCH; ++c) {
            if (c + 1 < NCH) SC_GLOAD(c + 1);
            if (c > 0) {
                const f32x4 yv = *(const LAS f32x4*)(ybuf + ((c - 1) & 1) * (SC_CH * 64) + sstep * 64 + 4 * spart);
                *(f32x4*)(Yd + (rowb + (size_t)SC_ROW(c - 1, sstep)) * D + colh) = yv;
            }
            const LAS float* cb = lbuf + (c & 1) * SC_BUF_F + 8 * kq;
            LAS float* yb = ybuf + (c & 1) * (SC_CH * 64) + vrow;
            ScanOps cur, nxt; SC_LDOPS(cur, cb);
#pragma unroll
            for (int s = 0; s < SC_CH; ++s) {
                if (s + 1 < SC_CH) SC_LDOPS(nxt, cb + (s + 1) * SC_STEP_F);
                float y; scan_step(Sa, Sb, cur, y);
                if (kq == 0) yb[s * 64] = y;
                cur = nxt;
            }
            if (c + 1 < NCH) SC_LWRITE((c + 1) & 1);
            __syncthreads();
        }
        {
            const f32x4 yv = *(const LAS f32x4*)(ybuf + ((NCH - 1) & 1) * (SC_CH * 64) + sstep * 64 + 4 * spart);
            *(f32x4*)(Yd + (rowb + (size_t)SC_ROW(NCH - 1, sstep)) * D + colh) = yv;
        }
#undef SC_ROW
#undef SC_GLOAD
#undef SC_BF4
#undef SC_LWRITE
#undef SC_LDOPS
    }
}
#else
constexpr int CK_P = 72, CK_MB = 64 * CK_P * 2;
enum { CB_RM = 0, CB_AT, CB_LAK, CB_LRB, CB_LRK, CB_SB, CB_N0, CB_N1, CB_N2, CB_NBUF };
constexpr int CK_PT = 80, CK_TB = 64 * CK_PT * 2, CK_TOFF = CB_NBUF * CK_MB;
enum { CT_VM = 0, CT_BM, CT_KM, CT_NBUF };
constexpr int CK_CW = CB_N0 * CK_MB;
constexpr int CK_SEG = CK_TOFF + CT_NBUF * CK_TB, CK_WC = CK_SEG + 8 * 64 * 4;
static_assert(CK_WC + 64 * 4 <= RING_BYTES && 2 * CK_MB >= 64 * 64 * 4, "chunked scan LDS");
typedef LAS unsigned char* lptr;
struct CkFrag { bf16x8 lo, hi; };
template <int PITCHB = CK_P * 2>
__device__ __forceinline__ CkFrag ck_ld(lptr Mb, int row0, int l15, int g) { const lptr p = Mb + (row0 + l15) * PITCHB + g * 16; CkFrag f; f.lo = *(const LAS bf16x8*)p; f.hi = *(const LAS bf16x8*)(p + 64); return f; }
typedef short ck_v4i16 __attribute__((ext_vector_type(4))); typedef short ck_v8i16 __attribute__((ext_vector_type(8)));
__device__ __forceinline__ CkFrag ck_ld_tr(lptr Mb, int n0, int l15, int g) {
    const lptr p = Mb + (8 * g + (l15 >> 2)) * (CK_PT * 2) + n0 * 2 + (l15 & 3) * 8;
    const ck_v4i16 a = __builtin_amdgcn_ds_read_tr16_b64_v4i16((LAS ck_v4i16*)(p)), b = __builtin_amdgcn_ds_read_tr16_b64_v4i16((LAS ck_v4i16*)(p + 4 * (CK_PT * 2)));
    const ck_v4i16 c = __builtin_amdgcn_ds_read_tr16_b64_v4i16((LAS ck_v4i16*)(p + 32 * (CK_PT * 2))), d = __builtin_amdgcn_ds_read_tr16_b64_v4i16((LAS ck_v4i16*)(p + 36 * (CK_PT * 2)));
    CkFrag f; f.lo = __builtin_bit_cast(bf16x8, (ck_v8i16)__builtin_shufflevector(a, b, 0, 1, 2, 3, 4, 5, 6, 7)); f.hi = __builtin_bit_cast(bf16x8, (ck_v8i16)__builtin_shufflevector(c, d, 0, 1, 2, 3, 4, 5, 6, 7)); return f; }
__device__ __forceinline__ f32x4 ck_mm(f32x4 acc, const CkFrag& a, const CkFrag& b) {
    acc = __builtin_amdgcn_mfma_f32_16x16x32_bf16(a.lo, b.lo, acc, 0, 0, 0); return __builtin_amdgcn_mfma_f32_16x16x32_bf16(a.hi, b.hi, acc, 0, 0, 0); }
__device__ __forceinline__ void ck_st_t(lptr Mb, int row0, int col0, int l15, int g, f32x4 v) {
    v2u w; w.x = pk2(v[0], v[1]); w.y = pk2(v[2], v[3]);
    *(LAS v2u*)(Mb + (col0 + l15) * (CK_P * 2) + (row0 + 4 * g) * 2) = w;
}
__device__ __forceinline__ bf16x8 sm_ld(lptr img, int l15, int g) { return *(const LAS bf16x8*)(img + l15 * 64 + g * 16); }
__device__ __forceinline__ f32x4 mm16(f32x4 acc, bf16x8 a, bf16x8 b) { return __builtin_amdgcn_mfma_f32_16x16x32_bf16(a, b, acc, 0, 0, 0); }
__device__ __forceinline__ void sm_st_t(lptr img, int l15, int g, f32x4 v) {
    v2u w; w.x = pk2(v[0], v[1]); w.y = pk2(v[2], v[3]);
    *(LAS v2u*)(img + l15 * 64 + g * 8) = w; { unsigned zz = 0u; asm volatile("" : "+v"(zz)); *(LAS v2u*)(img + l15 * 64 + 32 + g * 8) = (v2u){zz, zz}; }
}
#ifdef MK_SCANVAR
__device__ __forceinline__ void pR5_scan(Frame& F, int jj, int var = 0) {
    const bool HM = (var & 64) != 0;
#else
__device__ __forceinline__ void pR5_scan(Frame& F, int jj) {
    constexpr bool HM = false;
#endif
    const lptr L0 = F.lds + RING_OFF;
#define CKB(i) (L0 + (i) * CK_MB)
#define CKT(i) (L0 + CK_TOFF + (i) * CK_TB)
    LAS float* CW = (LAS float*)(L0 + CK_CW); LAS float* SEG = (LAS float*)(L0 + CK_SEG); LAS float* WC = (LAS float*)(L0 + CK_WC);
    const int tid = F.tid, lane = tid & 63, wv = F.wave, l15 = lane & 15, g = lane >> 4;
    const int tr16 = (wv >> 1) * 16, tc0 = (wv & 1) * 32;
    const int pk = tid & 63, pseg = tid >> 6;
    const int pt = tid >> 3, pkg = tid & 7;
    const bf16_t* Vsrc = WSP(const bf16_t, (jj == 0) ? WS_VFIRST : WS_VB);
    const f32x4 z4 = (f32x4){0.f, 0.f, 0.f, 0.f};
    for (int u = F.bid; u < NB * 16 * 2; u += F.G) {
        const int dir = u & 1, hh = (u >> 1) & 15, b = u >> 5;
        const int RS = HM ? 64 : D;
        const size_t ub = HM ? (size_t)(b * 16 + hh) * TPB * 64 : (size_t)b * TPB * D + hh * 64;
        const bf16_t* Wd = WSP(const bf16_t, WS_WDEC) + (size_t)dir * M * D + ub; const bf16_t* Kb = WSP(const bf16_t, WS_KB) + ub;
        const bf16_t* Ad = WSP(const bf16_t, WS_AD) + (size_t)dir * M * D + ub; const bf16_t* Rb = WSP(const bf16_t, WS_RB) + ub;
        const bf16_t* Vs = Vsrc + ub; const bf16_t* Vf = WSP(const bf16_t, WS_VFIRST) + ub; const bf16_t* Vg = WSP(const bf16_t, WS_VGT) + ub; bf16_t* Yd = WSP(bf16_t, WS_YS) + (size_t)dir * M * D + ub;
        float kkv[8], kav[8], rkv[8];
        { const float* pkk = INP(I_RWKV_K_K) + jj * D + hh * 64 + 8 * pkg; const float* pka = INP(I_RWKV_K_A) + jj * D + hh * 64 + 8 * pkg; const float* prk = INP(I_RWKV_R_K) + jj * D + hh * 64 + 8 * pkg;
#pragma unroll
          for (int j = 0; j < 8; ++j) { kkv[j] = pkk[j]; kav[j] = pka[j]; rkv[j] = prk[j]; } }
        float* Bon = WSP(float, WS_LOGITS) + ((size_t)dir * M + (size_t)b * TPB) * 16 + hh;
        constexpr int NCK = TPB / 64;
#define CK_ROW(st) ((dir == 0) ? (st) : (((st) < CTXL) ? (CTXL - 1 - (st)) : (TPB - 1 - ((st) - CTXL))))
        unsigned glw[8]; v4u gk, ga, gr, gv, gvf, gvg;
#define CK_GLOADW(c) do { const int rb_ = CK_ROW((c) * 64), sg_ = (dir == 0) ? RS : -RS;        \
        const bf16_t* wl_ = Wd + (size_t)rb_ * RS + (pk & ~1) + (long)sg_ * (8 * pseg); _Pragma("unroll") for (int j = 0; j < 8; ++j) glw[j] = *(const unsigned*)(wl_ + (long)sg_ * j); } while (0)
#define CK_GLOAD(c) do { const int rb_ = CK_ROW((c) * 64), sg_ = (dir == 0) ? RS : -RS; \
        const size_t ro = (size_t)((long)rb_ * RS + (long)sg_ * pt) + 8 * pkg; gk = *(const v4u*)(Kb + ro); ga = *(const v4u*)(Ad + ro); gr = *(const v4u*)(Rb + ro); gv = *(const v4u*)(Vs + ro); \
        if (jj > 0) { gvf = *(const v4u*)(Vf + ro); gvg = *(const v4u*)(Vg + ro); } } while (0)
        f32x4 SaccT[2] = {z4, z4};
        __syncthreads();
        CK_GLOADW(0); CK_GLOAD(0);
        float cl[8];
#define CK_LW(j) ((pk & 1) ? bfhi(glw[j]) : bflo(glw[j]))
#define CK_CUMSEG() do { cl[0] = CK_LW(0); _Pragma("unroll") for (int j = 1; j < 8; ++j) cl[j] = cl[j - 1] + CK_LW(j); SEG[pseg * 64 + pk] = cl[7]; } while (0)
        CK_CUMSEG();
        __syncthreads();
        for (int c = 0; c < NCK; ++c) {
            if (c + 1 < NCK) CK_GLOADW(c + 1);
            const v4u yprev = *(const LAS v4u*)(CKB(CB_N2) + pt * (CK_P * 2) + 16 * pkg);
#pragma unroll
            for (int q = 0; q < 2; ++q) ck_st_t(CKB(CB_SB), tr16, tc0 + 16 * q, l15, g, SaccT[q]);
            { float pre = 0.f;
#pragma unroll
              for (int s2 = 0; s2 < 7; ++s2) pre += (s2 < pseg) ? SEG[s2 * 64 + pk] : 0.f;
#pragma unroll
              for (int j = 0; j < 8; ++j) CW[(8 * pseg + j) * 64 + pk] = __expf(cl[j] + pre);
              if (pseg == 7) WC[pk] = __expf(cl[7] + pre); }
            __syncthreads();
            { const f32x4 c0 = *(const LAS f32x4*)(CW + pt * 64 + 8 * pkg), c1 = *(const LAS f32x4*)(CW + pt * 64 + 8 * pkg + 4);
              f32x4 p0 = (f32x4){1.f, 1.f, 1.f, 1.f}, p1 = p0;
              if (pt > 0) { p0 = *(const LAS f32x4*)(CW + (pt - 1) * 64 + 8 * pkg); p1 = *(const LAS f32x4*)(CW + (pt - 1) * 64 + 8 * pkg + 4); }
              float fa[8], fb[8], fk[8], fr[8], xk[8], xa[8], kkj[8];
              const unsigned wk_[4] = {gk.x, gk.y, gk.z, gk.w}, wa_[4] = {ga.x, ga.y, ga.z, ga.w}, wr[4] = {gr.x, gr.y, gr.z, gr.w};
              float ss = 0.f;
#pragma unroll
              for (int j = 0; j < 8; ++j) { xk[j] = (j & 1) ? bfhi(wk_[j >> 1]) : bflo(wk_[j >> 1]); xa[j] = (j & 1) ? bfhi(wa_[j >> 1]) : bflo(wa_[j >> 1]); kkj[j] = xk[j] * kkv[j]; ss += kkj[j] * kkj[j]; }
              ss += dpp_xor1(ss); ss += dpp_xor2(ss); ss += dpp_hmir(ss);
              const float rn = rsqrtf(fmaxf(ss, 1e-24f)); float bs = 0.f;
#pragma unroll
              for (int j = 0; j < 8; ++j) { const float cwj = (j < 4) ? c0[j & 3] : c1[j & 3], cpj = (j < 4) ? p0[j & 3] : p1[j & 3];
                  const float Wt = cwj, Wi = __builtin_amdgcn_rcpf(Wt), Wp = cpj;
                  const float xr = (j & 1) ? bfhi(wr[j >> 1]) : bflo(wr[j >> 1]), kn = kkj[j] * rn;
                  const float kd = xk[j] * ((xa[j] - 1.f) * kav[j] + 1.f);
                  fa[j] = -kn * Wp; fb[j] = kn * xa[j] * Wi; fk[j] = kd * Wi; fr[j] = xr * Wt; bs += xr * kd * rkv[j]; }
              bs += dpp_xor1(bs); bs += dpp_xor2(bs); bs += dpp_hmir(bs);
              if (pkg == 0) Bon[(size_t)CK_ROW(c * 64 + pt) * 16] = bs;
              if (jj > 0) {
                  const unsigned wv_[4] = {gv.x, gv.y, gv.z, gv.w}, wf_[4] = {gvf.x, gvf.y, gvf.z, gvf.w}, wg_[4] = {gvg.x, gvg.y, gvg.z, gvg.w}; float vm[8];
#pragma unroll
                  for (int j = 0; j < 8; ++j) { const float a_ = (j & 1) ? bfhi(wv_[j >> 1]) : bflo(wv_[j >> 1]), f_ = (j & 1) ? bfhi(wf_[j >> 1]) : bflo(wf_[j >> 1]), g_ = (j & 1) ? bfhi(wg_[j >> 1]) : bflo(wg_[j >> 1]); vm[j] = a_ + (f_ - a_) * g_; }
                  gv.x = pk2(vm[0], vm[1]); gv.y = pk2(vm[2], vm[3]); gv.z = pk2(vm[4], vm[5]); gv.w = pk2(vm[6], vm[7]); }
              v4u oa, ob, ok, orr;
              oa.x = pk2(fa[0], fa[1]); oa.y = pk2(fa[2], fa[3]); oa.z = pk2(fa[4], fa[5]); oa.w = pk2(fa[6], fa[7]);
              ob.x = pk2(fb[0], fb[1]); ob.y = pk2(fb[2], fb[3]); ob.z = pk2(fb[4], fb[5]); ob.w = pk2(fb[6], fb[7]);
              ok.x = pk2(fk[0], fk[1]); ok.y = pk2(fk[2], fk[3]); ok.z = pk2(fk[4], fk[5]); ok.w = pk2(fk[6], fk[7]);
              orr.x = pk2(fr[0], fr[1]); orr.y = pk2(fr[2], fr[3]); orr.z = pk2(fr[4], fr[5]); orr.w = pk2(fr[6], fr[7]);
              const int ro = pt * (CK_P * 2) + 16 * pkg;
              const int rt = pt * (CK_PT * 2) + 16 * pkg;
              *(LAS v4u*)(CKB(CB_AT) + ro) = oa; *(LAS v4u*)(CKT(CT_BM) + rt) = ob; *(LAS v4u*)(CKT(CT_KM) + rt) = ok; *(LAS v4u*)(CKB(CB_RM) + ro) = orr; *(LAS v4u*)(CKT(CT_VM) + rt) = gv; }
            if (c > 0) *(v4u*)(Yd + (size_t)CK_ROW((c - 1) * 64 + pt) * RS + 8 * pkg) = yprev;
            if (c + 1 < NCK) CK_GLOAD(c + 1);
            __syncthreads();
            { const CkFrag aBM = ck_ld<CK_PT * 2>(CKT(CT_BM), tr16, l15, g), aKM = ck_ld<CK_PT * 2>(CKT(CT_KM), tr16, l15, g);
#pragma unroll
              for (int q = 0; q < 2; ++q) { const int tc16 = tc0 + 16 * q; const bool dg = (tr16 == tc16);
                const CkFrag bAT = ck_ld(CKB(CB_AT), tc16, l15, g), bRM = ck_ld(CKB(CB_RM), tc16, l15, g);
                f32x4 pq = ck_mm(z4, aBM, bAT);
                f32x4 lak = ck_mm(z4, aKM, bAT), lrb = ck_mm(z4, aBM, bRM), lrk = ck_mm(z4, aKM, bRM);
#pragma unroll
                for (int r = 0; r < 4; ++r) { const int i = tr16 + 4 * g + r, t = tc16 + l15; if (!(i < t)) { pq[r] = 0.f; lak[r] = 0.f; } if (!(i <= t)) { lrb[r] = 0.f; lrk[r] = 0.f; } }
                if (dg) {
                    const CkFrag aAT = ck_ld(CKB(CB_AT), tr16, l15, g), bBM = ck_ld<CK_PT * 2>(CKT(CT_BM), tc16, l15, g);
                    f32x4 cn = ck_mm(z4, aAT, bBM);
#pragma unroll
                    for (int r = 0; r < 4; ++r) { const int t = tr16 + 4 * g + r, i = tc16 + l15; if (!(i < t)) cn[r] = 0.f; }
                    f32x4 cq = pq, Tt;
#pragma unroll
                    for (int r = 0; r < 4; ++r) Tt[r] = cq[r] + ((4 * g + r == l15) ? 1.f : 0.f);
                    unsigned zz = 0u; asm volatile("" : "+v"(zz));
#define CK_PACK(x) __builtin_bit_cast(bf16x8, (v4u){pk2((x)[0], (x)[1]), pk2((x)[2], (x)[3]), zz, zz})
#pragma unroll
                    for (int lv = 1; lv <= 3; ++lv) {
                        const bf16x8 on = CK_PACK(cn), oq = CK_PACK(cq);
                        cn = mm16(z4, oq, on);
                        if (lv < 3) cq = mm16(z4, on, oq);
                        Tt = mm16(Tt, CK_PACK(cn), CK_PACK(Tt));
                    }
#undef CK_PACK
                    sm_st_t(CKB(CB_N2) + (tr16 >> 4) * 1024, l15, g, Tt);
                    pq = z4;
                }
                ck_st_t(CKB(CB_N1), tr16, tc16, l15, g, pq);
                ck_st_t(CKB(CB_LAK), tr16, tc16, l15, g, lak); ck_st_t(CKB(CB_LRB), tr16, tc16, l15, g, lrb); ck_st_t(CKB(CB_LRK), tr16, tc16, l15, g, lrk);
                } }
            __syncthreads();
            if (wv < 4) {
                const int vb = 16 * wv; unsigned zz = 0u; asm volatile("" : "+v"(zz));
                const CkFrag bSB = ck_ld(CKB(CB_SB), vb, l15, g), bVT = ck_ld_tr(CKT(CT_VM), vb, l15, g);
                CkFrag aAT[4], aLAK[4]; v2u lw_[6], tw[4];
#pragma unroll
                for (int b2 = 0; b2 < 4; ++b2) { aAT[b2] = ck_ld(CKB(CB_AT), 16 * b2, l15, g); aLAK[b2] = ck_ld(CKB(CB_LAK), 16 * b2, l15, g); tw[b2] = *(const LAS v2u*)(CKB(CB_N2) + b2 * 1024 + l15 * 64 + g * 8); }
#pragma unroll
                for (int b2 = 1; b2 < 4; ++b2)
#pragma unroll
                    for (int j2 = 0; j2 < b2; ++j2) lw_[b2 * (b2 - 1) / 2 + j2] = *(const LAS v2u*)(CKB(CB_N1) + (16 * b2 + l15) * (CK_P * 2) + (16 * j2 + 4 * g) * 2);
                f32x4 R[4];
#pragma unroll
                for (int b2 = 0; b2 < 4; ++b2) { R[b2] = ck_mm(z4, aAT[b2], bSB); R[b2] = ck_mm(R[b2], aLAK[b2], bVT); }
#pragma unroll
                for (int b2 = 0; b2 < 4; ++b2) {
                    const f32x4 U = mm16(z4, __builtin_bit_cast(bf16x8, (v4u){tw[b2].x, tw[b2].y, zz, zz}), __builtin_bit_cast(bf16x8, (v4u){pk2(R[b2][0], R[b2][1]), pk2(R[b2][2], R[b2][3]), zz, zz}));
                    const bf16x8 Up = __builtin_bit_cast(bf16x8, (v4u){pk2(U[0], U[1]), pk2(U[2], U[3]), zz, zz});
                    ck_st_t(CKB(CB_N0), 16 * b2, vb, l15, g, U);
#pragma unroll
                    for (int b3 = b2 + 1; b3 < 4; ++b3) R[b3] = mm16(R[b3], __builtin_bit_cast(bf16x8, (v4u){lw_[b3 * (b3 - 1) / 2 + b2].x, lw_[b3 * (b3 - 1) / 2 + b2].y, zz, zz}), Up);
                }
            }
            __syncthreads();
            { const CkFrag aSB = ck_ld(CKB(CB_SB), tr16, l15, g), aUT = ck_ld(CKB(CB_N0), tr16, l15, g), aVT = ck_ld_tr(CKT(CT_VM), tr16, l15, g), aBMT = ck_ld_tr(CKT(CT_BM), tr16, l15, g), aKMT = ck_ld_tr(CKT(CT_KM), tr16, l15, g);
              const f32x4 wc = *(const LAS f32x4*)(WC + tr16 + 4 * g);
#pragma unroll
              for (int q = 0; q < 2; ++q) { const int tc16 = tc0 + 16 * q;
                const CkFrag bRM = ck_ld(CKB(CB_RM), tc16, l15, g), bLRB = ck_ld(CKB(CB_LRB), tc16, l15, g), bLRK = ck_ld(CKB(CB_LRK), tc16, l15, g), bUT = ck_ld(CKB(CB_N0), tc16, l15, g), bVT = ck_ld_tr(CKT(CT_VM), tc16, l15, g);
                f32x4 yt = ck_mm(z4, aSB, bRM); yt = ck_mm(yt, aUT, bLRB); yt = ck_mm(yt, aVT, bLRK);
                ck_st_t(CKB(CB_N2), tr16, tc16, l15, g, yt);
                SaccT[q] = ck_mm(SaccT[q], aBMT, bUT); SaccT[q] = ck_mm(SaccT[q], aKMT, bVT); SaccT[q] = SaccT[q] * wc; } }
            if (c + 1 < NCK) CK_CUMSEG();
            __syncthreads();
        }
        *(v4u*)(Yd + (size_t)CK_ROW((NCK - 1) * 64 + pt) * RS + 8 * pkg) = *(const LAS v4u*)(CKB(CB_N2) + pt * (CK_P * 2) + 16 * pkg);
#undef CK_CUMSEG
#undef CK_LW
#undef CK_ROW
#undef CK_GLOAD
#undef CK_GLOADW
    }
#undef CKB
#undef CKT
}
#endif
__device__ __forceinline__ void pR6_out(Frame& F, int jj) {
    const float* ln_w = INP(I_RWKV_LN_W) + jj * D; const float* ln_b = INP(I_RWKV_LN_B) + jj * D;
    v2u ry[4], ry1[4], rg[4], rv[4], rvf[4], rvg[4]; float rb0[4], rb1[4];
#define R6_ROW(P_, r_, dst_) do { _Pragma("unroll") for (int q = 0; q < 4; ++q) dst_[q] = ((const v2u*)(WSP(const bf16_t, P_) + (size_t)(r_) * D))[F.lane + 64 * q]; } while (0)
#define R6_LOAD(r_) do { R6_ROW(WS_YS, (r_), ry); R6_ROW(WS_YS, (size_t)M + (r_), ry1); R6_ROW(WS_GB, (r_), rg); \
        if (jj == 0) R6_ROW(WS_VFIRST, (r_), rv); else { R6_ROW(WS_VB, (r_), rv); R6_ROW(WS_VFIRST, (r_), rvf); R6_ROW(WS_VGT, (r_), rvg); } \
        const float* bon_ = WSP(const float, WS_LOGITS) + (size_t)(r_) * 16 + (F.lane >> 4);        \
        _Pragma("unroll") for (int q = 0; q < 4; ++q) { rb0[q] = bon_[4 * q]; rb1[q] = bon_[(size_t)M * 16 + 4 * q]; } } while (0)
#define R6_UNP(w_) ((f32x4){bflo((w_).x), bfhi((w_).x), bflo((w_).y), bfhi((w_).y)})
    if (F.gw < M) R6_LOAD(F.gw);
    for (int r = F.gw; r < M; r += F.NGW) {
        f32x4 yy[4], v[4], g[4]; float bonus[4];
#pragma unroll
        for (int q = 0; q < 4; ++q) { yy[q] = R6_UNP(ry[q]) + R6_UNP(ry1[q]); g[q] = R6_UNP(rg[q]); v[q] = R6_UNP(rv[q]); bonus[q] = rb0[q] + rb1[q];
            if (jj != 0) { const f32x4 vf = R6_UNP(rvf[q]), vg = R6_UNP(rvg[q]); v[q] = v[q] + (vf - v[q]) * vg; } }
        if (r + F.NGW < M) R6_LOAD(r + F.NGW);
        f32x4 o[4];
#pragma unroll
        for (int q = 0; q < 4; ++q) {
            const float mu = head_sum((yy[q].x + yy[q].y) + (yy[q].z + yy[q].w)) * (1.f / 64.f);
            const f32x4 dlt = yy[q] - mu;
            const float var = head_sum((dlt.x * dlt.x + dlt.y * dlt.y) + (dlt.z * dlt.z + dlt.w * dlt.w)) * (1.f / 64.f);
            const f32x4 yn = dlt * rsqrtf(var + GN_EPS) * ((const f32x4*)ln_w)[F.lane + 64 * q] + ((const f32x4*)ln_b)[F.lane + 64 * q];
            o[q] = (yn + v[q] * bonus[q]) * g[q];
        }
        st_row_bf16(WSP(bf16_t, WS_OB) + (size_t)r * D, F.lane, o);
    }
#undef R6_ROW
#undef R6_LOAD
#undef R6_UNP
}
#define RWKV_PHASES(p0, L, J) \
    { const unsigned char* swo = (const unsigned char*)F.ws + WS_SMALLW + SW_OD + (size_t)(J) * OD_BYTES; \
    if (IN((p0) + 0)) { pR1_mix(F, (J)); SEAM((p0) + 0); } \
    if (IN((p0) + 1)) { MultiOrder<7> S; const char* xm = (const char*)(F.ws + WS_XMIX); \
        S.s[0] = SubGemm{xm + 0 * ROWB2, (const char*)(swo + OD_WR), 2048, 1024, 4, 0}; S.s[1] = SubGemm{xm + 2 * ROWB2, (const char*)(swo + OD_WK), 2048, 1024, 4, 1}; \
        S.s[2] = SubGemm{xm + 3 * ROWB2, (const char*)(swo + OD_WV), 2048, 1024, 4, 2}; S.s[3] = SubGemm{xm + 1 * ROWB2, (const char*)(swo + OD_W1C), 2048, 1024, 1, 3}; \
        S.s[4] = SubGemm{xm + 4 * ROWB2, (const char*)(swo + OD_A1C), 2048, 1024, 1, 4}; S.s[5] = SubGemm{xm + 5 * ROWB2, (const char*)(swo + OD_G1), 2048, 1024, 1, 5}; \
        S.s[6] = SubGemm{xm + 3 * ROWB2, (const char*)(swo + OD_V1), 2048, 1024, ((J) > 0) ? 1 : 0, 6}; S.init(F.G, F.bid, 1); \
        EpiR2 E; E.dst[0] = WSP(bf16_t, WS_RB); E.dst[1] = WSP(bf16_t, WS_KB); E.dst[2] = WSP(bf16_t, ((J) == 0) ? WS_VFIRST : WS_VB); E.dst[3] = WSP(bf16_t, WS_LW); E.dst[4] = WSP(bf16_t, WS_LA); \
        E.dst[5] = WSP(bf16_t, WS_LG); E.dst[6] = WSP(bf16_t, WS_LV); pg8::gemm_phase(ring, S, E, F.wave); SEAM((p0) + 1); } \
    if (IN((p0) + 2)) { MultiOrder<4> S; \
        S.s[0] = SubGemm{(const char*)(F.ws + WS_LW), (const char*)(swo + OD_W2C), 256, 128, 8, 0}; S.s[1] = SubGemm{(const char*)(F.ws + WS_LA), (const char*)(swo + OD_A2C), 256, 128, 8, 1}; \
        S.s[2] = SubGemm{(const char*)(F.ws + WS_LG), (const char*)(swo + OD_G2), 256, 128, 4, 2}; S.s[3] = SubGemm{(const char*)(F.ws + WS_LV), (const char*)(swo + OD_V2), 256, 128, ((J) > 0) ? 4 : 0, 3}; S.init(F.G, F.bid); \
        EpiR3 E{WSP(bf16_t, WS_WDEC), WSP(bf16_t, WS_AD), WSP(bf16_t, WS_GB), WSP(bf16_t, WS_VGT), INP(I_RWKV_W0) + (size_t)(J) * 2 * D, INP(I_RWKV_A0) + (size_t)(J) * 2 * D, INP(I_RWKV_V0)}; \
        pg8::gemm_phase(ring, S, E, F.wave); SEAM((p0) + 2); } \
      \
    if (IN((p0) + 4)) { pR5_scan(F, (J)); SEAM((p0) + 4); } \
    if (IN((p0) + 5)) { pR6_out(F, (J)); SEAM((p0) + 5); } \
    if (IN((p0) + 6)) { MultiOrder<1> S; S.s[0] = SubGemm{(const char*)(F.ws + WS_OB), (const char*)(swo + OD_WO), 2048, 1024, 4, 0}; S.init(F.G, F.bid); \
        EpiResidual E{WSP(bf16_t, WS_XR), WSP(const float, WS_MOD) + (size_t)(L) * 9 * 6144 + 2 * 1024}; pg8::gemm_phase(ring, S, E, F.wave); SEAM((p0) + 6); } }
#define MOE_PHASES(p0, L) \
    if (IN((p0) + 0)) { pF1R_norm_router(F, args, (L)); SEAM((p0) + 0); } \
      \
    if (IN((p0) + 2) && F.G * NWAVES * 17 < M) { pF3_route(F, (L)); SEAM((p0) + 2); }     \
    if (IN((p0) + 3)) { const int tt = moe_table(F, (L)); MoeOrder<8, 4, 2> S; int z_ = 0; asm volatile("" : "+s"(z_)); S.tb = (const LAS int*)(F.lds + LDSCTL_OFF + z_); S.A = (const char*)(F.ws + WS_HB); \
        S.W = (const char*)(F.ws + WS_W1T) + (size_t)(L) * 32 * 2048 * 1024 * 2; S.RI = WSP(const int, WS_ROWIDX); S.G = F.G; S.c = F.bid; S.nwg = ((tt + 3) / 4) * 4 * 8; \
        EpiSwiglu E{WSP(bf16_t, WS_ACT), INP(I_MOE_B1) + (size_t)(L) * 32 * 2048}; pg8::gemm_phase<EpiSwiglu, MoeOrder<8, 4, 2>, 2>(ring, S, E, F.wave); SEAM((p0) + 3); } \
    if (IN((p0) + 4)) { const int tt = moe_table(F, (L)); MoeOrder<4, 8, 0> S; int z_ = 0; asm volatile("" : "+s"(z_)); S.tb = (const LAS int*)(F.lds + LDSCTL_OFF + z_); S.A = (const char*)(F.ws + WS_ACT); \
        S.W = (const char*)(F.ws + WS_W2T) + (size_t)(L) * 32 * 1024 * 1024 * 2; S.RI = WSP(const int, WS_ROWIDX); S.G = F.G; S.c = F.bid; S.nwg = ((tt + 7) / 8) * 8 * 4; \
        EpiMoeDown E{WSP(bf16_t, WS_YB), INP(I_MOE_B2) + (size_t)(L) * 32 * 1024}; pg8::gemm_phase<EpiMoeDown, MoeOrder<4, 8, 0>, 0>(ring, S, E, F.wave); SEAM((p0) + 4); } \
    if (IN((p0) + 5)) { pF6_combine(F, args, (L)); SEAM((p0) + 5); }
constexpr int PH_P0 = 0, PH_P1 = 1, PH_LAYER0 = 2, PH_PER_PAIR = 25, PH_COPY = PH_LAYER0 + 2 * PH_PER_PAIR, PH_TOTAL = PH_COPY + 1;
__global__ void __launch_bounds__(NTHREADS, 2) fwd(Args args) {
    extern __shared__ __attribute__((aligned(16))) unsigned char lds_raw[];
    Frame F;
    F.lds = (LAS unsigned char*)lds_raw;
    F.MISC = (volatile LAS unsigned*)(F.lds + MISC_OFF);
    F.tid = threadIdx.x; F.lane = F.tid & 63; F.wave = __builtin_amdgcn_readfirstlane(F.tid >> 6);
    F.G = gridDim.x; F.bid = blockIdx.x; F.gw = F.bid * NWAVES + F.wave; F.NGW = F.G * NWAVES;
    F.ws = (GAS unsigned char*)args.ws; F.ctl = (gu32*)(args.ws + WS_CTL);
    for (int u = F.tid; u < (LDS_BYTES - LDSCTL_OFF) / 4; u += NTHREADS) ((LAS unsigned*)(F.lds + LDSCTL_OFF))[u] = 0u;
    __syncthreads();
    if (F.tid <= N_IN) { const unsigned long long pv = (F.tid < N_IN) ? (unsigned long long)args.in[F.tid] : (unsigned long long)args.out; *(LAS unsigned long long*)(F.lds + PTR_OFF + 8 * F.tid) = pv; }
    __syncthreads();
    XcdBarrier bar = xcd_barrier_post((unsigned*)(F.ctl + CW_BAR) + args.bli * XCD_BAR_WORDS, F.MISC + 8);
    const int lo = args.ph_lo, hi = args.ph_hi;
#define IN(k) (lo <= (k) && (k) < hi && phase_fence(F))
#define SEAM(k) do { if (lo <= (k) + 1 && (k) + 1 < hi) { XcdBarrier b2_ = bar; asm volatile("" : "+s"(b2_.bar), "+s"(b2_.x), "+s"(b2_.w)); xcd_barrier(b2_); } } while (0)
    if (IN(PH_P0)) { p0_prologue(F, args); SEAM(PH_P0); }
    if (IN(PH_P1)) { p1_init(F, args); SEAM(PH_P1); }
    LAS unsigned char* ring = F.lds + RING_OFF;
    for (int lp = 0; lp < 2; ++lp) {
        const int pb = PH_LAYER0 + lp * PH_PER_PAIR;
        if (hi <= pb) break;
        {
            const int layer = 2 * lp, e = lp;
            const unsigned char* swe = (const unsigned char*)F.ws + WS_SMALLW + SW_EV + (size_t)e * EV_BYTES;
            if (IN(pb + 0)) {
                MultiOrder<1> S; S.s[0] = SubGemm{(const char*)(F.ws + WS_HB), (const char*)(swe + EV_WIN), 2048, 1024, 7, 0}; S.init(F.G, F.bid);
                EpiStoreBf16 E{WSP(bf16_t, WS_PROJ), PROJ_LD, PROJ_LD};
                pg8::gemm_phase(ring, S, E, F.wave); SEAM(pb + 0); }
            if (IN(pb + 1)) { pA2_proj_norms(F, args, e); SEAM(pb + 1); }
            if (IN(pb + 2)) {
                MultiOrder<2> S; S.s[0] = SubGemm{(const char*)(F.ws + WS_PROJ) + C_ZQ * 2, (const char*)(swe + EV_WUQ), PROJ_LD * 2, 384, 3, 0};
                S.s[1] = SubGemm{(const char*)(F.ws + WS_PROJ) + C_ZKV * 2, (const char*)(swe + EV_WUKV), PROJ_LD * 2, 256, 4, 1}; S.init(F.G, F.bid);
                EpiStore2 E{WSP(bf16_t, WS_QM), 768, WSP(bf16_t, WS_KVM), 1024};
                pg8::gemm_phase(ring, S, E, F.wave); SEAM(pb + 2); }
            if (IN(pb + 3)) { pA4_mla_norms(F, args, e); SEAM(pb + 3); }
            if (IN(pb + 4)) { pA5_attention(F, lp == 0); SEAM(pb + 4); }
            if (IN(pb + 5)) {
                MultiOrder<1> S; S.s[0] = SubGemm{(const char*)(F.ws + WS_OB), (const char*)(swe + EV_WOUT), 2048, 1024, 4, 0}; S.init(F.G, F.bid);
                EpiResidual E{WSP(bf16_t, WS_XR), WSP(const float, WS_MOD) + (size_t)layer * 9 * 6144 + 2 * 1024};
                pg8::gemm_phase(ring, S, E, F.wave); SEAM(pb + 5); }
            MOE_PHASES(pb + 6, layer)
        }
        {
            const int layer = 2 * lp + 1, jj = lp;
            RWKV_PHASES(pb + 12, layer, jj)
            MOE_PHASES(pb + 19, layer)
        }
    }
    if (IN(PH_COPY)) { p_copy_out(F, args); }
#ifdef MK_SCANVAR
    for (int v_ = 0; v_ < 128; v_ += 64) if (IN(60 + v_)) pR5_scan(F, 1, v_);
#endif
#undef IN
#undef SEAM
}

extern "C" void kernel_launch(void* const* d_in, const int* in_sizes, int n_in, void* d_out, int out_size, void* d_ws, size_t ws_size, hipStream_t stream) {
    static int grid = 0;
    if (grid == 0) {
        if (n_in != N_IN || out_size != NB * SEQ * D || ws_size < WS_END) { fprintf(stderr, "kernel_launch: unexpected shapes: n_in %d out %d ws %zu (need %zu)\n", n_in, out_size, ws_size, (size_t)WS_END); grid = -1; return; }
        int dev = 0, cus = 0, per_cu = 0;
        if (hipGetDevice(&dev) != hipSuccess || hipDeviceGetAttribute(&cus, hipDeviceAttributeMultiprocessorCount, dev) != hipSuccess) { grid = -1; return; }
        if (hipFuncSetAttribute((const void*)fwd, hipFuncAttributeMaxDynamicSharedMemorySize, LDS_BYTES) != hipSuccess) { fprintf(stderr, "kernel_launch: hipFuncSetAttribute failed\n"); grid = -1; return; }
        if (hipOccupancyMaxActiveBlocksPerMultiprocessor(&per_cu, (const void*)fwd, NTHREADS, LDS_BYTES) != hipSuccess || per_cu < 1) { fprintf(stderr, "kernel_launch: occupancy query says %d\n", per_cu); }
        (void)hipGetLastError();
        grid = cus;
        if (grid > 256) grid = 256;
    }
    if (grid < 0) return;
    (void)hipMemsetAsync((char*)d_ws + WS_CTL, 0, CTL_BYTES, stream);
    (void)hipMemsetAsync((char*)d_ws + WS_SMALLW, 0, SMALLW_BYTES, stream);
    Args a{};
    for (int i = 0; i < N_IN; ++i) a.in[i] = (const float*)d_in[i];
    a.out = (float*)d_out; a.ws = (unsigned char*)d_ws;
#ifdef MK_RANGES
    { static const int ranges[][2] = { MK_RANGES };
      for (unsigned i = 0; i < sizeof(ranges) / sizeof(ranges[0]); ++i) { a.ph_lo = ranges[i][0]; a.ph_hi = ranges[i][1]; a.bli = (int)i; hipLaunchKernelGGL(fwd, dim3(grid), dim3(NTHREADS), LDS_BYTES, stream, a); } }
#elif MK_PER_PHASE
    for (int p = 0; p < PH_COPY; ++p) { a.ph_lo = p; a.ph_hi = p + 1; hipLaunchKernelGGL(fwd, dim3(grid), dim3(NTHREADS), LDS_BYTES, stream, a); }
#else
    a.ph_lo = 0; a.ph_hi = PH_COPY;
    hipLaunchKernelGGL(fwd, dim3(grid), dim3(NTHREADS), LDS_BYTES, stream, a);
#endif
}
```

```cpp
#include <hip/hip_runtime.h>
#include <cstdio>
#include <cstdint>

#ifndef MK_PER_PHASE
#define MK_PER_PHASE 0
#endif
#ifndef MK_LAST_PHASE
#define MK_LAST_PHASE 9999
#endif

#define GAS __attribute__((address_space(1)))
#define LAS __attribute__((address_space(3)))
typedef unsigned short bf16_t;
typedef unsigned v4u __attribute__((ext_vector_type(4)));
typedef unsigned v2u __attribute__((ext_vector_type(2)));
typedef float f32x4 __attribute__((ext_vector_type(4)));
typedef float f32x2 __attribute__((ext_vector_type(2)));
typedef float f32x16 __attribute__((ext_vector_type(16)));
typedef short bf16x8 __attribute__((ext_vector_type(8)));
typedef short s16x4 __attribute__((ext_vector_type(4)));
typedef GAS unsigned gu32;
#define RLX_AGENT __ATOMIC_RELAXED, __HIP_MEMORY_SCOPE_AGENT
#define LDS_WAIT() asm volatile("s_waitcnt lgkmcnt(0)" ::: "memory")
#define VM_WAIT() asm volatile("s_waitcnt vmcnt(0)" ::: "memory")

constexpr int D = 1024, NB = 8, SEQ = 4096, CTXL = 256, DEPTH = 4;
constexpr int TPB = SEQ + CTXL;
constexpr int M = NB * TPB;
constexpr int NPANEL = M / 256;
constexpr int NMOD = 6;
constexpr int PROJ_LD = 1792;
constexpr int C_ZQ = 0, C_ZKV = 384, C_ZR = 640, C_GQ = 704, C_GK = 1216, C_GV = 1472;
constexpr int NE = 32, TOPK = 4, FF = 1024;
constexpr int CAP = M;
constexpr float NORM_EPS = 1e-6f, GN_EPS = 64e-5f;
constexpr float MLA_SCALE = 0.07216878364870322f;
constexpr float GQA_SCALE = 0.08838834764831845f;
constexpr int NWAVES = 8, NTHREADS = 512;

enum { I_X = 0, I_C, I_CTX, I_CCTX, I_ADA_W, I_ADA_B, I_NORM_MIX, I_NORM_FFN, I_ATTN_W_IN, I_MLA_Q_NORM, I_MLA_W_UQ, I_MLA_KV_NORM, I_MLA_W_UKV,
       I_MLA_QN_G, I_MLA_QR_G, I_MLA_KN_G, I_MLA_KR_G, I_GQA_Q_G, I_GQA_K_G, I_ATTN_W_OUT, I_RWKV_MIX, I_RWKV_W_R, I_RWKV_W_K, I_RWKV_W_V, I_RWKV_W_O,
       I_RWKV_W0, I_RWKV_W1, I_RWKV_W2, I_RWKV_A0, I_RWKV_A1, I_RWKV_A2, I_RWKV_V0, I_RWKV_V1, I_RWKV_V2, I_RWKV_G1, I_RWKV_G2, I_RWKV_K_K, I_RWKV_K_A,
       I_RWKV_R_K, I_RWKV_LN_W, I_RWKV_LN_B, I_MOE_ROUTER_W, I_MOE_ROUTER_B, I_MOE_W1, I_MOE_B1, I_MOE_W2, I_MOE_B2, N_IN };

constexpr size_t MiB = 1u << 20;
constexpr size_t WS_CTL = 0, CTL_BYTES = 1 * MiB;
constexpr size_t WS_MOD = WS_CTL + CTL_BYTES;
constexpr size_t WS_SMALLW = WS_MOD + 1 * MiB;
constexpr size_t EV_WIN = 0, EV_WUQ = EV_WIN + (size_t)1792 * 1024 * 2, EV_WUKV = EV_WUQ + (size_t)768 * 384 * 2, EV_WOUT = EV_WUKV + (size_t)1024 * 256 * 2,
                 EV_BYTES = EV_WOUT + (size_t)1024 * 1024 * 2;
constexpr size_t OD_WR = 0, OD_WK = OD_WR + 2 * MiB, OD_WV = OD_WK + 2 * MiB, OD_WO = OD_WV + 2 * MiB, OD_W1C = OD_WO + 2 * MiB, OD_A1C = OD_W1C + 512 * 1024,
                 OD_G1 = OD_A1C + 512 * 1024, OD_V1 = OD_G1 + 512 * 1024, OD_W2C = OD_V1 + 512 * 1024, OD_A2C = OD_W2C + 512 * 1024, OD_G2 = OD_A2C + 512 * 1024,
                 OD_V2 = OD_G2 + 256 * 1024, OD_BYTES = OD_V2 + 256 * 1024;
constexpr size_t RT_BYTES = (size_t)256 * 1024 * 2;
constexpr size_t SW_EV = 0, SW_OD = SW_EV + 2 * EV_BYTES, SW_RT = SW_OD + 2 * OD_BYTES, SMALLW_BYTES = ((SW_RT + 4 * RT_BYTES + MiB - 1) / MiB) * MiB;
constexpr size_t WS_W1T = WS_SMALLW + SMALLW_BYTES;
constexpr size_t WS_W2T = WS_W1T + (size_t)128 * 2048 * 1024 * 2;
constexpr size_t WS_XR = WS_W2T + (size_t)128 * 1024 * 1024 * 2;
constexpr size_t ROWB2 = (size_t)M * 1024 * 2;
constexpr size_t WS_HB = WS_XR + 2 * ROWB2;
constexpr size_t WS_OB = WS_HB + ROWB2;
constexpr size_t WS_LOGITS = WS_OB + ROWB2;
constexpr size_t WS_TOPI = WS_LOGITS + (size_t)M * 32 * 4;
constexpr size_t WS_TOPG = WS_TOPI + (size_t)M * 16;
constexpr size_t WS_ROWIDX = WS_TOPG + (size_t)M * 16;
constexpr size_t WS_ACT = ((WS_ROWIDX + (size_t)NE * CAP * 4 + MiB - 1) / MiB) * MiB;
constexpr size_t WS_YB = WS_ACT + 4 * ROWB2;
constexpr size_t WS_MIX = WS_YB + 4 * ROWB2;
constexpr size_t WS_PROJ = WS_MIX;
constexpr size_t WS_QM = WS_PROJ + (size_t)M * PROJ_LD * 2;
constexpr size_t WS_KVM = WS_QM + (size_t)M * 768 * 2;
constexpr size_t WS_ATT_END = WS_KVM + ROWB2;
constexpr size_t WS_XMIX = WS_MIX;
constexpr size_t WS_RB = WS_XMIX + 6 * ROWB2, WS_KB = WS_RB + ROWB2, WS_VB = WS_KB + ROWB2;
constexpr size_t WS_LW = WS_VB + ROWB2, LORA_B = (size_t)M * 128 * 2, WS_LA = WS_LW + LORA_B, WS_LG = WS_LA + LORA_B, WS_LV = WS_LG + LORA_B;
constexpr size_t WS_WDEC = WS_LV + LORA_B;
constexpr size_t WS_AD = WS_WDEC + 4 * ROWB2;
constexpr size_t WS_GB = WS_AD + 2 * ROWB2, WS_VGT = WS_GB + ROWB2;
constexpr size_t WS_KK = WS_VGT + ROWB2, WS_KD = WS_KK + ROWB2, WS_BD = WS_KD + 2 * ROWB2, WS_V2 = WS_BD + 2 * ROWB2;
constexpr size_t WS_YS = WS_V2 + ROWB2;
constexpr size_t WS_RWKV_END = WS_YS + 4 * ROWB2;
constexpr size_t WS_VFIRST = WS_RWKV_END;
constexpr size_t WS_END = WS_VFIRST + ROWB2;
static_assert(WS_ATT_END <= WS_RWKV_END, "mixer scratch overlay");
static_assert(WS_END <= (size_t)4096 * MiB, "d_ws map must fit 4 GiB");

constexpr int CW_TMO = 0, CW_CODE = 1;
constexpr int CW_ECNT = 1024;
constexpr int CW_BAR = 16384;
constexpr int MAX_BAR_REGIONS = 64;
static_assert(CW_ECNT + 4 * 32 * 64 <= CW_BAR && (CW_BAR + MAX_BAR_REGIONS * 3456) * 4 <= (int)CTL_BYTES, "CTL words inside the memset region");

constexpr int RING_OFF = 0, RING_BYTES = 153600;
constexpr int LDSCTL_OFF = RING_BYTES, MISC_OFF = LDSCTL_OFF + 320;
constexpr int LDS_BYTES = RING_BYTES + 4096;
static_assert(MISC_OFF + 128 <= LDS_BYTES, "LDS map");

__device__ __forceinline__ unsigned f2bf(float f) { unsigned u = __builtin_bit_cast(unsigned, f); return (u + 0x7fffu + ((u >> 16) & 1u)) >> 16; }
typedef __bf16 bf16x2_t __attribute__((ext_vector_type(2)));
__device__ __forceinline__ unsigned pk2(float lo, float hi) { const f32x2 v = {lo, hi}; const bf16x2_t b = __builtin_convertvector(v, bf16x2_t); return __builtin_bit_cast(unsigned, b); }
__device__ __forceinline__ float bf2f(unsigned short h) { return __builtin_bit_cast(float, (unsigned)h << 16); }
__device__ __forceinline__ float bflo(unsigned w) { return __builtin_bit_cast(float, w << 16); }
__device__ __forceinline__ float bfhi(unsigned w) { return __builtin_bit_cast(float, w & 0xffff0000u); }
__device__ __forceinline__ int lane_now() { int l; asm volatile("v_mbcnt_lo_u32_b32 %0, -1, 0\n\tv_mbcnt_hi_u32_b32 %0, -1, %0" : "=v"(l)); return l; }
__device__ __forceinline__ int opaque_tid(int wave) { int t = wave * 64 + lane_now(); asm volatile("" : "+v"(t)); return t; }
__device__ __forceinline__ int lanes_get(int v, int src_lane) { return __builtin_amdgcn_ds_bpermute(src_lane << 2, v); }
__device__ __forceinline__ float lanes_xor(float v, int m) { return __builtin_bit_cast(float, __builtin_amdgcn_ds_bpermute((lane_now() ^ m) << 2, __builtin_bit_cast(int, v))); }
__device__ __forceinline__ float dpp_xor1(float x) { return __builtin_bit_cast(float, __builtin_amdgcn_update_dpp(0, __builtin_bit_cast(int, x), 0xB1, 0xF, 0xF, true)); }
__device__ __forceinline__ float dpp_xor2(float x) { return __builtin_bit_cast(float, __builtin_amdgcn_update_dpp(0, __builtin_bit_cast(int, x), 0x4E, 0xF, 0xF, true)); }
__device__ __forceinline__ float dpp_hmir(float x) { return __builtin_bit_cast(float, __builtin_amdgcn_update_dpp(0, __builtin_bit_cast(int, x), 0x141, 0xF, 0xF, true)); }
__device__ __forceinline__ float sum8(float x) { x += dpp_xor1(x); x += dpp_xor2(x); x += dpp_hmir(x); return x; }
__device__ __forceinline__ float dpp_rmir(float x) { return __builtin_bit_cast(float, __builtin_amdgcn_update_dpp(0, __builtin_bit_cast(int, x), 0x140, 0xF, 0xF, true)); }
__device__ __forceinline__ float sum16(float x) { x += dpp_xor1(x); x += dpp_xor2(x); x += dpp_hmir(x); x += dpp_rmir(x); return x; }
__device__ __forceinline__ float wave_sum(float v) {
    const int s = __builtin_bit_cast(int, sum16(v));
    return (__builtin_bit_cast(float, __builtin_amdgcn_readlane(s, 0)) + __builtin_bit_cast(float, __builtin_amdgcn_readlane(s, 16))) + (__builtin_bit_cast(float, __builtin_amdgcn_readlane(s, 32)) + __builtin_bit_cast(float, __builtin_amdgcn_readlane(s, 48)));
}
__device__ __forceinline__ float sigmoidf_(float x) { return __builtin_amdgcn_rcpf(1.f + __expf(-x)); }
__device__ __forceinline__ float siluf_(float x) { return x * __builtin_amdgcn_rcpf(1.f + __expf(-x)); }
#define XB_TMO      128
#define XB_XCNT(j)  (256  + 64 * (j))
#define XB_XSUB(j)  (1280 + 64 * (j))
#define XB_XGEN(j)  (2304 + 64 * (j))
#define XB_TOP      3328
#define XB_TOPGEN   3392
#define XCD_BAR_WORDS 3456
#define XB_SPIN_CAP (1u << 18)

__device__ __forceinline__ unsigned xb_ld(unsigned* p)              { return __hip_atomic_load(p, __ATOMIC_RELAXED, __HIP_MEMORY_SCOPE_AGENT); }
__device__ __forceinline__ unsigned xb_add(unsigned* p, unsigned v) { return __hip_atomic_fetch_add(p, v, __ATOMIC_RELAXED, __HIP_MEMORY_SCOPE_AGENT); }
__device__ __forceinline__ unsigned xb_xcc_id() { return (unsigned)__builtin_amdgcn_s_getreg((3 << 11) | 20) & 0xFu; }
#define XB_SPIN(cond, bar) do { unsigned _sp = 0; while (cond) { __builtin_amdgcn_s_sleep(1); \
    if ((++_sp & 255u) == 0u) { if (xb_ld(&(bar)[XB_TMO])) break; if (_sp > XB_SPIN_CAP) { atomicAdd(&(bar)[XB_TMO], 1u); break; } } } } while (0)

struct XcdBarrier {
    unsigned* bar; unsigned x; int w;
    volatile LAS unsigned* st;
};

__device__ __forceinline__ XcdBarrier xcd_barrier_post(unsigned* bar, volatile LAS unsigned* st) {
    XcdBarrier b; b.bar = bar; b.x = xb_xcc_id(); b.st = st; b.w = __builtin_amdgcn_readfirstlane((int)threadIdx.x >> 6);
    if (threadIdx.x == 0) (void)xb_add(&bar[XB_XCNT(b.x)], 1u);
    return b;
}
__device__ __forceinline__ void xcd_barrier_complete(unsigned* bar, unsigned x, unsigned& nloc, unsigned& nx) {
    const unsigned G = gridDim.x * gridDim.y * gridDim.z;
    unsigned sum, cnt, mine, sp = 0u;
    for (;;) {
        sum = 0u; cnt = 0u; mine = 0u;
#pragma unroll
        for (unsigned j = 0; j < 16; ++j) { const unsigned c = xb_ld(&bar[XB_XCNT(j)]); sum += c; cnt += (c > 0u) ? 1u : 0u; mine = (j == x) ? c : mine; }
        if (sum == G) break;
        __builtin_amdgcn_s_sleep(1);
        if ((++sp & 255u) == 0u) { if (xb_ld(&bar[XB_TMO])) break; if (sp > XB_SPIN_CAP) { atomicAdd(&bar[XB_TMO], 1u); break; } }
    }
    nloc = mine > 0u ? mine : 1u; nx = cnt > 0u ? cnt : 1u;
}

__device__ __forceinline__ void xcd_barrier(const XcdBarrier& b) {
    asm volatile("s_waitcnt vmcnt(0)" ::: "memory");
    __syncthreads();
    if (b.w == 0 && lane_now() == 0) {
        unsigned* bar = b.bar;
        __builtin_amdgcn_s_waitcnt(0);
        unsigned nloc = b.st[0], nx = b.st[1];
        if (nloc == 0u) { xcd_barrier_complete(bar, b.x, nloc, nx); b.st[0] = nloc; b.st[1] = nx; }
        const unsigned old = xb_add(&bar[XB_XSUB(b.x)], 1u);
        const unsigned gen = old / nloc;
        if (old + 1u == (gen + 1u) * nloc) {
            __builtin_amdgcn_fence(__ATOMIC_RELEASE, "agent");
            asm volatile("s_waitcnt vmcnt(0)" ::: "memory");
            const unsigned og = xb_add(&bar[XB_TOP], 1u);
            const unsigned tg = og / nx;
            if (og + 1u == (tg + 1u) * nx) xb_add(&bar[XB_TOPGEN], 1u);
            else XB_SPIN(xb_ld(&bar[XB_TOPGEN]) == tg, bar);
            __builtin_amdgcn_fence(__ATOMIC_ACQUIRE, "agent");
            xb_add(&bar[XB_XGEN(b.x)], 1u);
            asm volatile("s_waitcnt vmcnt(0)" ::: "memory");
        } else {
            XB_SPIN(xb_ld(&bar[XB_XGEN(b.x)]) == gen, bar);
            __builtin_amdgcn_fence(__ATOMIC_ACQUIRE, "agent");
            asm volatile("s_waitcnt vmcnt(0)" ::: "memory");
        }
    }
    __syncthreads();
}
namespace pg8 {
constexpr int BM = 256, BK = 64, HALF = 128, HTB = HALF * BK * 2  , STAGE_BYTES = 8 * HTB, IDX_OFF = STAGE_BYTES  ,
              TAB_OFF = IDX_OFF + 16384  ;

__host__ __device__ __forceinline__ int lds_byte(int r, int c) { const int st = (r >> 4) * 2 + (c >> 5), rr = r & 15, cc = c & 31, ob = rr * 64 + cc * 2; return st * 1024 + (ob ^ (((ob >> 9) & 1) << 5)); }
__host__ __device__ __forceinline__ void stage_rc(int b, int& R, int& C) { const int st = b / 1024, sb = b % 1024, swz = sb ^ (((sb >> 9) & 1) << 5); R = (st >> 1) * 16 + swz / 64; C = (st & 1) * 32 + (swz % 64) / 2; }
__host__ __device__ __forceinline__ int perm32(int rho) { const int n = rho >> 4, i = rho & 15; return 8 * (i >> 2) + 4 * n + (i & 3); }

struct Unit {
    const char* A; const char* B;
    int lda;
    int K;
    int pm, pn;
    int kind;
    int e;
    int nrows;
    const int* ridx;
};

__device__ __forceinline__ int rfl(int v) { return __builtin_amdgcn_readfirstlane(v); }
template <class T> __device__ __forceinline__ T* rflp(T* p) { const unsigned long long v = (unsigned long long)p; const unsigned lo = __builtin_amdgcn_readfirstlane((unsigned)v), hi = __builtin_amdgcn_readfirstlane((unsigned)(v >> 32));
    return (T*)(((unsigned long long)hi << 32) | lo); }
__device__ __forceinline__ void uniformize(Unit& u) { u.A = rflp(u.A); u.B = rflp(u.B); u.lda = rfl(u.lda); u.K = rfl(u.K); u.pm = rfl(u.pm); u.pn = rfl(u.pn); u.kind = rfl(u.kind); u.e = rfl(u.e); u.nrows = rfl(u.nrows); u.ridx = rflp(u.ridx); }
__device__ __forceinline__ unsigned cvt_pk_bf16(float lo, float hi) { unsigned r; asm volatile("v_cvt_pk_bf16_f32 %0, %1, %2" : "=v"(r) : "v"(lo), "v"(hi)); return r; }

template <class T, class = void> struct epi_has_tab { static constexpr bool value = false; };
template <class T> struct epi_has_tab<T, decltype((void)T::HAS_TAB)> { static constexpr bool value = true; };
template <class Epi, bool PRE = false>
__device__ __forceinline__ void run_epilogue(const Epi& E, const f32x4 (&acc)[2][2][4][2], const Unit& u, int wr, int wc, int fr, int fq, const LAS unsigned char* tab = nullptr) {
    typename Epi::Ctx c;
    const int lrow0 = wr * 64 + fr, lcol0 = wc * 32 + 8 * fq;
    if constexpr (PRE) E.begin_pre(c, u, lrow0, lcol0, tab); else E.begin(c, u, lrow0, lcol0);
#pragma unroll
    for (int ai = 0; ai < 2; ++ai) {
        E.begin_half(c, u, ai, lrow0, lcol0);
#pragma unroll
        for (int m = 0; m < 4; ++m)
#pragma unroll
            for (int bj = 0; bj < 2; ++bj) E.row8(c, u, ai * 4 + m, bj, lrow0 + ai * HALF + m * 16, lcol0 + bj * HALF, acc[ai][bj][m][0], acc[ai][bj][m][1]);
    }
}

template <class Epi, class Sched, int GSH = -1>
__device__ __forceinline__ void gemm_phase(LAS unsigned char* lds, const Sched& S, const Epi& E, int wave_) {
    const int tid = opaque_tid(wave_), wid = __builtin_amdgcn_readfirstlane(tid >> 6), lane = tid & 63, wr = wid >> 2, wc = wid & 3, fr = lane & 15, fq = lane >> 4;
    int R0, C0, R1, C1; stage_rc(tid * 16, R0, C0); stage_rc(tid * 16 + 8192, R1, C1);
    const int Rb0 = (R0 & ~31) + perm32(R0 & 31), Rb1 = (R1 & ~31) + perm32(R1 & 31);
    const unsigned ldsw = (unsigned)wid * 1024u;
    const int aoff = lds_byte(wr * 64 + fr, fq * 8), boff = lds_byte(wc * 32 + fr, fq * 8);
#define PG8_SA(b, h) (((b) * 2 + (h)) * HTB)
#define PG8_SB(b, h) ((4 + (b) * 2 + (h)) * HTB)
#define PG8_STAGE2(bufoff, gbase, o0, o1) do { \
        __builtin_amdgcn_global_load_lds((const unsigned*)((const char*)(gbase) + (o0)), (LAS unsigned*)(lds + (bufoff) + ldsw), 16, 0, 0); \
        __builtin_amdgcn_global_load_lds((const unsigned*)((const char*)(gbase) + (o1)), (LAS unsigned*)(lds + (bufoff) + ldsw + 8192), 16, 0, 0); } while (0)
#define PG8_LDA(dst, b, h) do { _Pragma("unroll") for (int m = 0; m < 4; ++m) _Pragma("unroll") for (int k = 0; k < 2; ++k) dst[m][k] = *(const LAS bf16x8*)(lds + PG8_SA(b, h) + aoff + m * 2048 + k * 1024); } while (0)
#define PG8_LDB(dst, b, h) do { _Pragma("unroll") for (int n = 0; n < 2; ++n) _Pragma("unroll") for (int k = 0; k < 2; ++k) dst[n][k] = *(const LAS bf16x8*)(lds + PG8_SB(b, h) + boff + n * 2048 + k * 1024); } while (0)
#define PG8_MMA(ai, bj, At, Bt) do { __builtin_amdgcn_s_setprio(1); _Pragma("unroll") for (int m = 0; m < 4; ++m) _Pragma("unroll") for (int n = 0; n < 2; ++n) _Pragma("unroll") for (int k = 0; k < 2; ++k) \
        acc[ai][bj][m][n] = __builtin_amdgcn_mfma_f32_16x16x32_bf16(Bt[n][k], At[m][k], acc[ai][bj][m][n], 0, 0, 0); __builtin_amdgcn_s_setprio(0); } while (0)
#define PG8_WAIT_V(n) asm volatile("s_waitcnt vmcnt(" #n ")" ::: "memory")
#define PG8_WAIT_L(n) asm volatile("s_waitcnt lgkmcnt(" #n ")" ::: "memory")
#define PG8_BAR __builtin_amdgcn_s_barrier()
#define PG8_SCHED __builtin_amdgcn_sched_barrier(0)
#define PG8_OFFS(u, a00, a01, a10, a11, b0, b1, hs) do { \
        if constexpr (GSH >= 0) { \
            const int i00 = (R0 < (u).nrows) ? (u).ridx[R0] : 0, i01 = (R1 < (u).nrows) ? (u).ridx[R1] : 0; \
            const int i10 = (HALF + R0 < (u).nrows) ? (u).ridx[HALF + R0] : 0, i11 = (HALF + R1 < (u).nrows) ? (u).ridx[HALF + R1] : 0; \
            a00 = (unsigned)(i00 >> GSH) * (unsigned)(u).lda + C0 * 2; a01 = (unsigned)(i01 >> GSH) * (unsigned)(u).lda + C1 * 2; \
            a10 = (unsigned)(i10 >> GSH) * (unsigned)(u).lda + C0 * 2; a11 = (unsigned)(i11 >> GSH) * (unsigned)(u).lda + C1 * 2; \
        } else { \
            const unsigned rb = (unsigned)((u).pm * BM) * (unsigned)(u).lda; \
            a00 = rb + (unsigned)R0 * (unsigned)(u).lda + C0 * 2; a01 = rb + (unsigned)R1 * (unsigned)(u).lda + C1 * 2; \
            a10 = a00 + (unsigned)HALF * (unsigned)(u).lda; a11 = a01 + (unsigned)HALF * (unsigned)(u).lda; } \
        b0 = (unsigned)(Rb0 * (u).K + C0) * 2u; b1 = (unsigned)(Rb1 * (u).K + C1) * 2u; hs = (unsigned)HALF * (unsigned)(u).K * 2u; } while (0)
    Unit cur, nxt; int ui = 0;
    if (!S.next(0, cur)) return;
    uniformize(cur);
    f32x4 acc[2][2][4][2];
#pragma unroll
    for (int a = 0; a < 2; ++a)
#pragma unroll
        for (int b = 0; b < 2; ++b)
#pragma unroll
            for (int m = 0; m < 4; ++m)
#pragma unroll
                for (int n = 0; n < 2; ++n) acc[a][b][m][n] = (f32x4){0.f, 0.f, 0.f, 0.f};
    bf16x8 At[4][2], B0[2][2], B1[2][2];
    unsigned ca00, ca01, ca10, ca11, cb0, cb1, chs;
    unsigned na00, na01, na10, na11, nb0, nb1, nhs;
    PG8_OFFS(cur, ca00, ca01, ca10, ca11, cb0, cb1, chs);
    const char* cA = cur.A; const char* cB = cur.B;
    constexpr unsigned kstep = BK * 2;
    PG8_STAGE2(PG8_SB(0, 0), cB, cb0, cb1); PG8_STAGE2(PG8_SB(0, 1), cB + chs, cb0, cb1); PG8_STAGE2(PG8_SA(0, 0), cA, ca00, ca01); PG8_STAGE2(PG8_SA(0, 1), cA, ca10, ca11);
    if (wr == 1) PG8_BAR;
    PG8_WAIT_V(2); PG8_BAR;
    PG8_STAGE2(PG8_SB(1, 0), cB + kstep, cb0, cb1); PG8_STAGE2(PG8_SA(1, 0), cA + kstep, ca00, ca01); PG8_STAGE2(PG8_SB(1, 1), cB + chs + kstep, cb0, cb1);
    PG8_WAIT_V(6); PG8_BAR;
    for (;;) {
        if constexpr (GSH >= 0) {
            LAS unsigned char* tb = lds + TAB_OFF + (ui & 1) * 2048;
            if (wid < 4) __builtin_amdgcn_global_load_lds((const unsigned*)(cur.ridx + wid * 64 + lane), (LAS unsigned*)(tb + wid * 256), 4, 0, 0);
            else __builtin_amdgcn_global_load_lds((const unsigned*)(E.bias_of(cur) + (wid - 4) * 64 + lane), (LAS unsigned*)(tb + 1024 + (wid - 4) * 256), 4, 0, 0);
        }
        else if constexpr (epi_has_tab<Epi>::value) {
            if (wid >= 4) __builtin_amdgcn_global_load_lds((const unsigned*)(E.bias_of(cur) + (wid - 4) * 64 + lane), (LAS unsigned*)(lds + TAB_OFF + (ui & 1) * 2048 + 1024 + (wid - 4) * 256), 4, 0, 0);
        }
        const bool has_next = S.next(ui + 1, nxt); uniformize(nxt);
        const char* nA = cA; const char* nB = cB; na00 = ca00; na01 = ca01; na10 = ca10; na11 = ca11; nb0 = cb0; nb1 = cb1; nhs = chs;
        if (has_next) { nA = nxt.A; nB = nxt.B;
            if constexpr (GSH >= 0) {
                nb0 = (unsigned)(Rb0 * nxt.K + C0) * 2u; nb1 = (unsigned)(Rb1 * nxt.K + C1) * 2u; nhs = (unsigned)HALF * (unsigned)nxt.K * 2u;
                LAS unsigned char* ib = lds + IDX_OFF + (ui & 1) * 8192 + wid * 1024;
                __builtin_amdgcn_global_load_lds((const unsigned*)(nxt.ridx + R0), (LAS unsigned*)(ib), 4, 0, 0);
                __builtin_amdgcn_global_load_lds((const unsigned*)(nxt.ridx + R1), (LAS unsigned*)(ib + 256), 4, 0, 0);
                __builtin_amdgcn_global_load_lds((const unsigned*)(nxt.ridx + HALF + R0), (LAS unsigned*)(ib + 512), 4, 0, 0);
                __builtin_amdgcn_global_load_lds((const unsigned*)(nxt.ridx + HALF + R1), (LAS unsigned*)(ib + 768), 4, 0, 0);
            } else { PG8_OFFS(nxt, na00, na01, na10, na11, nb0, nb1, nhs); } }
        const int nt = cur.K / BK;
        for (int t = 0; t < nt; t += 2) {
            const bool last = (t == nt - 2);
            if constexpr (GSH >= 0) { if (last && has_next) {
                const LAS unsigned char* ib = lds + IDX_OFF + (ui & 1) * 8192 + wid * 1024 + lane * 4;
                int i00 = *(const LAS int*)(ib), i01 = *(const LAS int*)(ib + 256), i10 = *(const LAS int*)(ib + 512), i11 = *(const LAS int*)(ib + 768);
                i00 = (R0 < nxt.nrows) ? i00 : 0; i01 = (R1 < nxt.nrows) ? i01 : 0; i10 = (HALF + R0 < nxt.nrows) ? i10 : 0; i11 = (HALF + R1 < nxt.nrows) ? i11 : 0;
                na00 = (unsigned)(i00 >> GSH) * (unsigned)nxt.lda + C0 * 2; na01 = (unsigned)(i01 >> GSH) * (unsigned)nxt.lda + C1 * 2;
                na10 = (unsigned)(i10 >> GSH) * (unsigned)nxt.lda + C0 * 2; na11 = (unsigned)(i11 >> GSH) * (unsigned)nxt.lda + C1 * 2; } }
            const char* a1 = cA + (size_t)(t + 1) * kstep;
            const char* a2 = last ? nA : cA + (size_t)(t + 2) * kstep; const char* b2 = last ? nB : cB + (size_t)(t + 2) * kstep;
            const char* a3 = a2 + kstep; const char* b3 = b2 + kstep;
            const unsigned xa00 = last ? na00 : ca00, xa01 = last ? na01 : ca01, xa10 = last ? na10 : ca10, xa11 = last ? na11 : ca11;
            const unsigned xb0 = last ? nb0 : cb0, xb1 = last ? nb1 : cb1, xhs = last ? nhs : chs;
            PG8_LDB(B0, 0, 0); PG8_LDB(B1, 0, 1); PG8_SCHED; PG8_LDA(At, 0, 0); PG8_STAGE2(PG8_SA(1, 1), a1, ca10, ca11);
            PG8_WAIT_V(8); PG8_WAIT_L(0); PG8_BAR; PG8_MMA(0, 0, At, B0); PG8_MMA(0, 1, At, B1); PG8_BAR; PG8_SCHED;
            PG8_LDA(At, 0, 1); PG8_STAGE2(PG8_SB(0, 0), b2, xb0, xb1); PG8_STAGE2(PG8_SB(0, 1), b2 + xhs, xb0, xb1); PG8_STAGE2(PG8_SA(0, 0), a2, xa00, xa01);
            PG8_WAIT_V(8); PG8_WAIT_L(0); PG8_BAR; PG8_MMA(1, 0, At, B0); PG8_MMA(1, 1, At, B1); PG8_BAR; PG8_SCHED;
            PG8_LDB(B0, 1, 0); PG8_LDB(B1, 1, 1); PG8_SCHED; PG8_LDA(At, 1, 0); PG8_STAGE2(PG8_SA(0, 1), a2, xa10, xa11);
            PG8_WAIT_V(8); PG8_WAIT_L(0); PG8_BAR; PG8_MMA(0, 0, At, B0); PG8_MMA(0, 1, At, B1); PG8_BAR; PG8_SCHED;
            PG8_LDA(At, 1, 1); PG8_STAGE2(PG8_SB(1, 0), b3, xb0, xb1); PG8_STAGE2(PG8_SB(1, 1), b3 + xhs, xb0, xb1); PG8_STAGE2(PG8_SA(1, 0), a3, xa00, xa01);
            PG8_WAIT_V(8); PG8_WAIT_L(0); PG8_BAR; PG8_MMA(1, 0, At, B0); PG8_MMA(1, 1, At, B1); PG8_BAR; PG8_SCHED;
        }
        if (wr == 0) PG8_BAR;
        if constexpr (GSH >= 0 || epi_has_tab<Epi>::value) run_epilogue<Epi, true>(E, acc, cur, wr, wc, fr, fq, lds + TAB_OFF + (ui & 1) * 2048); else run_epilogue(E, acc, cur, wr, wc, fr, fq);
        if (!has_next) break;
#pragma unroll
        for (int a = 0; a < 2; ++a)
#pragma unroll
            for (int b = 0; b < 2; ++b)
#pragma unroll
                for (int m = 0; m < 4; ++m)
#pragma unroll
                    for (int n = 0; n < 2; ++n) acc[a][b][m][n] = (f32x4){0.f, 0.f, 0.f, 0.f};
        cur = nxt; cA = nA; cB = nB; ca00 = na00; ca01 = na01; ca10 = na10; ca11 = na11; cb0 = nb0; cb1 = nb1; chs = nhs; ++ui;
        if (wr == 1) PG8_BAR;
    }
    PG8_WAIT_V(0);
    PG8_BAR;
#undef PG8_SA
#undef PG8_SB
#undef PG8_STAGE2
#undef PG8_LDA
#undef PG8_LDB
#undef PG8_MMA
#undef PG8_WAIT_V
#undef PG8_WAIT_L
#undef PG8_BAR
#undef PG8_SCHED
#undef PG8_OFFS
}
}
namespace att {
constexpr int NW = 8, QBLK = 32, KVBLK = 64;
constexpr float THR = 8.f;
constexpr int SHM_V = KVBLK * 128 * 2, SHM_K = KVBLK * 128 * 2, SHM_R = KVBLK * 64 * 2;
constexpr int OFF_V = 0, OFF_K = 2 * SHM_V, OFF_R = OFF_K + 2 * SHM_K, OFF_WS = OFF_R + 2 * SHM_R, OFF_QR = OFF_WS + NW * 64 * 4, ATTN_LDS_GQA = OFF_QR, QL_MAX = 8, ATTN_LDS = OFF_QR + NW * QL_MAX * 1024;
#define KSWZ(row, colB) ((row) * 256 + ((colB) ^ (((row) & 7) << 4)))
#define RSWZ(row, colB) ((row) * 128 + ((colB) ^ ((((row) >> 1) & 7) << 4)))
#define SBAR() __builtin_amdgcn_sched_barrier(0)
__device__ __forceinline__ int crow(int r, int hi) { return (r & 3) + 8 * (r >> 2) + 4 * hi; }
__device__ __forceinline__ unsigned cvtpk(float lo, float hi) { unsigned r; asm volatile("v_cvt_pk_bf16_f32 %0, %1, %2" : "=v"(r) : "v"(lo), "v"(hi)); return r; }

template <int DK>
__device__ __forceinline__ void partialSM(f32x16& p0, f32x16& p1, float& m_reg, float& mn, float& alpha) {
  constexpr float SCALE = (DK == 192) ? MLA_SCALE : GQA_SCALE;
  constexpr float C = SCALE * 1.4426950408889634f;
  float pmax = p0[0];
#pragma unroll
  for (int r = 1; r < 16; ++r) pmax = fmaxf(pmax, p0[r]);
#pragma unroll
  for (int r = 0; r < 16; ++r) pmax = fmaxf(pmax, p1[r]);
  { auto rr = __builtin_amdgcn_permlane32_swap(__float_as_uint(pmax), __float_as_uint(pmax), false, false);
    pmax = fmaxf(__uint_as_float(rr[0]), __uint_as_float(rr[1])); }
  if (__builtin_expect(__all(pmax - m_reg <= THR / SCALE), 1)) { mn = m_reg; alpha = 1.f; }
  else { mn = fmaxf(m_reg, pmax); alpha = __builtin_amdgcn_exp2f((m_reg - mn) * C); m_reg = mn; }
  float mnC = -mn * C;
#pragma unroll
  for (int r = 0; r < 16; ++r) p0[r] = fmaf(p0[r], C, mnC);
#pragma unroll
  for (int r = 0; r < 16; ++r) p1[r] = fmaf(p1[r], C, mnC);
#pragma unroll
  for (int r = 0; r < 16; ++r) p0[r] = __builtin_amdgcn_exp2f(p0[r]);
}
__device__ __forceinline__ void finishSM(f32x16& p0, f32x16& p1, float alpha, float& l_reg, bf16x8& pa0, bf16x8& pa1, bf16x8& pa2, bf16x8& pa3) {
#pragma unroll
  for (int r = 0; r < 16; ++r) p1[r] = __builtin_amdgcn_exp2f(p1[r]);
  float ps = 0;
#pragma unroll
  for (int r = 0; r < 16; ++r) ps += p0[r];
#pragma unroll
  for (int r = 0; r < 16; ++r) ps += p1[r];
  { auto rr = __builtin_amdgcn_permlane32_swap(__float_as_uint(ps), __float_as_uint(ps), false, false);
    ps = __uint_as_float(rr[0]) + __uint_as_float(rr[1]); }
  l_reg = l_reg * alpha + ps;
#define PK4(P, BASE, OUT) do { unsigned a0 = cvtpk(P[BASE + 0], P[BASE + 1]), a1 = cvtpk(P[BASE + 2], P[BASE + 3]);   \
    unsigned b0 = cvtpk(P[BASE + 4], P[BASE + 5]), b1 = cvtpk(P[BASE + 6], P[BASE + 7]);                              \
    auto r0 = __builtin_amdgcn_permlane32_swap(a0, b0, false, false); auto r1 = __builtin_amdgcn_permlane32_swap(a1, b1, false, false); \
    v4u w = {r0[0], r1[0], r0[1], r1[1]}; OUT = __builtin_bit_cast(bf16x8, w); } while (0)
  PK4(p0, 0, pa0); PK4(p0, 8, pa1); PK4(p1, 0, pa2); PK4(p1, 8, pa3);
#undef PK4
}
template <int DK, int QREG, bool QSB = (DK == 192)>
__device__ __forceinline__ void qkt(f32x16& p0, f32x16& p1, const char* Ks, const char* Rs, const bf16x8* qr, const char* Qrl, int r32, int hi) {
  p0 = f32x16{}; p1 = f32x16{};
#pragma unroll
  for (int d0 = 0; d0 < 8; ++d0) { const int cb = (d0 * 16 + hi * 8) * 2;
    bf16x8 b0 = *reinterpret_cast<const bf16x8*>(Ks + KSWZ(r32, cb));
    bf16x8 b1 = *reinterpret_cast<const bf16x8*>(Ks + KSWZ(32 + r32, cb));
    bf16x8 qf; if constexpr (true) { if (d0 < QREG) qf = qr[d0 < QREG ? d0 : 0]; else qf = *reinterpret_cast<const bf16x8*>(Qrl + (d0 - QREG) * (NW * 1024)); }
    p0 = __builtin_amdgcn_mfma_f32_32x32x16_bf16(b0, qf, p0, 0, 0, 0);
    p1 = __builtin_amdgcn_mfma_f32_32x32x16_bf16(b1, qf, p1, 0, 0, 0);
    if (QSB && (d0 & 3) == 3) SBAR(); }
  if constexpr (DK == 192) {
#pragma unroll
    for (int d0 = 0; d0 < 4; ++d0) { const int cb = (d0 * 16 + hi * 8) * 2;
      bf16x8 b0 = *reinterpret_cast<const bf16x8*>(Rs + RSWZ(r32, cb));
      bf16x8 b1 = *reinterpret_cast<const bf16x8*>(Rs + RSWZ(32 + r32, cb));
      const bf16x8 qf = *reinterpret_cast<const bf16x8*>(Qrl + (8 + d0 - QREG) * (NW * 1024));
      p0 = __builtin_amdgcn_mfma_f32_32x32x16_bf16(b0, qf, p0, 0, 0, 0);
      p1 = __builtin_amdgcn_mfma_f32_32x32x16_bf16(b1, qf, p1, 0, 0, 0); }
  }
}
__device__ __forceinline__ int v_st(int k, int c) { const int kk = (k & ~0xC) | ((k & 4) << 1) | ((k & 8) >> 1); return ((kk >> 3) * 4 + (c >> 5)) * 512 + ((kk & 7) * 32 + (c & 31)) * 2; }
__device__ __forceinline__ int v_rd_base(int lane) { return ((lane & 3) << 3) | (((lane >> 2) & 3) << 6) | (((lane >> 4) & 1) << 5) | (((lane >> 5) & 1) << 8); }
constexpr int v_rd_off(int d0, int ks, int half) { return d0 * 512 + ks * 4096 + half * 2048; }
template <int OFF> __device__ __forceinline__ s16x4 tr_read(int vb) {
  s16x4 r; asm volatile("ds_read_b64_tr_b16 %0, %1 offset:%2" : "=&v"(r) : "v"(vb), "i"(OFF) : "memory"); return r;
}
template <int D0> __device__ __forceinline__ void pv_one(f32x16& od, int vb, bf16x8 pa0, bf16x8 pa1, bf16x8 pa2, bf16x8 pa3) {
  const s16x4 l0 = tr_read<v_rd_off(D0, 0, 0)>(vb), h0 = tr_read<v_rd_off(D0, 0, 1)>(vb), l1 = tr_read<v_rd_off(D0, 1, 0)>(vb), h1 = tr_read<v_rd_off(D0, 1, 1)>(vb);
  const s16x4 l2 = tr_read<v_rd_off(D0, 2, 0)>(vb), h2 = tr_read<v_rd_off(D0, 2, 1)>(vb), l3 = tr_read<v_rd_off(D0, 3, 0)>(vb), h3 = tr_read<v_rd_off(D0, 3, 1)>(vb);
  asm volatile("s_waitcnt lgkmcnt(0)" ::: "memory"); SBAR();
#define PK(L, H) (bf16x8){L[0], L[1], L[2], L[3], H[0], H[1], H[2], H[3]}
  od = __builtin_amdgcn_mfma_f32_32x32x16_bf16(pa0, PK(l0, h0), od, 0, 0, 0);
  od = __builtin_amdgcn_mfma_f32_32x32x16_bf16(pa1, PK(l1, h1), od, 0, 0, 0);
  od = __builtin_amdgcn_mfma_f32_32x32x16_bf16(pa2, PK(l2, h2), od, 0, 0, 0);
  od = __builtin_amdgcn_mfma_f32_32x32x16_bf16(pa3, PK(l3, h3), od, 0, 0, 0);
#undef PK
}
__device__ __forceinline__ void pv_d0(f32x16* o, int vb, bf16x8 pa0, bf16x8 pa1, bf16x8 pa2, bf16x8 pa3) {
  pv_one<0>(o[0], vb, pa0, pa1, pa2, pa3); pv_one<1>(o[1], vb, pa0, pa1, pa2, pa3); pv_one<2>(o[2], vb, pa0, pa1, pa2, pa3); pv_one<3>(o[3], vb, pa0, pa1, pa2, pa3);
}

template <int DK, int SDEPTH, int QREG, int LDQ, int LDK, int LDR, int LDV, int LDO>
__device__ __forceinline__ void attn_unit(const bf16_t* __restrict__ Qb, const bf16_t* __restrict__ Kh, const bf16_t* __restrict__ Rh,
                                          const bf16_t* __restrict__ Vh, bf16_t* __restrict__ Ob, int seq, char* lds, int wave_) {
  const int tid = opaque_tid(wave_), wid = tid >> 6, lane = tid & 63, r32 = lane & 31, hi = lane >> 5;
  char* V_lds = lds + OFF_V; char* K_lds = lds + OFF_K; char* R_lds = lds + OFF_R;
  float* ws = (float*)(lds + OFF_WS) + wid * 64; float* li_l = ws; float* al_l = ws + 32;
  float m_reg = -1e30f, l_reg = 0; f32x16 o[4] = {}; bf16x8 qr[QREG];
  static_assert(DK / 16 - QREG <= QL_MAX, "q fragments in LDS");
  char* Qrl = lds + OFF_QR + wid * 1024 + lane * 16;
  const bf16_t* Qw = Qb + (long)(wid * QBLK + r32) * LDQ + hi * 8;
#pragma unroll
  for (int d0 = 0; d0 < QREG; ++d0) qr[d0] = *reinterpret_cast<const bf16x8*>(Qw + d0 * 16);
#pragma unroll
  for (int d0 = QREG; d0 < DK / 16; ++d0) *reinterpret_cast<bf16x8*>(Qrl + (d0 - QREG) * (NW * 1024)) = *reinterpret_cast<const bf16x8*>(Qw + d0 * 16);
  const int sr = tid >> 4, sc = (tid & 15) * 8, vst0 = v_st(sr, sc), vst1 = v_st(32 + sr, sc);
  const int rr_ = tid >> 3, rc_ = (tid & 7) * 8;
  const int vb0 = (int)(uintptr_t)V_lds + v_rd_base(lane);
  struct { bf16x8 vs0, vs1, ks0, ks1; } sr_[SDEPTH];
  bf16x8 rs_[SDEPTH];
  const unsigned voV = (unsigned)(sr * LDV + sc) * 2u, voK = (unsigned)(sr * LDK + sc) * 2u, voR = (unsigned)(rr_ * LDR + rc_) * 2u;
#define GLD(base, uoff, voff) (*reinterpret_cast<const bf16x8*>((const char*)(base) + (size_t)(uoff) + (voff)))
#define SLOAD(i, k0) do { sr_[i].vs0 = GLD(Vh, (size_t)(k0) * LDV * 2, voV); sr_[i].vs1 = GLD(Vh, (size_t)((k0) + 32) * LDV * 2, voV); \
    sr_[i].ks0 = GLD(Kh, (size_t)(k0) * LDK * 2, voK); sr_[i].ks1 = GLD(Kh, (size_t)((k0) + 32) * LDK * 2, voK); \
    if constexpr (DK == 192) rs_[i] = GLD(Rh, (size_t)(k0) * LDR * 2, voR); } while (0)
#define SWRITE(b, i) do { *(bf16x8*)(V_lds + (b) * SHM_V + vst0) = sr_[i].vs0;          \
    *(bf16x8*)(V_lds + (b) * SHM_V + vst1) = sr_[i].vs1; const int kc = sc * 2;               \
    *(bf16x8*)(K_lds + (b) * SHM_K + KSWZ(sr, kc)) = sr_[i].ks0;                       \
    *(bf16x8*)(K_lds + (b) * SHM_K + KSWZ(32 + sr, kc)) = sr_[i].ks1;                  \
    if constexpr (DK == 192) *(bf16x8*)(R_lds + (b) * SHM_R + RSWZ(rr_, rc_ * 2)) = rs_[i]; } while (0)
#define SWAIT() do { if constexpr (SDEPTH == 2) { if constexpr (DK == 192) asm volatile("s_waitcnt vmcnt(5)" ::: "memory"); else asm volatile("s_waitcnt vmcnt(4)" ::: "memory"); } \
    else asm volatile("s_waitcnt vmcnt(0)" ::: "memory"); } while (0)
#define RESC(a) do { if (__any((a) < 1.f)) { if (hi == 0) al_l[r32] = (a); asm volatile("s_waitcnt lgkmcnt(0)" ::: "memory"); \
    _Pragma("unroll") for (int d = 0; d < 4; ++d) _Pragma("unroll") for (int r = 0; r < 16; ++r) o[d][r] *= al_l[crow(r, hi)]; } } while (0)
  f32x16 pA0, pA1, pB0, pB1; float mnA, mnB, alA, alB; bf16x8 pa0, pa1, pa2, pa3; const int NT = seq / KVBLK;
  constexpr int SE = 0, SO = SDEPTH - 1;
  SLOAD(SE, 0); asm volatile("s_waitcnt vmcnt(0)" ::: "memory"); SWRITE(0, SE); __syncthreads();
  qkt<DK, QREG>(pA0, pA1, K_lds, R_lds, qr, Qrl, r32, hi); partialSM<DK>(pA0, pA1, m_reg, mnA, alA);
  SLOAD(SO, KVBLK); if constexpr (SDEPTH == 2) { if (2 < NT) SLOAD(SE, 2 * KVBLK); }
  SWAIT(); SWRITE(1, SO); __syncthreads();
  for (int j = 1; j + 1 < NT; j += 2) {
    SBAR(); qkt<DK, QREG>(pB0, pB1, K_lds + SHM_K, R_lds + SHM_R, qr, Qrl, r32, hi);
    finishSM(pA0, pA1, alA, l_reg, pa0, pa1, pa2, pa3); SBAR();
    SLOAD(SO, (j + SDEPTH) * KVBLK); SBAR();
    pv_d0(o, vb0, pa0, pa1, pa2, pa3); partialSM<DK>(pB0, pB1, m_reg, mnB, alB);
    __syncthreads(); SWAIT(); SWRITE(0, SE);
    RESC(alB); __syncthreads();
    SBAR(); qkt<DK, QREG>(pA0, pA1, K_lds, R_lds, qr, Qrl, r32, hi);
    finishSM(pB0, pB1, alB, l_reg, pa0, pa1, pa2, pa3); SBAR();
    if (SDEPTH == 1 || j + 3 < NT) SLOAD(SE, (j + 1 + SDEPTH) * KVBLK); SBAR();
    pv_d0(o, vb0 + (int)SHM_V, pa0, pa1, pa2, pa3); partialSM<DK>(pA0, pA1, m_reg, mnA, alA);
    __syncthreads(); SWAIT(); SWRITE(1, SO);
    RESC(alA); __syncthreads();
  }
  SBAR(); qkt<DK, QREG>(pB0, pB1, K_lds + SHM_K, R_lds + SHM_R, qr, Qrl, r32, hi);
  finishSM(pA0, pA1, alA, l_reg, pa0, pa1, pa2, pa3); SBAR();
  pv_d0(o, vb0, pa0, pa1, pa2, pa3); partialSM<DK>(pB0, pB1, m_reg, mnB, alB);
  __syncthreads(); RESC(alB);
  finishSM(pB0, pB1, alB, l_reg, pa0, pa1, pa2, pa3); SBAR();
  pv_d0(o, vb0 + (int)SHM_V, pa0, pa1, pa2, pa3);
  if (hi == 0) li_l[r32] = l_reg; asm volatile("s_waitcnt lgkmcnt(0)" ::: "memory");
  float rli[16];
#pragma unroll
  for (int r = 0; r < 16; ++r) rli[r] = __builtin_amdgcn_rcpf(li_l[crow(r, hi)]);
  bf16_t* Ow = Ob + (long)(wid * QBLK) * LDO;
#pragma unroll
  for (int r = 0; r < 16; ++r) { const int orow = crow(r, hi);
#pragma unroll
    for (int d0 = 0; d0 < 4; ++d0) Ow[(long)orow * LDO + d0 * 32 + r32] = (bf16_t)f2bf(o[d0][r] * rli[r]); }
  __syncthreads();
#undef SLOAD
#undef GLD
#undef SWRITE
#undef SWAIT
#undef RESC
}
#undef KSWZ
#undef RSWZ
#undef SBAR
}
struct Args { const float* in[N_IN]; float* out; unsigned char* ws; int ph_lo, ph_hi, bli, pad; };
struct Frame {
    LAS unsigned char* lds;
    volatile LAS unsigned* MISC;
    gu32* ctl;
    int tid, lane, wave, bid, G, gw, NGW;
    GAS unsigned char* ws;
};
#define WSP(T, off) ((T*)(GAS T*)(F.ws + (off)))
constexpr int PTR_OFF = LDSCTL_OFF + 1024;
__device__ __forceinline__ const float* inp(const Frame& F, int i) {
    int z = 0; asm volatile("" : "+s"(z));
    const LAS unsigned* t = (const LAS unsigned*)(F.lds + PTR_OFF + z) + 2 * i;
    const unsigned lo = __builtin_amdgcn_readfirstlane(t[0]), hi = __builtin_amdgcn_readfirstlane(t[1]);
    return (const float*)(GAS const float*)(((unsigned long long)hi << 32) | lo);
}
#define INP(i) inp(F, (i))
__device__ __forceinline__ bool phase_fence(Frame& F) { asm volatile("" : "+s"(F.ws), "+s"(F.ctl), "+s"(F.G), "+s"(F.bid), "+s"(F.wave));
    F.tid = opaque_tid(F.wave); F.lane = F.tid & 63; F.gw = F.bid * NWAVES + F.wave; F.NGW = F.G * NWAVES; return true; }

__device__ __forceinline__ void row_bj(int r, int& b, int& j) { b = r / TPB; j = r - b * TPB; }
__device__ __forceinline__ const float* mod_ptr(const Frame& F, int layer, int mrow, int which) { return WSP(const float, WS_MOD) + ((size_t)(layer * 9 + mrow) * NMOD + which) * D; }

__device__ __forceinline__ void ld_row_f32(const float* p, int lane, f32x4 (&v)[4]) {
#pragma unroll
    for (int j = 0; j < 4; ++j) v[j] = ((const f32x4*)p)[lane + 64 * j];
}
__device__ __forceinline__ void st_row_f32(float* p, int lane, const f32x4 (&v)[4]) {
#pragma unroll
    for (int j = 0; j < 4; ++j) ((f32x4*)p)[lane + 64 * j] = v[j];
}
__device__ __forceinline__ void ld_row_bf16(const bf16_t* p, int lane, f32x4 (&v)[4]) {
#pragma unroll
    for (int j = 0; j < 4; ++j) { const v2u w = ((const v2u*)p)[lane + 64 * j]; v[j] = (f32x4){bflo(w.x), bfhi(w.x), bflo(w.y), bfhi(w.y)}; }
}
__device__ __forceinline__ void st_row_bf16(bf16_t* p, int lane, const f32x4 (&v)[4]) {
#pragma unroll
    for (int j = 0; j < 4; ++j) { v2u w; w.x = pk2(v[j].x, v[j].y); w.y = pk2(v[j].z, v[j].w); ((v2u*)p)[lane + 64 * j] = w; }
}
__device__ __forceinline__ void rms_mod(f32x4 (&v)[4], int lane, const float* gain, const float* shift, const float* scale) {
    float ss = 0.f;
#pragma unroll
    for (int j = 0; j < 4; ++j) ss += (v[j].x * v[j].x + v[j].y * v[j].y) + (v[j].z * v[j].z + v[j].w * v[j].w);
    const float rs = rsqrtf(wave_sum(ss) * (1.f / D) + NORM_EPS);
#pragma unroll
    for (int j = 0; j < 4; ++j) {
        const f32x4 g = ((const f32x4*)gain)[lane + 64 * j], sh = ((const f32x4*)shift)[lane + 64 * j], sc = ((const f32x4*)scale)[lane + 64 * j];
        v[j] = (v[j] * rs) * g * (sc + 1.f) + sh;
    }
}

__device__ __forceinline__ void p0_transpose_item(const float* W, int K, int N, bf16_t* WT, int ld, LAS float* scr, int item, int lane) {
    const int nblk = N / 32, kb = item / nblk, nb = item - kb * nblk, k0 = 64 * kb, n0 = 32 * nb;
#pragma unroll 8
    for (int i = 0; i < 32; ++i) { const int kk = 2 * i + (lane >> 5); scr[kk * 33 + (lane & 31)] = (k0 + kk < K) ? W[(size_t)(k0 + kk) * N + n0 + (lane & 31)] : 0.f; }
    LDS_WAIT(); asm volatile("" ::: "memory");
    const int c = lane & 7;
    if (k0 + 8 * c < K) {
#pragma unroll
        for (int j = 0; j < 4; ++j) { const int n = (lane >> 3) + 8 * j; const LAS float* s = scr + (8 * c) * 33 + n;
            v4u o; o.x = pk2(s[0 * 33], s[1 * 33]); o.y = pk2(s[2 * 33], s[3 * 33]); o.z = pk2(s[4 * 33], s[5 * 33]); o.w = pk2(s[6 * 33], s[7 * 33]);
            *(GAS v4u*)(WT + (size_t)(n0 + n) * ld + k0 + 8 * c) = o; }
    }
    LDS_WAIT(); asm volatile("" ::: "memory");
}
__device__ __forceinline__ void p0_transpose_item64(const float* W, int N, bf16_t* WT, int ld, LAS float* scr, int kb, int nb, int lane) {
    const int k0 = 64 * kb, n0 = 64 * nb, lr = lane >> 4, lc = 4 * (lane & 15);
    const float* src = W + (size_t)(k0 + lr) * N + n0 + lc;
    f32x4 v[16];
#pragma unroll
    for (int q = 0; q < 16; ++q) v[q] = __builtin_nontemporal_load((const f32x4*)(src + (size_t)(4 * q) * N));
#pragma unroll
    for (int q = 0; q < 16; ++q) *(LAS f32x4*)(scr + (4 * q + lr) * 68 + lc) = v[q];
    LDS_WAIT(); asm volatile("" ::: "memory");
    const int ln = lane >> 3, kc = lane & 7;
#pragma unroll
    for (int rr = 0; rr < 8; ++rr) { const int n = 8 * rr + ln; const LAS float* s = scr + (8 * kc) * 68 + n;
        v4u o; o.x = pk2(s[0 * 68], s[1 * 68]); o.y = pk2(s[2 * 68], s[3 * 68]); o.z = pk2(s[4 * 68], s[5 * 68]); o.w = pk2(s[6 * 68], s[7 * 68]);
        *(GAS v4u*)(WT + (size_t)(n0 + n) * ld + k0 + 8 * kc) = o; }
    LDS_WAIT(); asm volatile("" ::: "memory");
}
struct TJob { int in_idx; unsigned src_off; int K, N; unsigned long long dst_off; int ld; int count; unsigned src_stride; unsigned dst_stride; };
constexpr unsigned long long SWE(int e, size_t o) { return WS_SMALLW + SW_EV + (size_t)e * EV_BYTES + o; }
constexpr unsigned long long SWO(int j, size_t o) { return WS_SMALLW + SW_OD + (size_t)j * OD_BYTES + o; }
constexpr int NJOBS = 33;
__device__ const TJob g_jobs[NJOBS] = {
    {I_MOE_W1, 0, 1024, 2048, WS_W1T, 1024, 128, 1024u * 2048u, 2048u * 1024u},
    {I_MOE_W2, 0, 1024, 1024, WS_W2T, 1024, 128, 1024u * 1024u, 1024u * 1024u},
    {I_ATTN_W_IN, 0, 1024, 1728, SWE(0, EV_WIN), 1024, 2, 1024u * 1728u, (unsigned)(EV_BYTES / 2)},
    {I_MLA_W_UQ, 0, 384, 768, SWE(0, EV_WUQ), 384, 2, 384u * 768u, (unsigned)(EV_BYTES / 2)},
    {I_MLA_W_UKV, 0, 256, 1024, SWE(0, EV_WUKV), 256, 2, 256u * 1024u, (unsigned)(EV_BYTES / 2)},
    {I_ATTN_W_OUT, 0, 1024, 1024, SWE(0, EV_WOUT), 1024, 2, 1024u * 1024u, (unsigned)(EV_BYTES / 2)},
    {I_RWKV_W_R, 0, 1024, 1024, SWO(0, OD_WR), 1024, 2, 1024u * 1024u, (unsigned)(OD_BYTES / 2)},
    {I_RWKV_W_K, 0, 1024, 1024, SWO(0, OD_WK), 1024, 2, 1024u * 1024u, (unsigned)(OD_BYTES / 2)},
    {I_RWKV_W_V, 0, 1024, 1024, SWO(0, OD_WV), 1024, 2, 1024u * 1024u, (unsigned)(OD_BYTES / 2)},
    {I_RWKV_W_O, 0, 1024, 1024, SWO(0, OD_WO), 1024, 2, 1024u * 1024u, (unsigned)(OD_BYTES / 2)},
    {I_RWKV_W1, 0 * 65536u, 1024, 64, SWO(0, OD_W1C) + 0 * 64 * 2048, 1024, 1, 0, 0},
    {I_RWKV_W1, 1 * 65536u, 1024, 64, SWO(0, OD_W1C) + 1 * 64 * 2048, 1024, 1, 0, 0},
    {I_RWKV_W1, 2 * 65536u, 1024, 64, SWO(1, OD_W1C) + 0 * 64 * 2048, 1024, 1, 0, 0},
    {I_RWKV_W1, 3 * 65536u, 1024, 64, SWO(1, OD_W1C) + 1 * 64 * 2048, 1024, 1, 0, 0},
    {I_RWKV_A1, 0 * 65536u, 1024, 64, SWO(0, OD_A1C) + 0 * 64 * 2048, 1024, 1, 0, 0},
    {I_RWKV_A1, 1 * 65536u, 1024, 64, SWO(0, OD_A1C) + 1 * 64 * 2048, 1024, 1, 0, 0},
    {I_RWKV_A1, 2 * 65536u, 1024, 64, SWO(1, OD_A1C) + 0 * 64 * 2048, 1024, 1, 0, 0},
    {I_RWKV_A1, 3 * 65536u, 1024, 64, SWO(1, OD_A1C) + 1 * 64 * 2048, 1024, 1, 0, 0},
    {I_RWKV_G1, 0, 1024, 128, SWO(0, OD_G1), 1024, 2, 1024u * 128u, (unsigned)(OD_BYTES / 2)},
    {I_RWKV_V1, 0, 1024, 32, SWO(1, OD_V1), 1024, 1, 0, 0},
    {I_RWKV_W2, 0 * 65536u, 64, 1024, SWO(0, OD_W2C) + (0 * 1024 * 128 + 0 * 64) * 2, 128, 1, 0, 0},
    {I_RWKV_W2, 1 * 65536u, 64, 1024, SWO(0, OD_W2C) + (1 * 1024 * 128 + 1 * 64) * 2, 128, 1, 0, 0},
    {I_RWKV_W2, 2 * 65536u, 64, 1024, SWO(1, OD_W2C) + (0 * 1024 * 128 + 0 * 64) * 2, 128, 1, 0, 0},
    {I_RWKV_W2, 3 * 65536u, 64, 1024, SWO(1, OD_W2C) + (1 * 1024 * 128 + 1 * 64) * 2, 128, 1, 0, 0},
    {I_RWKV_A2, 0 * 65536u, 64, 1024, SWO(0, OD_A2C) + (0 * 1024 * 128 + 0 * 64) * 2, 128, 1, 0, 0},
    {I_RWKV_A2, 1 * 65536u, 64, 1024, SWO(0, OD_A2C) + (1 * 1024 * 128 + 1 * 64) * 2, 128, 1, 0, 0},
    {I_RWKV_A2, 2 * 65536u, 64, 1024, SWO(1, OD_A2C) + (0 * 1024 * 128 + 0 * 64) * 2, 128, 1, 0, 0},
    {I_RWKV_A2, 3 * 65536u, 64, 1024, SWO(1, OD_A2C) + (1 * 1024 * 128 + 1 * 64) * 2, 128, 1, 0, 0},
    {I_RWKV_G2, 0, 128, 1024, SWO(0, OD_G2), 128, 2, 128u * 1024u, (unsigned)(OD_BYTES / 2)},
    {I_RWKV_V2, 0, 32, 1024, SWO(1, OD_V2), 128, 1, 0, 0},
    {I_MOE_ROUTER_W, 0, 1024, 32, WS_SMALLW + SW_RT, 1024, 4, 1024u * 32u, (unsigned)(RT_BYTES / 2)},
    {-1, 0, 64, 32, 0, 0, 0, 0, 0},
    {-1, 0, 64, 32, 0, 0, 0, 0, 0},
};
__device__ __forceinline__ bool job_fast(const TJob& j) { return (j.K % 64 == 0) && (j.N % 64 == 0); }
__device__ __forceinline__ int job_per(const TJob& j) { return job_fast(j) ? (j.K / 64) * (j.N / 64) : ((j.K + 63) / 64) * (j.N / 32); }
__device__ __forceinline__ int job_items(const TJob& j) { return j.count * job_per(j); }

struct TItem { const float* W; bf16_t* WT; int K, N, ld, item; bool fast; };
__device__ __forceinline__ TItem p0_decode(const Frame& F, int jlo, int it) {
    int r = it, j = jlo;
    for (;; ++j) { if (g_jobs[j].in_idx < 0) continue; const int n = job_items(g_jobs[j]); if (r < n) break; r -= n; }
    const TJob jb = g_jobs[j];
    const int per = job_per(jb), mi = r / per;
    TItem t; t.W = INP(jb.in_idx) + jb.src_off + (size_t)mi * jb.src_stride; t.WT = (bf16_t*)(GAS bf16_t*)(F.ws + jb.dst_off) + (size_t)mi * jb.dst_stride; t.K = jb.K; t.N = jb.N; t.ld = jb.ld; t.item = r - mi * per; t.fast = job_fast(jb);
    return t;
}
__device__ __forceinline__ void p0_load64(const TItem& t, int lane, f32x4 (&v)[16]) {
    const int nblk = t.N / 64, kb = t.item / nblk, nb = t.item - kb * nblk;
    const float* src = t.W + (size_t)(64 * kb + (lane >> 4)) * t.N + 64 * nb + 4 * (lane & 15);
#pragma unroll
    for (int q = 0; q < 16; ++q) v[q] = __builtin_nontemporal_load((const f32x4*)(src + (size_t)(4 * q) * t.N));
}
__device__ __forceinline__ void p0_finish64(const TItem& t, int lane, const f32x4 (&v)[16], LAS float* scr) {
    const int nblk = t.N / 64, kb = t.item / nblk, nb = t.item - kb * nblk, k0 = 64 * kb, n0 = 64 * nb, lr = lane >> 4, lc = 4 * (lane & 15);
#pragma unroll
    for (int q = 0; q < 16; ++q) *(LAS f32x4*)(scr + (4 * q + lr) * 68 + lc) = v[q];
    LDS_WAIT(); asm volatile("" ::: "memory");
    const int ln = lane >> 3, kc = lane & 7;
#pragma unroll
    for (int rr = 0; rr < 8; ++rr) { const int n = 8 * rr + ln; const LAS float* s = scr + (8 * kc) * 68 + n;
        v4u o; o.x = pk2(s[0 * 68], s[1 * 68]); o.y = pk2(s[2 * 68], s[3 * 68]); o.z = pk2(s[4 * 68], s[5 * 68]); o.w = pk2(s[6 * 68], s[7 * 68]);
        __builtin_nontemporal_store(o, (GAS v4u*)(t.WT + (size_t)(n0 + n) * t.ld + k0 + 8 * kc)); }
    LDS_WAIT(); asm volatile("" ::: "memory");
}
__device__ __forceinline__ void p0_transposes_fast(Frame& F, int jlo, int jhi, int first, int stride) {
    LAS float* scr = (LAS float*)(F.lds + RING_OFF + F.wave * 17408);
    int total = 0;
    for (int j = jlo; j < jhi; ++j) if (g_jobs[j].in_idx >= 0) total += job_items(g_jobs[j]);
    if (first >= total) return;
    f32x4 va[16], vb[16];
    TItem ta = p0_decode(F, jlo, first), tb = ta; p0_load64(ta, F.lane, va);
    for (int it = first; it < total; it += 2 * stride) {
        const bool hb = it + stride < total, ha2 = it + 2 * stride < total;
        if (hb) { tb = p0_decode(F, jlo, it + stride); p0_load64(tb, F.lane, vb); }
        p0_finish64(ta, F.lane, va, scr);
        if (ha2) { ta = p0_decode(F, jlo, it + 2 * stride); p0_load64(ta, F.lane, va); }
        if (hb) p0_finish64(tb, F.lane, vb, scr);
    }
}
__device__ __forceinline__ void p0_transposes(Frame& F, int jlo, int jhi, int first, int stride) {
    LAS float* scr = (LAS float*)(F.lds + RING_OFF + F.wave * 17408);
    int total = 0;
    for (int j = jlo; j < jhi; ++j) if (g_jobs[j].in_idx >= 0) total += job_items(g_jobs[j]);
    for (int it = first; it < total; it += stride) {
        const TItem t = p0_decode(F, jlo, it);
        if (t.fast) { const int nblk = t.N / 64; p0_transpose_item64(t.W, t.N, t.WT, t.ld, scr, t.item / nblk, t.item % nblk, F.lane); }
        else p0_transpose_item(t.W, t.K, t.N, t.WT, t.ld, scr, t.item, F.lane);
    }
}
__device__ __forceinline__ void p0_prologue(Frame& F, const Args& args) {
    {
        LAS float* Ssil = (LAS float*)(F.lds + RING_OFF);
        LAS float* Part = (LAS float*)(F.lds + RING_OFF + 40960);
        bool have = false;
        for (int it = F.bid; it < 96; it += F.G) {
            if (!have) {
                for (int idx = F.tid; idx < 9 * 1024; idx += NTHREADS) { const int r = idx >> 10, k = idx & 1023; const float cv = (r < 8) ? INP(I_C)[r * 1024 + k] : INP(I_CCTX)[k]; Ssil[idx] = siluf_(cv); }
                __syncthreads(); have = true;
            }
            const int l = it / 24, n0 = (it % 24) * 256;
            const float* Wb = INP(I_ADA_W) + (size_t)l * 1024 * 6144 + n0 + 4 * F.lane;
            f32x4 acc[9];
#pragma unroll
            for (int r = 0; r < 9; ++r) acc[r] = (f32x4){0.f, 0.f, 0.f, 0.f};
            const int kb = F.wave * 128;
            for (int k = 0; k < 128; k += 8) {
                f32x4 wv[8];
#pragma unroll
                for (int u = 0; u < 8; ++u) wv[u] = *(const f32x4*)(Wb + (size_t)(kb + k + u) * 6144);
#pragma unroll
                for (int u = 0; u < 8; ++u)
#pragma unroll
                    for (int r = 0; r < 9; ++r) acc[r] = acc[r] + wv[u] * Ssil[r * 1024 + kb + k + u];
            }
#pragma unroll
            for (int r = 0; r < 9; ++r) *(LAS f32x4*)(Part + (F.wave * 9 + r) * 256 + 4 * F.lane) = acc[r];
            __syncthreads();
            for (int idx = F.tid; idx < 9 * 256; idx += NTHREADS) {
                const int r = idx >> 8, n = idx & 255; float s = INP(I_ADA_B)[l * 6144 + n0 + n];
#pragma unroll
                for (int w = 0; w < 8; ++w) s += Part[(w * 9 + r) * 256 + n];
                WSP(float, WS_MOD)[(size_t)(l * 9 + r) * 6144 + n0 + n] = s;
            }
            __syncthreads();
        }
        __syncthreads();
    }
    if (F.G > 2 * 96) { if (F.bid >= 96) p0_transposes(F, 2, NJOBS, (F.bid - 96) * NWAVES + F.wave, (F.G - 96) * NWAVES); }
    else p0_transposes(F, 2, NJOBS, F.gw, F.NGW);
}
__device__ __forceinline__ void p1_init(Frame& F, const Args& args) {
    const float* gain = INP(I_NORM_MIX);
    f32x4 raw[4];
#define P1_LOAD(r_) do { int b_, j_; row_bj((r_), b_, j_); const float* src_ = (j_ < CTXL) ? INP(I_CTX) + ((size_t)b_ * CTXL + j_) * D : INP(I_X) + ((size_t)b_ * SEQ + (j_ - CTXL)) * D; ld_row_f32(src_, F.lane, raw); } while (0)
    if (F.gw < M) P1_LOAD(F.gw);
    for (int r = F.gw; r < M; r += F.NGW) {
        int b, j; row_bj(r, b, j);
        f32x4 v[4];
#pragma unroll
        for (int q = 0; q < 4; ++q) v[q] = raw[q];
        asm volatile("" : "+v"(v[0]), "+v"(v[1]), "+v"(v[2]), "+v"(v[3]));
        if (r + F.NGW < M) P1_LOAD(r + F.NGW);
        st_row_bf16(WSP(bf16_t, WS_XR) + (size_t)r * D, F.lane, v);
        const int mrow = (j < CTXL) ? 8 : b;
        rms_mod(v, F.lane, gain, mod_ptr(F, 0, mrow, 0), mod_ptr(F, 0, mrow, 1));
        st_row_bf16(WSP(bf16_t, WS_HB) + (size_t)r * D, F.lane, v);
    }
#undef P1_LOAD
}
__device__ __forceinline__ void p_copy_out(Frame& F, const Args& args) {
    for (int r = F.gw; r < M; r += F.NGW) {
        int b, j; row_bj(r, b, j); if (j < CTXL) continue;
        f32x4 v[4]; ld_row_bf16(WSP(const bf16_t, WS_XR) + (size_t)r * D, F.lane, v);
        st_row_f32(((float*)INP(N_IN)) + ((size_t)b * SEQ + (j - CTXL)) * D, F.lane, v);
    }
}
struct SubGemm { const char* A; const char* Bt; int lda; int K; int ntn; int kind; };
template <int NS>
struct MultiOrder {
    SubGemm s[NS]; int ntn_total, nwg, G, c, submajor;
    __device__ __forceinline__ void init(int G_, int c_, int submajor_ = 0) { ntn_total = 0; submajor = submajor_;
#pragma unroll
        for (int i = 0; i < NS; ++i) ntn_total += s[i].ntn;
        nwg = NPANEL * ntn_total; G = G_; c = c_; }
    __device__ __forceinline__ bool next(int i, pg8::Unit& u) const {
        const long L = (long)i * G + c; if (L >= nwg) return false;
        int wgid = (int)L; { const int q = nwg / 8, r = nwg % 8, xcd = wgid % 8, off = wgid / 8; wgid = (xcd < r ? xcd * (q + 1) : r * (q + 1) + (xcd - r) * q) + off; }
        const char* A = s[0].A; const char* Bt = s[0].Bt; int lda = s[0].lda, K = s[0].K, kind = s[0].kind; int pm, pn;
        if (submajor) {
            int nN = s[0].ntn, base = 0, acc = NPANEL * s[0].ntn;
#pragma unroll
            for (int k = 1; k < NS; ++k) { const bool ge = wgid >= acc; A = ge ? s[k].A : A; Bt = ge ? s[k].Bt : Bt; lda = ge ? s[k].lda : lda; K = ge ? s[k].K : K; kind = ge ? s[k].kind : kind; nN = ge ? s[k].ntn : nN; base = ge ? acc : base; acc += NPANEL * s[k].ntn; }
            const int lid = wgid - base, nig = 8 * nN, gid = lid / nig, fm = gid * 8, gsz = (NPANEL - fm) < 8 ? (NPANEL - fm) : 8;
            pm = fm + ((lid % nig) % gsz); pn = (lid % nig) / gsz;
        } else {
            const int nig = 8 * ntn_total, gid = wgid / nig, fm = gid * 8, gsz = (NPANEL - fm) < 8 ? (NPANEL - fm) : 8;
            pm = fm + ((wgid % nig) % gsz); const int vpn = (wgid % nig) / gsz; pn = vpn; int base = 0;
#pragma unroll
            for (int k = 1; k < NS; ++k) { base += s[k - 1].ntn; const bool ge = vpn >= base; A = ge ? s[k].A : A; Bt = ge ? s[k].Bt : Bt; lda = ge ? s[k].lda : lda; K = ge ? s[k].K : K; kind = ge ? s[k].kind : kind; pn = ge ? vpn - base : pn; }
        }
        u.A = A; u.B = Bt + (size_t)pn * 256 * K * 2; u.lda = lda; u.K = K; u.pm = pm; u.pn = pn; u.kind = kind; u.e = 0; u.nrows = 256; u.ridx = nullptr;
        return true;
    }
};

__device__ __forceinline__ v4u pack8(f32x4 v0, f32x4 v1) { v4u w; w.x = pk2(v0[0], v0[1]); w.y = pk2(v0[2], v0[3]); w.z = pk2(v1[0], v1[1]); w.w = pk2(v1[2], v1[3]); return w; }
struct NoCtx {};
struct EpiStoreBf16 {
    typedef NoCtx Ctx;
    bf16_t* O; int ldc; int ncols;
    __device__ __forceinline__ void begin(Ctx&, const pg8::Unit&, int, int) const {}
    __device__ __forceinline__ void begin_half(Ctx&, const pg8::Unit&, int, int, int) const {}
    __device__ __forceinline__ void row8(const Ctx&, const pg8::Unit& u, int, int, int lrow, int lcol, f32x4 v0, f32x4 v1) const {
        const int col = u.pn * 256 + lcol; if (col >= ncols) return;
        *(v4u*)(O + (size_t)(u.pm * 256 + lrow) * ldc + col) = pack8(v0, v1);
    }
};
struct EpiStore2 {
    typedef NoCtx Ctx;
    bf16_t* O0; int ld0; bf16_t* O1; int ld1;
    __device__ __forceinline__ void begin(Ctx&, const pg8::Unit&, int, int) const {}
    __device__ __forceinline__ void begin_half(Ctx&, const pg8::Unit&, int, int, int) const {}
    __device__ __forceinline__ void row8(const Ctx&, const pg8::Unit& u, int, int, int lrow, int lcol, f32x4 v0, f32x4 v1) const {
        bf16_t* O = u.kind ? O1 : O0; const int ld = u.kind ? ld1 : ld0;
        *(v4u*)(O + (size_t)(u.pm * 256 + lrow) * ld + u.pn * 256 + lcol) = pack8(v0, v1);
    }
};
struct EpiResidual {
    struct Ctx { f32x4 g[2][2]; v4u x[8][2]; };
    bf16_t* XR; const float* mod_base;
    __device__ __forceinline__ void begin(Ctx& c, const pg8::Unit& u, int lrow0, int lcol0) const {
        const int b = u.pm / 17, mrow = (u.pm - b * 17 == 0) ? 8 : b;
        const float* g = mod_base + (size_t)mrow * 6144 + u.pn * 256 + lcol0;
#pragma unroll
        for (int bj = 0; bj < 2; ++bj) { c.g[bj][0] = *(const f32x4*)(g + bj * 128); c.g[bj][1] = *(const f32x4*)(g + bj * 128 + 4); }
#pragma unroll
        for (int ai = 0; ai < 2; ++ai) {
            const bf16_t* x = XR + (size_t)(u.pm * 256 + lrow0 + ai * 128) * D + u.pn * 256 + lcol0;
#pragma unroll
            for (int m = 0; m < 4; ++m)
#pragma unroll
                for (int bj = 0; bj < 2; ++bj) c.x[ai * 4 + m][bj] = *(const v4u*)(x + (size_t)m * 16 * D + bj * 128); }
    }
    __device__ __forceinline__ void begin_half(Ctx&, const pg8::Unit&, int, int, int) const {}
    __device__ __forceinline__ void row8(const Ctx& c, const pg8::Unit& u, int slot, int bj, int lrow, int lcol, f32x4 v0, f32x4 v1) const {
        bf16_t* x = XR + (size_t)(u.pm * 256 + lrow) * D + u.pn * 256 + lcol; const v4u xo = c.x[slot][bj];
        const f32x4 x0 = (f32x4){bflo(xo.x), bfhi(xo.x), bflo(xo.y), bfhi(xo.y)}, x1 = (f32x4){bflo(xo.z), bfhi(xo.z), bflo(xo.w), bfhi(xo.w)};
        const f32x4 r0 = x0 + c.g[bj][0] * v0, r1 = x1 + c.g[bj][1] * v1;
        v4u w; w.x = pk2(r0[0], r0[1]); w.y = pk2(r0[2], r0[3]); w.z = pk2(r1[0], r1[1]); w.w = pk2(r1[2], r1[3]);
        *(v4u*)x = w;
    }
};
struct EpiRouter {
    struct Ctx { f32x4 b0, b1; };
    float* L; const float* bias;
    __device__ __forceinline__ void begin(Ctx& c, const pg8::Unit&, int, int lcol0) const { const int lc = lcol0 < 32 ? lcol0 : 0; c.b0 = *(const f32x4*)(bias + lc); c.b1 = *(const f32x4*)(bias + lc + 4); }
    __device__ __forceinline__ void begin_half(Ctx&, const pg8::Unit&, int, int, int) const {}
    __device__ __forceinline__ void row8(const Ctx& c, const pg8::Unit& u, int, int, int lrow, int lcol, f32x4 v0, f32x4 v1) const {
        if (lcol >= 32) return;
        float* o = L + (size_t)(u.pm * 256 + lrow) * 32 + lcol;
        *(f32x4*)o = v0 + c.b0; *(f32x4*)(o + 4) = v1 + c.b1;
    }
};
struct MoeCtx { int orow[8]; f32x4 b[2][2]; };
__device__ __forceinline__ void moe_begin(MoeCtx& c, const pg8::Unit& u, int lrow0, int lcol0, const float* bias_e) {
#pragma unroll
    for (int s = 0; s < 8; ++s) { const int lr = lrow0 + (s >> 2) * 128 + (s & 3) * 16; c.orow[s] = (lr < u.nrows) ? u.ridx[lr] : -1; }
    const float* bb = bias_e + u.pn * 256 + lcol0;
#pragma unroll
    for (int bj = 0; bj < 2; ++bj) { c.b[bj][0] = *(const f32x4*)(bb + bj * 128); c.b[bj][1] = *(const f32x4*)(bb + bj * 128 + 4); }
}
__device__ __forceinline__ void moe_begin_pre(MoeCtx& c, const pg8::Unit& u, int lrow0, int lcol0, const LAS unsigned char* tab) {
#pragma unroll
    for (int s = 0; s < 8; ++s) { const int lr = lrow0 + (s >> 2) * 128 + (s & 3) * 16; const int v = ((const LAS int*)tab)[lr]; c.orow[s] = (lr < u.nrows) ? v : -1; }
    const LAS float* bb = (const LAS float*)(tab + 1024) + lcol0;
#pragma unroll
    for (int bj = 0; bj < 2; ++bj) { c.b[bj][0] = *(const LAS f32x4*)(bb + bj * 128); c.b[bj][1] = *(const LAS f32x4*)(bb + bj * 128 + 4); }
}
struct EpiSwiglu {
    typedef MoeCtx Ctx;
    bf16_t* ACT; const float* b1;
    __device__ __forceinline__ void begin(Ctx& c, const pg8::Unit& u, int lrow0, int lcol0) const { moe_begin(c, u, lrow0, lcol0, b1 + (size_t)u.e * 2048); }
    __device__ __forceinline__ const float* bias_of(const pg8::Unit& u) const { return b1 + (size_t)u.e * 2048 + u.pn * 256; }
    __device__ __forceinline__ void begin_pre(Ctx& c, const pg8::Unit& u, int lrow0, int lcol0, const LAS unsigned char* tab) const { moe_begin_pre(c, u, lrow0, lcol0, tab); }
    __device__ __forceinline__ void begin_half(Ctx&, const pg8::Unit&, int, int, int) const {}
    __device__ __forceinline__ void row8(const Ctx& c, const pg8::Unit& u, int slot, int bj, int, int lcol, f32x4 v0, f32x4 v1) const {
        const int orow = c.orow[slot]; if (orow < 0) return;
        const int col = u.pn * 256 + lcol;
        v0 = v0 + c.b[bj][0]; v1 = v1 + c.b[bj][1];
        float o[4];
#pragma unroll
        for (int p = 0; p < 4; ++p) {
            float g = (p < 2) ? v0[2 * p] : v1[2 * (p - 2)], l = (p < 2) ? v0[2 * p + 1] : v1[2 * (p - 2) + 1];
            g = fminf(g, 7.f); l = fminf(fmaxf(l, -7.f), 7.f);
            o[p] = g * sigmoidf_(1.702f * g) * (l + 1.f);
        }
        v2u w; w.x = pk2(o[0], o[1]); w.y = pk2(o[2], o[3]);
        *(v2u*)(ACT + (size_t)orow * FF + (col >> 1)) = w;
    }
};
struct EpiMoeDown {
    typedef MoeCtx Ctx;
    bf16_t* Y; const float* b2;
    __device__ __forceinline__ void begin(Ctx& c, const pg8::Unit& u, int lrow0, int lcol0) const { moe_begin(c, u, lrow0, lcol0, b2 + (size_t)u.e * 1024); }
    __device__ __forceinline__ const float* bias_of(const pg8::Unit& u) const { return b2 + (size_t)u.e * 1024 + u.pn * 256; }
    __device__ __forceinline__ void begin_pre(Ctx& c, const pg8::Unit& u, int lrow0, int lcol0, const LAS unsigned char* tab) const { moe_begin_pre(c, u, lrow0, lcol0, tab); }
    __device__ __forceinline__ void begin_half(Ctx&, const pg8::Unit&, int, int, int) const {}
    __device__ __forceinline__ void row8(const Ctx& c, const pg8::Unit& u, int slot, int bj, int, int lcol, f32x4 v0, f32x4 v1) const {
        const int orow = c.orow[slot]; if (orow < 0) return;
        *(v4u*)(Y + (size_t)orow * D + u.pn * 256 + lcol) = pack8(v0 + c.b[bj][0], v1 + c.b[bj][1]);
    }
};

__device__ __forceinline__ void rope_pair(float& v, int lane, int half  , float cs, float sn) {
    const unsigned x_ = __builtin_bit_cast(unsigned, v);
    float p;
    if (half == 16) { const auto r_ = __builtin_amdgcn_permlane16_swap(x_, x_, false, false); p = __builtin_bit_cast(float, (unsigned)((lane & 16) ? r_[0] : r_[1])); }
    else { const auto r_ = __builtin_amdgcn_permlane32_swap(x_, x_, false, false); p = __builtin_bit_cast(float, (unsigned)((lane & 32) ? r_[0] : r_[1])); }
    v = ((lane & half) == 0) ? (v * cs - p * sn) : (v * cs + p * sn);
}
__device__ __forceinline__ void pA2_proj_norms(Frame& F, const Args& args, int e) {
    const float* q_norm = INP(I_MLA_Q_NORM) + e * 384; const float* kv_norm = INP(I_MLA_KV_NORM) + e * 256; const float* kr_g = INP(I_MLA_KR_G) + e * 64;
    const float* gq_g = INP(I_GQA_Q_G) + e * 128; const float* gk_g = INP(I_GQA_K_G) + e * 128;
    const int lane = F.lane;
    float gqn[6], gkvn[4];
#pragma unroll
    for (int g = 0; g < 6; ++g) gqn[g] = q_norm[64 * g + lane];
#pragma unroll
    for (int g = 0; g < 4; ++g) gkvn[g] = kv_norm[64 * g + lane];
    const float gkr = kr_g[lane], gq0 = gq_g[lane], gq1 = gq_g[64 + lane], gk0 = gk_g[lane], gk1 = gk_g[64 + lane];
    const float LOG2_THETA = 13.287712379549449f;
    const float ifm = __builtin_amdgcn_exp2f(-(float)(2 * (lane & 15)) * (1.f / 32.f) * LOG2_THETA);
    const float ifg = __builtin_amdgcn_exp2f(-(float)(2 * (lane & 31)) * (1.f / 64.f) * LOG2_THETA);
    unsigned short raw[23];
#define A2_LOAD(r_) do { const bf16_t* p_ = WSP(const bf16_t, WS_PROJ) + (size_t)(r_) * PROJ_LD; _Pragma("unroll") for (int g = 0; g < 23; ++g) raw[g] = p_[64 * g + lane]; } while (0)
    if (F.gw < M) A2_LOAD(F.gw);
    for (int r = F.gw; r < M; r += F.NGW) {
        int b, j; row_bj(r, b, j);
        bf16_t* p = WSP(bf16_t, WS_PROJ) + (size_t)r * PROJ_LD;
        float v[23];
#pragma unroll
        for (int g = 0; g < 23; ++g) v[g] = bf2f(raw[g]);
        if (r + F.NGW < M) A2_LOAD(r + F.NGW);
        const bool lat = j >= CTXL; const int t = j - CTXL; const float prow = (float)(t >> 6), pcol = (float)(t & 63);
        { float ss = 0.f;
#pragma unroll
          for (int g = 0; g < 6; ++g) ss += v[g] * v[g];
          const float rs = rsqrtf(wave_sum(ss) * (1.f / 384.f) + NORM_EPS);
#pragma unroll
          for (int g = 0; g < 6; ++g) v[g] = v[g] * rs * gqn[g]; }
        { float ss = 0.f;
#pragma unroll
          for (int g = 0; g < 4; ++g) ss += v[6 + g] * v[6 + g];
          const float rs = rsqrtf(wave_sum(ss) * (1.f / 256.f) + NORM_EPS);
#pragma unroll
          for (int g = 0; g < 4; ++g) v[6 + g] = v[6 + g] * rs * gkvn[g]; }
        { const float rs = rsqrtf(wave_sum(v[10] * v[10]) * (1.f / 64.f) + NORM_EPS); v[10] = v[10] * rs * gkr;
          if (lat) { const float ang = ((lane < 32) ? prow : pcol) * ifm; rope_pair(v[10], lane, 16, __cosf(ang), __sinf(ang)); } }
        float c0 = 1.f, s0 = 0.f, c1 = 1.f, s1 = 0.f;
        if (lat) { const float a0 = prow * ifg, a1 = pcol * ifg; c0 = __cosf(a0); s0 = __sinf(a0); c1 = __cosf(a1); s1 = __sinf(a1); }
#pragma unroll
        for (int h = 0; h < 6; ++h) {
            const int g0 = 11 + 2 * h; const float w0 = (h < 4) ? gq0 : gk0, w1 = (h < 4) ? gq1 : gk1;
            const float rs = rsqrtf(wave_sum(v[g0] * v[g0] + v[g0 + 1] * v[g0 + 1]) * (1.f / 128.f) + NORM_EPS);
            v[g0] = v[g0] * rs * w0; v[g0 + 1] = v[g0 + 1] * rs * w1;
            if (lat) { rope_pair(v[g0], lane, 32, c0, s0); rope_pair(v[g0 + 1], lane, 32, c1, s1); }
        }
#pragma unroll
        for (int g = 0; g < 23; ++g) p[64 * g + lane] = (bf16_t)f2bf(v[g]);
    }
#undef A2_LOAD
}
__device__ __forceinline__ void pA4_mla_norms(Frame& F, const Args& args, int e) {
    const float* qn_g = INP(I_MLA_QN_G) + e * 128; const float* qr_g = INP(I_MLA_QR_G) + e * 64; const float* kn_g = INP(I_MLA_KN_G) + e * 128;
    const int lane = F.lane;
    const float qn0 = qn_g[lane], qn1 = qn_g[64 + lane], qr = qr_g[lane], kn0 = kn_g[lane], kn1 = kn_g[64 + lane];
    const float LOG2_THETA = 13.287712379549449f;
    const float ifm = __builtin_amdgcn_exp2f(-(float)(2 * (lane & 15)) * (1.f / 32.f) * LOG2_THETA);
    unsigned short rq[12], rk[8];
#define A4_LOAD(r_) do { const bf16_t* q_ = WSP(const bf16_t, WS_QM) + (size_t)(r_) * 768; const bf16_t* kv_ = WSP(const bf16_t, WS_KVM) + (size_t)(r_) * 1024; \
        _Pragma("unroll") for (int g = 0; g < 12; ++g) rq[g] = q_[64 * g + lane]; _Pragma("unroll") for (int h = 0; h < 4; ++h) { rk[2 * h] = kv_[256 * h + lane]; rk[2 * h + 1] = kv_[256 * h + 64 + lane]; } } while (0)
    if (F.gw < M) A4_LOAD(F.gw);
    for (int r = F.gw; r < M; r += F.NGW) {
        int b, j; row_bj(r, b, j);
        const bool lat = j >= CTXL; const int t = j - CTXL;
        float cs = 1.f, sn = 0.f;
        if (lat) { const float ang = ((lane < 32) ? (float)(t >> 6) : (float)(t & 63)) * ifm; cs = __cosf(ang); sn = __sinf(ang); }
        bf16_t* q = WSP(bf16_t, WS_QM) + (size_t)r * 768;
        bf16_t* kv = WSP(bf16_t, WS_KVM) + (size_t)r * 1024;
        float vq[12], vk[8];
#pragma unroll
        for (int g = 0; g < 12; ++g) vq[g] = bf2f(rq[g]);
#pragma unroll
        for (int h = 0; h < 8; ++h) vk[h] = bf2f(rk[h]);
        if (r + F.NGW < M) A4_LOAD(r + F.NGW);
#pragma unroll
        for (int h = 0; h < 4; ++h) {
            float rs = rsqrtf(wave_sum(vq[3 * h] * vq[3 * h] + vq[3 * h + 1] * vq[3 * h + 1]) * (1.f / 128.f) + NORM_EPS);
            vq[3 * h] = vq[3 * h] * rs * qn0; vq[3 * h + 1] = vq[3 * h + 1] * rs * qn1;
            rs = rsqrtf(wave_sum(vq[3 * h + 2] * vq[3 * h + 2]) * (1.f / 64.f) + NORM_EPS);
            vq[3 * h + 2] = vq[3 * h + 2] * rs * qr;
            if (lat) rope_pair(vq[3 * h + 2], lane, 16, cs, sn);
            rs = rsqrtf(wave_sum(vk[2 * h] * vk[2 * h] + vk[2 * h + 1] * vk[2 * h + 1]) * (1.f / 128.f) + NORM_EPS);
            vk[2 * h] = vk[2 * h] * rs * kn0; vk[2 * h + 1] = vk[2 * h + 1] * rs * kn1;
        }
#pragma unroll
        for (int g = 0; g < 12; ++g) q[64 * g + lane] = (bf16_t)f2bf(vq[g]);
#pragma unroll
        for (int h = 0; h < 4; ++h) { kv[256 * h + lane] = (bf16_t)f2bf(vk[2 * h]); kv[256 * h + 64 + lane] = (bf16_t)f2bf(vk[2 * h + 1]); }
    }
#undef A4_LOAD
}
template <bool MLA>
__device__ __forceinline__ void attn_one(Frame& F, int b, int h, int qb) {
    static_assert(att::ATTN_LDS <= RING_BYTES, "attention LDS");
    char* lds = (char*)(F.lds + RING_OFF);
    const bf16_t* PROJ = WSP(const bf16_t, WS_PROJ); bf16_t* OB = WSP(bf16_t, WS_OB);
    const size_t row0 = (size_t)b * TPB + (size_t)qb * 256, krow0 = (size_t)b * TPB; const int seq = qb ? TPB : CTXL;
    if constexpr (MLA) { const bf16_t* QM = WSP(const bf16_t, WS_QM); const bf16_t* KVM = WSP(const bf16_t, WS_KVM);
        att::attn_unit<192, 1, 8, 768, 1024, PROJ_LD, 1024, D>(QM + row0 * 768 + 192 * h, KVM + krow0 * 1024 + 256 * h, PROJ + krow0 * PROJ_LD + C_ZR,
                                          KVM + krow0 * 1024 + 256 * h + 128, OB + row0 * D + 128 * h, seq, lds, F.wave);
    } else { const int g = h - 4, kvh = g >> 1;
        att::attn_unit<128, 1, 8, PROJ_LD, PROJ_LD, PROJ_LD, PROJ_LD, D>(PROJ + row0 * PROJ_LD + C_GQ + 128 * g, PROJ + krow0 * PROJ_LD + C_GK + 128 * kvh, nullptr,
                                      PROJ + krow0 * PROJ_LD + C_GV + 128 * kvh, OB + row0 * D + 512 + 128 * g, seq, lds, F.wave); }
}
__device__ __forceinline__ void moe_convert_share(Frame& F, bool doit) {
    if (!doit) return;
    p0_transposes_fast(F, 0, 2, F.gw, F.NGW);
    __syncthreads();
}
template <bool MLA>
__device__ __forceinline__ void pA5_attention_half(Frame& F, int conv_phase  ) {
    const int x = F.bid & 7, lc = F.bid >> 3;
    const int nunits = NB * 4 * 17, niter = (F.G == 256) ? 3 : (nunits + F.G - 1) / F.G;
#pragma unroll 1
    for (int i = 0; i < niter; ++i) {
        if (i < 2) moe_convert_share(F, conv_phase == (MLA ? 0 : 3) + i);
        int b, h, qb;
        if (F.G == 256) { b = x; if (i < 2) { h = 2 * i + (lc >> 4); qb = 1 + (lc & 15); } else { if (lc >= 4) break; h = lc; qb = 0; } }
        else { const int u = i * F.G + F.bid; if (u >= nunits) break; b = u / (4 * 17); h = (u / 17) % 4; qb = u % 17; }
        attn_one<MLA>(F, b, (MLA ? 0 : 4) + h, qb);
    }
}
__device__ __forceinline__ void pA5_attention(Frame& F, bool convert) {
    const int cp = convert ? (F.bid % 5) : -1;
    pA5_attention_half<true>(F, cp); moe_convert_share(F, cp == 2); pA5_attention_half<false>(F, cp);
#ifdef MK_PROBE_REP_MLA
    pA5_attention_half<true>(F, -1);
#endif
#ifdef MK_PROBE_REP_GQA
    pA5_attention_half<false>(F, -1);
#endif
}
__device__ __forceinline__ void pF1_ffn_norm(Frame& F, const Args& args, int layer) {
    const float* gain = INP(I_NORM_FFN) + layer * D;
    for (int r = F.gw; r < M; r += F.NGW) {
        int b, j; row_bj(r, b, j); const int mrow = (j < CTXL) ? 8 : b;
        f32x4 v[4]; ld_row_bf16(WSP(const bf16_t, WS_XR) + (size_t)r * D, F.lane, v);
        rms_mod(v, F.lane, gain, mod_ptr(F, layer, mrow, 3), mod_ptr(F, layer, mrow, 4));
        st_row_bf16(WSP(bf16_t, WS_HB) + (size_t)r * D, F.lane, v);
    }
}
__device__ __forceinline__ void route_lane_tokens(Frame& F, int layer, int r, bool valid, const float (&l)[32]);
__device__ __forceinline__ void pF1R_norm_router(Frame& F, const Args& args, int layer) {
    constexpr int RP = 2048 + 16;
    const LAS unsigned char* WR = F.lds + RING_OFF;
    LAS unsigned char* SL = F.lds + RING_OFF + 32 * RP + F.wave * (4 * RP);
    constexpr int RPW = 17;
    LAS float* LT = (LAS float*)(F.lds + RING_OFF + 32 * RP + NWAVES * 4 * RP);
    static_assert(32 * RP + NWAVES * 4 * RP + NWAVES * RPW * 32 * 4 <= RING_BYTES, "F1R LDS");
    const bool fused = (F.G * NWAVES * RPW >= M);
    { const bf16_t* wr = (const bf16_t*)(F.ws + WS_SMALLW + SW_RT + (size_t)layer * RT_BYTES);
      __syncthreads();
      for (int i = F.tid; i < 32 * 128; i += NTHREADS) { const int row = i >> 7, ch = i & 127; *(LAS v4u*)((LAS unsigned char*)WR + row * RP + ch * 16) = *(const v4u*)(wr + (size_t)row * 1024 + ch * 8); }
      __syncthreads(); }
    const float* gain = INP(I_NORM_FFN) + layer * D; const float* rb = INP(I_MOE_ROUTER_B) + layer * 32; float* LG = WSP(float, WS_LOGITS);
    const int lane = F.lane, l15 = lane & 15, g = lane >> 4;
    const float rb0 = rb[l15], rb1 = rb[16 + l15];
    int grp = 0;
    v2u raw[4][4];
#define F1R_LOAD(rb_) do { _Pragma("unroll") for (int i = 0; i < 4; ++i) { const int r = (rb_) + i * F.NGW; if (r < M) { _Pragma("unroll") for (int q = 0; q < 4; ++q) raw[i][q] = ((const v2u*)(WSP(const bf16_t, WS_XR) + (size_t)r * D))[lane + 64 * q]; } } } while (0)
    F1R_LOAD(F.gw);
    for (int r0 = F.gw; r0 < M; r0 += 4 * F.NGW, ++grp) {
        f32x4 v[4][4];
#pragma unroll
        for (int i = 0; i < 4; ++i)
#pragma unroll
            for (int q = 0; q < 4; ++q) v[i][q] = (f32x4){bflo(raw[i][q].x), bfhi(raw[i][q].x), bflo(raw[i][q].y), bfhi(raw[i][q].y)};
#pragma unroll
        for (int i = 0; i < 4; ++i) { const int r = r0 + i * F.NGW; if (r < M) {
            int b, j; row_bj(r, b, j); const int mrow = (j < CTXL) ? 8 : b;
            rms_mod(v[i], lane, gain, mod_ptr(F, layer, mrow, 3), mod_ptr(F, layer, mrow, 4));
#pragma unroll
            for (int q = 0; q < 4; ++q) { v2u w; w.x = pk2(v[i][q].x, v[i][q].y); w.y = pk2(v[i][q].z, v[i][q].w);
                ((v2u*)(WSP(bf16_t, WS_HB) + (size_t)r * D))[lane + 64 * q] = w; *(LAS v2u*)(SL + i * RP + (lane + 64 * q) * 8) = w; } } }
        if (r0 + 4 * F.NGW < M) F1R_LOAD(r0 + 4 * F.NGW);
        f32x4 acc0 = (f32x4){0.f, 0.f, 0.f, 0.f}, acc1 = acc0;
        const LAS unsigned char* ap = SL + (l15 & 3) * RP + g * 16; const LAS unsigned char* bp = WR + l15 * RP + g * 16;
#pragma unroll 8
        for (int s2 = 0; s2 < 32; ++s2) { const bf16x8 a = *(const LAS bf16x8*)(ap + s2 * 64), b0 = *(const LAS bf16x8*)(bp + s2 * 64), b1 = *(const LAS bf16x8*)(bp + 16 * RP + s2 * 64);
            acc0 = __builtin_amdgcn_mfma_f32_16x16x32_bf16(a, b0, acc0, 0, 0, 0); acc1 = __builtin_amdgcn_mfma_f32_16x16x32_bf16(a, b1, acc1, 0, 0, 0); }
        if (g == 0) {
#pragma unroll
            for (int i = 0; i < 4; ++i) { const int r = r0 + i * F.NGW; if (r < M) {
                if (fused) { LAS float* lt = LT + (F.wave * RPW + grp * 4 + i) * 32; lt[l15] = acc0[i] + rb0; lt[16 + l15] = acc1[i] + rb1; }
                else { LG[(size_t)r * 32 + l15] = acc0[i] + rb0; LG[(size_t)r * 32 + 16 + l15] = acc1[i] + rb1; } } } }
    }
#undef F1R_LOAD
    if (fused) {
        __syncthreads();
        if (F.wave < (NWAVES * RPW + 63) / 64) {
            const int t = F.wave * 64 + lane, w = t / RPW, idx = t - w * RPW, r = F.bid * NWAVES + w + idx * F.NGW;
            bool valid = (t < NWAVES * RPW) && (r < M);
            if (valid) { int b, j; row_bj(r, b, j); valid = !((layer == DEPTH - 1) && j < CTXL); }
            const LAS float* lt = LT + ((t < NWAVES * RPW) ? t : 0) * 32;
            float l[32];
#pragma unroll
            for (int q = 0; q < 8; ++q) { const f32x4 x = ((const LAS f32x4*)lt)[q]; l[4 * q] = x[0]; l[4 * q + 1] = x[1]; l[4 * q + 2] = x[2]; l[4 * q + 3] = x[3]; }
            route_lane_tokens(F, layer, r, valid, l);
        }
    }
}
__device__ __forceinline__ void route_lane_tokens(Frame& F, int layer, int r, bool valid, const float (&l)[32]) {
    float* TG = WSP(float, WS_TOPG); int* RI = WSP(int, WS_ROWIDX);
    unsigned* cnt = (unsigned*)(F.ctl + CW_ECNT + layer * 32 * 64);
    const int lane = F.lane;
    int sel[4]; float val[4]; unsigned used = 0u;
#pragma unroll
    for (int k = 0; k < 4; ++k) { float best = -3.0e38f; int bi = 0;
#pragma unroll
        for (int e = 0; e < 32; ++e) { const bool ok = !((used >> e) & 1u) && (l[e] > best); best = ok ? l[e] : best; bi = ok ? e : bi; }
        sel[k] = bi; val[k] = best; used |= 1u << bi; }
    float p[4], ps = 0.f;
#pragma unroll
    for (int k = 0; k < 4; ++k) { p[k] = __expf(val[k] - val[0]); ps += p[k]; }
    const float inv = 1.f / ps;
    int pre[4] = {0, 0, 0, 0}; unsigned mycnt = 0u;
    const unsigned long long below = (lane == 0) ? 0ull : (~0ull >> (64 - lane));
#pragma unroll
    for (int e = 0; e < 32; ++e) {
        const bool has = valid && ((used >> e) & 1u);
        const unsigned long long m = __ballot(has);
        const int c = __popcll(m), pf = __popcll(m & below);
        if (lane == e) mycnt = (unsigned)c;
#pragma unroll
        for (int k = 0; k < 4; ++k) if (sel[k] == e) pre[k] = pf;
    }
    unsigned base = 0u;
    if (lane < 32 && mycnt) base = __hip_atomic_fetch_add(cnt + lane * 64, mycnt, RLX_AGENT);
    unsigned be[4];
#pragma unroll
    for (int k = 0; k < 4; ++k) be[k] = (unsigned)lanes_get((int)base, sel[k]);
    if (valid) {
#pragma unroll
        for (int k = 0; k < 4; ++k) RI[(size_t)sel[k] * CAP + be[k] + pre[k]] = r * 4 + k;
        *(f32x4*)(TG + (size_t)r * 4) = (f32x4){p[0] * inv, p[1] * inv, p[2] * inv, p[3] * inv};
    }
}
__device__ __forceinline__ void pF3_route(Frame& F, int layer) {
    const float* LG = WSP(const float, WS_LOGITS);
    const int lane = F.lane; const bool lastl = (layer == DEPTH - 1);
    for (int t0 = F.gw * 64; t0 < M; t0 += F.NGW * 64) {
        const int r = t0 + lane; int b, j; row_bj(r, b, j);
        const bool valid = !(lastl && j < CTXL);
        float l[32];
#pragma unroll
        for (int q = 0; q < 8; ++q) { const f32x4 x = ((const f32x4*)(LG + (size_t)r * 32))[q]; l[4 * q] = x[0]; l[4 * q + 1] = x[1]; l[4 * q + 2] = x[2]; l[4 * q + 3] = x[3]; }
        route_lane_tokens(F, layer, r, valid, l);
    }
}
template <int NPN, int GM, int GSH>
struct MoeOrder {
    const LAS int* tb;
    const char* A; const char* W; const int* RI; int G, c, nwg;
    __device__ __forceinline__ bool next(int i, pg8::Unit& u) const {
        const long L = (long)i * G + c;
        int wgid = (int)L;
        if ((G & 7) == 0) {
            const int ng = nwg / (GM * NPN), qg = ng / 8, rg = ng % 8, xcd = wgid % 8, off = wgid / 8;
            const int ngx = qg + (xcd < rg ? 1 : 0), gs = (xcd < rg) ? xcd * (qg + 1) : rg * (qg + 1) + (xcd - rg) * qg;
            if (off >= ngx * (GM * NPN)) return false;
            wgid = gs * (GM * NPN) + off;
        } else {
            if (L >= nwg) return false;
            const int q = nwg / 8, r = nwg % 8, xcd = wgid % 8, off = wgid / 8; wgid = (xcd < r ? xcd * (q + 1) : r * (q + 1) + (xcd - r) * q) + off;
        }
        const int grp = wgid / (GM * NPN), l = wgid % (GM * NPN), mt = grp * GM + (l % GM), pn = l / GM;
        const int ln = lane_now() & 31;
        const int e = __popcll(__ballot(mt >= tb[ln]) & 0xffffffffull) - 1;
        const int total = tb[32];
        const int lt = mt - tb[e], cnt = tb[33 + e];
        u.A = A; u.B = W + ((size_t)e * NPN * 256 + (size_t)pn * 256) * 1024 * 2; u.lda = 2048; u.K = 1024; u.pm = mt; u.pn = pn; u.kind = 0; u.e = e;
        int nr = (mt < total) ? cnt - lt * 256 : 0; nr = nr > 256 ? 256 : nr; u.nrows = nr;
        u.ridx = RI + (size_t)e * CAP + (size_t)lt * 256;
        return true;
    }
};
__device__ __forceinline__ int moe_table(Frame& F, int layer) {
    int z = 0; asm volatile("" : "+s"(z));
    LAS int* tb = (LAS int*)(F.lds + LDSCTL_OFF + z);
    __syncthreads();
    if (F.wave == 0) {
        const int e = F.lane & 31;
        const int c = (int)__hip_atomic_load((unsigned*)(F.ctl + CW_ECNT + (layer * 32 + e) * 64), RLX_AGENT);
        const int t = (c + 255) >> 8; int incl = t;
#pragma unroll
        for (int o = 1; o < 32; o <<= 1) { const int v = lanes_get(incl, (lane_now() - o) & 63); if (e >= o) incl += v; }
        if (F.lane < 32) { tb[e] = incl - t; tb[33 + e] = c; if (e == 31) tb[32] = incl; }
    }
    __syncthreads();
    return tb[32];
}
__device__ __forceinline__ void pF6_combine(Frame& F, const Args& args, int layer) {
    const bool lastl = (layer == DEPTH - 1);
    const bf16_t* Y = WSP(const bf16_t, WS_YB); const float* TG = WSP(const float, WS_TOPG);
    v2u rx[4], ry[4][4]; f32x4 rg;
#define F6_LOAD(r_) do { _Pragma("unroll") for (int q = 0; q < 4; ++q) rx[q] = ((const v2u*)(WSP(const bf16_t, WS_XR) + (size_t)(r_) * D))[F.lane + 64 * q]; rg = *(const f32x4*)(TG + (size_t)(r_) * 4);     \
        _Pragma("unroll") for (int k = 0; k < 4; ++k) _Pragma("unroll") for (int q = 0; q < 4; ++q) ry[k][q] = __builtin_nontemporal_load(&((const v2u*)(Y + ((size_t)(r_) * 4 + k) * D))[F.lane + 64 * q]); } while (0)
    if (F.gw < M) F6_LOAD(F.gw);
    for (int r = F.gw; r < M; r += F.NGW) {
        int b, j; row_bj(r, b, j);
        const int mrow = (j < CTXL) ? 8 : b;
        f32x4 x[4], acc[4]; const f32x4 g = rg;
#pragma unroll
        for (int q = 0; q < 4; ++q) { x[q] = (f32x4){bflo(rx[q].x), bfhi(rx[q].x), bflo(rx[q].y), bfhi(rx[q].y)}; acc[q] = (f32x4){0.f, 0.f, 0.f, 0.f}; }
#pragma unroll
        for (int k = 0; k < 4; ++k)
#pragma unroll
            for (int q = 0; q < 4; ++q) acc[q] = acc[q] + (f32x4){bflo(ry[k][q].x), bfhi(ry[k][q].x), bflo(ry[k][q].y), bfhi(ry[k][q].y)} * g[k];
        if (r + F.NGW < M) F6_LOAD(r + F.NGW);
        if (lastl && j < CTXL) continue;
        const float* m5 = mod_ptr(F, layer, mrow, 5);
#pragma unroll
        for (int q = 0; q < 4; ++q) x[q] = x[q] + ((const f32x4*)m5)[F.lane + 64 * q] * acc[q];
        if (lastl) { st_row_f32(((float*)INP(N_IN)) + ((size_t)b * SEQ + (j - CTXL)) * D, F.lane, x); continue; }
        st_row_bf16(WSP(bf16_t, WS_XR) + (size_t)r * D, F.lane, x);
        rms_mod(x, F.lane, INP(I_NORM_MIX) + (layer + 1) * D, mod_ptr(F, layer + 1, mrow, 0), mod_ptr(F, layer + 1, mrow, 1));
        st_row_bf16(WSP(bf16_t, WS_HB) + (size_t)r * D, F.lane, x);
    }
#undef F6_LOAD
}
__device__ __forceinline__ void pR1_mix(Frame& F, int jj) {
    const float* mix = INP(I_RWKV_MIX) + (size_t)jj * 6 * D;
    const bf16_t* HB = WSP(const bf16_t, WS_HB);
    v2u rh[4], rp[4], rn[4];
#define R1_LOAD(r_) do { int b_, j_; row_bj((r_), b_, j_); const bool hp_ = (j_ != 0) && (j_ != CTXL), hn_ = (j_ != CTXL - 1) && (j_ != TPB - 1); \
        _Pragma("unroll") for (int q = 0; q < 4; ++q) { rh[q] = ((const v2u*)(HB + (size_t)(r_) * D))[F.lane + 64 * q]; \
            rp[q] = hp_ ? ((const v2u*)(HB + (size_t)((r_) - 1) * D))[F.lane + 64 * q] : (v2u){0u, 0u}; rn[q] = hn_ ? ((const v2u*)(HB + (size_t)((r_) + 1) * D))[F.lane + 64 * q] : (v2u){0u, 0u}; } } while (0)
#define R1_UNP(w_) ((f32x4){bflo((w_).x), bfhi((w_).x), bflo((w_).y), bfhi((w_).y)})
    if (F.gw < M) R1_LOAD(F.gw);
    for (int r = F.gw; r < M; r += F.NGW) {
        f32x4 h[4], xx[4];
#pragma unroll
        for (int q = 0; q < 4; ++q) { h[q] = R1_UNP(rh[q]); xx[q] = (R1_UNP(rp[q]) + R1_UNP(rn[q])) * 0.5f - h[q]; }
        if (r + F.NGW < M) R1_LOAD(r + F.NGW);
#pragma unroll
        for (int m = 0; m < 6; ++m) {
            f32x4 o[4];
#pragma unroll
            for (int q = 0; q < 4; ++q) o[q] = h[q] + xx[q] * ((const f32x4*)(mix + m * D))[F.lane + 64 * q];
            st_row_bf16(WSP(bf16_t, WS_XMIX) + ((size_t)m * M + r) * D, F.lane, o);
        }
    }
#undef R1_LOAD
#undef R1_UNP
}
#ifndef MK_SCAN_SEQ
#define MK_SCAN_SEQ 0
#endif
#if MK_SCAN_SEQ
#define SC_DECAY(z) __expf(-0.6065306597126334f * sigmoidf_(z))
#else
#define SC_DECAY(z) (-0.6065306597126334f * sigmoidf_(z))
#endif
struct EpiR2 {
    typedef NoCtx Ctx;
    bf16_t* dst[7];
    __device__ __forceinline__ void begin(Ctx&, const pg8::Unit&, int, int) const {}
    __device__ __forceinline__ void begin_half(Ctx&, const pg8::Unit&, int, int, int) const {}
    __device__ __forceinline__ void row8(const Ctx&, const pg8::Unit& u, int, int, int lrow, int lcol, f32x4 v0, f32x4 v1) const {
        const int row = u.pm * 256 + lrow;
        if (u.kind < 3) { bf16_t* O = (u.kind == 0) ? dst[0] : (u.kind == 1) ? dst[1] : dst[2]; *(v4u*)(O + (size_t)row * D + u.pn * 256 + lcol) = pack8(v0, v1); return; }
        if (lcol >= 128) return;
        bf16_t* O = (u.kind == 3) ? dst[3] : (u.kind == 4) ? dst[4] : (u.kind == 5) ? dst[5] : dst[6];
        if (u.kind == 3) {
#pragma unroll
            for (int q = 0; q < 4; ++q) { v0[q] = 1.f - 2.f * __builtin_amdgcn_rcpf(1.f + __expf(2.f * v0[q])); v1[q] = 1.f - 2.f * __builtin_amdgcn_rcpf(1.f + __expf(2.f * v1[q])); } }
        else if (u.kind == 5) {
#pragma unroll
            for (int q = 0; q < 4; ++q) { v0[q] = sigmoidf_(v0[q]); v1[q] = sigmoidf_(v1[q]); } }
        *(v4u*)(O + (size_t)row * 128 + lcol) = pack8(v0, v1);
    }
};
struct EpiR3 {
    struct Ctx { f32x4 b00, b01, b10, b11; };
    bf16_t* WDEC; bf16_t* AD; bf16_t* GB; bf16_t* VGT; const float* w0; const float* a0; const float* v0b;
    __device__ __forceinline__ void begin(Ctx& c, const pg8::Unit& u, int, int lcol0) const {
        const float* p0 = w0; const float* p1 = a0; const float* p2 = v0b; asm volatile("" : "+s"(p0), "+s"(p1), "+s"(p2));
        const float* bp = (u.kind == 0) ? p0 : (u.kind == 1) ? p1 : p2; const int col = u.pn * 256 + lcol0;
        const float* bb = bp + ((u.kind == 2) ? 0 : col);
        c.b00 = *(const f32x4*)(bb); c.b01 = *(const f32x4*)(bb + 4); c.b10 = *(const f32x4*)(bb + 128); c.b11 = *(const f32x4*)(bb + 132);
    }
    static constexpr bool HAS_TAB = true;
    __device__ __forceinline__ const float* bias_of(const pg8::Unit& u) const {
        const float* p0 = w0; const float* p1 = a0; const float* p2 = v0b; asm volatile("" : "+s"(p0), "+s"(p1), "+s"(p2));
        const float* bp = (u.kind == 0) ? p0 : (u.kind == 1) ? p1 : p2; return bp + ((u.kind == 2) ? 0 : u.pn * 256); }
    __device__ __forceinline__ void begin_pre(Ctx& c, const pg8::Unit&, int, int lcol0, const LAS unsigned char* tab) const {
        const LAS float* bb = (const LAS float*)(tab + 1024) + lcol0;
        c.b00 = *(const LAS f32x4*)(bb); c.b01 = *(const LAS f32x4*)(bb + 4); c.b10 = *(const LAS f32x4*)(bb + 128); c.b11 = *(const LAS f32x4*)(bb + 132); }
    __device__ __forceinline__ void begin_half(Ctx&, const pg8::Unit&, int, int, int) const {}
    __device__ __forceinline__ void row8(const Ctx& c, const pg8::Unit& u, int, int bj, int lrow, int lcol, f32x4 v0, f32x4 v1) const {
        const int row = u.pm * 256 + lrow, col = u.pn * 256 + lcol;
        const f32x4 cb0 = bj ? c.b10 : c.b00, cb1 = bj ? c.b11 : c.b01;
        if (u.kind == 0) {
            bf16_t* o = WDEC + ((size_t)(col >> 10) * M + row) * D + (col & 1023);
            f32x4 z0 = v0 + cb0, z1 = v1 + cb1;
#pragma unroll
            for (int q = 0; q < 4; ++q) { z0[q] = SC_DECAY(z0[q]); z1[q] = SC_DECAY(z1[q]); }
            *(v4u*)o = pack8(z0, z1);
        } else if (u.kind == 1) {
            f32x4 z0 = v0 + cb0, z1 = v1 + cb1;
#pragma unroll
            for (int q = 0; q < 4; ++q) { z0[q] = sigmoidf_(z0[q]); z1[q] = sigmoidf_(z1[q]); }
            *(v4u*)(AD + ((size_t)(col >> 10) * M + row) * D + (col & 1023)) = pack8(z0, z1);
        } else if (u.kind == 2) {
            *(v4u*)(GB + (size_t)row * D + col) = pack8(v0, v1);
        } else {
            f32x4 z0 = v0 + cb0, z1 = v1 + cb1;
#pragma unroll
            for (int q = 0; q < 4; ++q) { z0[q] = sigmoidf_(z0[q]); z1[q] = sigmoidf_(z1[q]); }
            *(v4u*)(VGT + (size_t)row * D + col) = pack8(z0, z1);
        }
    }
};
__device__ __forceinline__ float head_sum(float v) { return sum16(v); }
__device__ __forceinline__ void pR4_scan_prep(Frame& F, int jj) {
    const float* k_k = INP(I_RWKV_K_K) + jj * D; const float* k_a = INP(I_RWKV_K_A) + jj * D;
    for (int r = F.gw; r < M; r += F.NGW) {
        f32x4 k[4], kk[4];
        ld_row_bf16(WSP(const bf16_t, WS_KB) + (size_t)r * D, F.lane, k);
#pragma unroll
        for (int q = 0; q < 4; ++q) {
            kk[q] = k[q] * ((const f32x4*)k_k)[F.lane + 64 * q];
            const float ss = head_sum((kk[q].x * kk[q].x + kk[q].y * kk[q].y) + (kk[q].z * kk[q].z + kk[q].w * kk[q].w));
            kk[q] = kk[q] * rsqrtf(fmaxf(ss, 1e-24f));
        }
        st_row_bf16(WSP(bf16_t, WS_KK) + (size_t)r * D, F.lane, kk);
#pragma unroll
        for (int d = 0; d < 2; ++d) {
            f32x4 a[4], o[4];
            ld_row_bf16(WSP(const bf16_t, WS_AD) + ((size_t)d * M + r) * D, F.lane, a);
#pragma unroll
            for (int q = 0; q < 4; ++q) o[q] = k[q] * ((a[q] - 1.f) * ((const f32x4*)k_a)[F.lane + 64 * q] + 1.f);
            st_row_bf16(WSP(bf16_t, WS_KD) + ((size_t)d * M + r) * D, F.lane, o);
#pragma unroll
            for (int q = 0; q < 4; ++q) o[q] = kk[q] * a[q];
            st_row_bf16(WSP(bf16_t, WS_BD) + ((size_t)d * M + r) * D, F.lane, o);
        }
        if (jj > 0) {
            f32x4 v[4], vf[4], vg[4];
            ld_row_bf16(WSP(const bf16_t, WS_VB) + (size_t)r * D, F.lane, v);
            ld_row_bf16(WSP(const bf16_t, WS_VFIRST) + (size_t)r * D, F.lane, vf);
            ld_row_bf16(WSP(const bf16_t, WS_VGT) + (size_t)r * D, F.lane, vg);
#pragma unroll
            for (int q = 0; q < 4; ++q) v[q] = v[q] + (vf[q] - v[q]) * vg[q];
            st_row_bf16(WSP(bf16_t, WS_V2) + (size_t)r * D, F.lane, v);
        }
    }
}
constexpr int SC_CH = 32;
constexpr int SC_STEP_F = 6 * 64;
constexpr int SC_BUF_F = SC_CH * SC_STEP_F;
constexpr int SC_YOFF = 2 * SC_BUF_F * 4;
static_assert(SC_YOFF + 2 * SC_CH * 64 * 4 <= RING_BYTES, "scan LDS");
#if MK_SCAN_SEQ
struct ScanOps { f32x4 w0, w1, k0, k1, b0, b1, q0, q1, r0, r1; float v; };
__device__ __forceinline__ float fma_s(float a, float b, float c) { float d; asm("v_fma_f32 %0, %1, %2, %3" : "=v"(d) : "v"(a), "v"(b), "v"(c)); return d; }
__device__ __forceinline__ float mul_s(float a, float b) { float d; asm("v_mul_f32_e32 %0, %1, %2" : "=v"(d) : "v"(a), "v"(b)); return d; }
__device__ __forceinline__ float add_s(float a, float b) { float d; asm("v_add_f32_e32 %0, %1, %2" : "=v"(d) : "v"(a), "v"(b)); return d; }
__device__ __forceinline__ float fnma_s(float a, float b, float c) { float d; asm("v_fma_f32 %0, -%1, %2, %3" : "=v"(d) : "v"(a), "v"(b), "v"(c)); return d; }
__device__ __forceinline__ void scan_step(f32x4& Sa, f32x4& Sb, const ScanOps& o, float& y) {
    float a0 = mul_s(Sa[0], o.q0[0]), a1 = mul_s(Sb[0], o.q1[0]);
    a0 = fma_s(Sa[1], o.q0[1], a0); a1 = fma_s(Sb[1], o.q1[1], a1); a0 = fma_s(Sa[2], o.q0[2], a0); a1 = fma_s(Sb[2], o.q1[2], a1); a0 = fma_s(Sa[3], o.q0[3], a0); a1 = fma_s(Sb[3], o.q1[3], a1);
    float sa = add_s(a0, a1);
    f32x4 pa, pb;
#pragma unroll
    for (int j = 0; j < 4; ++j) { pa[j] = mul_s(o.v, o.k0[j]); pb[j] = mul_s(o.v, o.k1[j]); }
#pragma unroll
    for (int j = 0; j < 4; ++j) { pa[j] = fma_s(Sa[j], o.w0[j], pa[j]); pb[j] = fma_s(Sb[j], o.w1[j], pb[j]); }
    sa += dpp_xor1(sa); sa += dpp_xor2(sa); sa += dpp_hmir(sa);
#pragma unroll
    for (int j = 0; j < 4; ++j) { Sa[j] = fnma_s(sa, o.b0[j], pa[j]); Sb[j] = fnma_s(sa, o.b1[j], pb[j]); }
    a0 = mul_s(Sa[0], o.r0[0]); a1 = mul_s(Sb[0], o.r1[0]);
    a0 = fma_s(Sa[1], o.r0[1], a0); a1 = fma_s(Sb[1], o.r1[1], a1); a0 = fma_s(Sa[2], o.r0[2], a0); a1 = fma_s(Sb[2], o.r1[2], a1); a0 = fma_s(Sa[3], o.r0[3], a0); a1 = fma_s(Sb[3], o.r1[3], a1);
    y = add_s(a0, a1);
    y += dpp_xor1(y); y += dpp_xor2(y); y += dpp_hmir(y);
}
__device__ __forceinline__ void pR5_scan(Frame& F, int jj) {
    LAS float* lbuf = (LAS float*)(F.lds + RING_OFF);
    LAS float* ybuf = (LAS float*)(F.lds + RING_OFF + SC_YOFF);
    const int tid = F.tid, vrow = tid >> 3, kq = tid & 7;
    const int sstep = tid >> 4, spart = tid & 15;
    const bf16_t* Vsrc = WSP(const bf16_t, (jj == 0) ? WS_VFIRST : WS_V2);
    for (int u = F.bid; u < NB * 16 * 2; u += F.G) {
        const int dir = u & 1, hh = (u >> 1) & 15, b = u >> 5;
        const size_t rowb = (size_t)b * TPB; const int colh = hh * 64 + 4 * spart;
        const float* Wd = WSP(const float, WS_WDEC) + (size_t)dir * M * D; const bf16_t* Kd = WSP(const bf16_t, WS_KD) + (size_t)dir * M * D; const bf16_t* Bd = WSP(const bf16_t, WS_BD) + (size_t)dir * M * D;
        const bf16_t* Kk = WSP(const bf16_t, WS_KK); const bf16_t* Rb = WSP(const bf16_t, WS_RB);
        float* Yd = WSP(float, WS_YS) + (size_t)dir * M * D;
        f32x4 Sa = (f32x4){0.f, 0.f, 0.f, 0.f}, Sb = (f32x4){0.f, 0.f, 0.f, 0.f};
        constexpr int NCH = TPB / SC_CH;
        f32x4 gw_; v2u gk_, gb_, gkk_, gr_, gv_;
#define SC_ROW(c, s) ((dir == 0) ? ((c) * SC_CH + (s)) : (((c) < CTXL / SC_CH) ? (CTXL - 1 - ((c) * SC_CH + (s))) : (TPB - 1 - ((c) * SC_CH + (s) - CTXL))))
#define SC_GLOAD(c) do { const size_t ro = (rowb + (size_t)SC_ROW(c, sstep)) * D + colh; gw_ = *(const f32x4*)(Wd + ro); gk_ = *(const v2u*)(Kd + ro); gb_ = *(const v2u*)(Bd + ro); \
        gkk_ = *(const v2u*)(Kk + ro); gr_ = *(const v2u*)(Rb + ro); gv_ = *(const v2u*)(Vsrc + ro); } while (0)
#define SC_BF4(w) (f32x4){bflo((w).x), bfhi((w).x), bflo((w).y), bfhi((w).y)}
#define SC_LWRITE(bufi) do { LAS float* d_ = lbuf + (bufi) * SC_BUF_F + sstep * SC_STEP_F + 4 * spart; *(LAS f32x4*)(d_) = gw_; *(LAS f32x4*)(d_ + 64) = SC_BF4(gk_); *(LAS f32x4*)(d_ + 128) = SC_BF4(gb_); \
        *(LAS f32x4*)(d_ + 192) = SC_BF4(gkk_); *(LAS f32x4*)(d_ + 256) = SC_BF4(gr_); *(LAS f32x4*)(d_ + 320) = SC_BF4(gv_); } while (0)
#define SC_LDOPS(o, sb) do { (o).w0 = *(const LAS f32x4*)(sb); (o).w1 = *(const LAS f32x4*)((sb) + 4); (o).k0 = *(const LAS f32x4*)((sb) + 64); (o).k1 = *(const LAS f32x4*)((sb) + 68); \
        (o).b0 = *(const LAS f32x4*)((sb) + 128); (o).b1 = *(const LAS f32x4*)((sb) + 132); (o).q0 = *(const LAS f32x4*)((sb) + 192); (o).q1 = *(const LAS f32x4*)((sb) + 196); \
        (o).r0 = *(const LAS f32x4*)((sb) + 256); (o).r1 = *(const LAS f32x4*)((sb) + 260); (o).v = (sb)[320 - 8 * kq + vrow]; } while (0)
        __syncthreads();
        SC_GLOAD(0); SC_LWRITE(0); __syncthreads();
        for (int c = 0; c < NCH; ++c) {
            if (c + 1 < NCH) SC_GLOAD(c + 1);
            if (c > 0) {
                const f32x4 yv = *(const LAS f32x4*)(ybuf + ((c - 1) & 1) * (SC_CH * 64) + sstep * 64 + 4 * spart);
                *(f32x4*)(Yd + (rowb + (size_t)SC_ROW(c - 1, sstep)) * D + colh) = yv;
            }
            const LAS float* cb = lbuf + (c & 1) * SC_BUF_F + 8 * kq;
            LAS float* yb = ybuf + (c & 1) * (SC_CH * 64) + vrow;
            ScanOps cur, nxt; SC_LDOPS(cur, cb);
#pragma unroll
            for (int s = 0; s < SC_CH; ++s) {
                if (s + 1 < SC_CH) SC_LDOPS(nxt, cb + (s + 1) * SC_STEP_F);
                float y; scan_step(Sa, Sb, cur, y);
                if (kq == 0) yb[s * 64] = y;
                cur = nxt;
            }
            if (c + 1 < NCH) SC_LWRITE((c + 1) & 1);
            __syncthreads();
        }
        {
            const f32x4 yv = *(const LAS f32x4*)(ybuf + ((NCH - 1) & 1) * (SC_CH * 64) + sstep * 64 + 4 * spart);
            *(f32x4*)(Yd + (rowb + (size_t)SC_ROW(NCH - 1, sstep)) * D + colh) = yv;
        }
#undef SC_ROW
#undef SC_GLOAD
#undef SC_BF4
#undef SC_LWRITE
#undef SC_LDOPS
    }
}
#else
constexpr int CK_P = 72, CK_MB = 64 * CK_P * 2;
enum { CB_RM = 0, CB_AT, CB_LAK, CB_LRB, CB_LRK, CB_SB, CB_N0, CB_N1, CB_N2, CB_NBUF };
constexpr int CK_PT = 80, CK_TB = 64 * CK_PT * 2, CK_TOFF = CB_NBUF * CK_MB;
enum { CT_VM = 0, CT_BM, CT_KM, CT_NBUF };
constexpr int CK_CW = CB_N0 * CK_MB;
constexpr int CK_SEG = CK_TOFF + CT_NBUF * CK_TB, CK_WC = CK_SEG + 8 * 64 * 4;
static_assert(CK_WC + 64 * 4 <= RING_BYTES && 2 * CK_MB >= 64 * 64 * 4, "chunked scan LDS");
typedef LAS unsigned char* lptr;
struct CkFrag { bf16x8 lo, hi; };
template <int PITCHB = CK_P * 2>
__device__ __forceinline__ CkFrag ck_ld(lptr Mb, int row0, int l15, int g) { const lptr p = Mb + (row0 + l15) * PITCHB + g * 16; CkFrag f; f.lo = *(const LAS bf16x8*)p; f.hi = *(const LAS bf16x8*)(p + 64); return f; }
typedef short ck_v4i16 __attribute__((ext_vector_type(4))); typedef short ck_v8i16 __attribute__((ext_vector_type(8)));
__device__ __forceinline__ CkFrag ck_ld_tr(lptr Mb, int n0, int l15, int g) {
    const lptr p = Mb + (8 * g + (l15 >> 2)) * (CK_PT * 2) + n0 * 2 + (l15 & 3) * 8;
    const ck_v4i16 a = __builtin_amdgcn_ds_read_tr16_b64_v4i16((LAS ck_v4i16*)(p)), b = __builtin_amdgcn_ds_read_tr16_b64_v4i16((LAS ck_v4i16*)(p + 4 * (CK_PT * 2)));
    const ck_v4i16 c = __builtin_amdgcn_ds_read_tr16_b64_v4i16((LAS ck_v4i16*)(p + 32 * (CK_PT * 2))), d = __builtin_amdgcn_ds_read_tr16_b64_v4i16((LAS ck_v4i16*)(p + 36 * (CK_PT * 2)));
    CkFrag f; f.lo = __builtin_bit_cast(bf16x8, (ck_v8i16)__builtin_shufflevector(a, b, 0, 1, 2, 3, 4, 5, 6, 7)); f.hi = __builtin_bit_cast(bf16x8, (ck_v8i16)__builtin_shufflevector(c, d, 0, 1, 2, 3, 4, 5, 6, 7)); return f; }
__device__ __forceinline__ f32x4 ck_mm(f32x4 acc, const CkFrag& a, const CkFrag& b) {
    acc = __builtin_amdgcn_mfma_f32_16x16x32_bf16(a.lo, b.lo, acc, 0, 0, 0); return __builtin_amdgcn_mfma_f32_16x16x32_bf16(a.hi, b.hi, acc, 0, 0, 0); }
__device__ __forceinline__ void ck_st_t(lptr Mb, int row0, int col0, int l15, int g, f32x4 v) {
    v2u w; w.x = pk2(v[0], v[1]); w.y = pk2(v[2], v[3]);
    *(LAS v2u*)(Mb + (col0 + l15) * (CK_P * 2) + (row0 + 4 * g) * 2) = w;
}
__device__ __forceinline__ bf16x8 sm_ld(lptr img, int l15, int g) { return *(const LAS bf16x8*)(img + l15 * 64 + g * 16); }
__device__ __forceinline__ f32x4 mm16(f32x4 acc, bf16x8 a, bf16x8 b) { return __builtin_amdgcn_mfma_f32_16x16x32_bf16(a, b, acc, 0, 0, 0); }
__device__ __forceinline__ void sm_st_t(lptr img, int l15, int g, f32x4 v) {
    v2u w; w.x = pk2(v[0], v[1]); w.y = pk2(v[2], v[3]);
    *(LAS v2u*)(img + l15 * 64 + g * 8) = w; { unsigned zz = 0u; asm volatile("" : "+v"(zz)); *(LAS v2u*)(img + l15 * 64 + 32 + g * 8) = (v2u){zz, zz}; }
}
#ifdef MK_SCANVAR
__device__ __forceinline__ void pR5_scan(Frame& F, int jj, int var = 0) {
    const bool HM = (var & 64) != 0;
#else
__device__ __forceinline__ void pR5_scan(Frame& F, int jj) {
    constexpr bool HM = false;
#endif
    const lptr L0 = F.lds + RING_OFF;
#define CKB(i) (L0 + (i) * CK_MB)
#define CKT(i) (L0 + CK_TOFF + (i) * CK_TB)
    LAS float* CW = (LAS float*)(L0 + CK_CW); LAS float* SEG = (LAS float*)(L0 + CK_SEG); LAS float* WC = (LAS float*)(L0 + CK_WC);
    const int tid = F.tid, lane = tid & 63, wv = F.wave, l15 = lane & 15, g = lane >> 4;
    const int tr16 = (wv >> 1) * 16, tc0 = (wv & 1) * 32;
    const int pk = tid & 63, pseg = tid >> 6;
    const int pt = tid >> 3, pkg = tid & 7;
    const bf16_t* Vsrc = WSP(const bf16_t, (jj == 0) ? WS_VFIRST : WS_VB);
    const f32x4 z4 = (f32x4){0.f, 0.f, 0.f, 0.f};
    for (int u = F.bid; u < NB * 16 * 2; u += F.G) {
        const int dir = u & 1, hh = (u >> 1) & 15, b = u >> 5;
        const int RS = HM ? 64 : D;
        const size_t ub = HM ? (size_t)(b * 16 + hh) * TPB * 64 : (size_t)b * TPB * D + hh * 64;
        const bf16_t* Wd = WSP(const bf16_t, WS_WDEC) + (size_t)dir * M * D + ub; const bf16_t* Kb = WSP(const bf16_t, WS_KB) + ub;
        const bf16_t* Ad = WSP(const bf16_t, WS_AD) + (size_t)dir * M * D + ub; const bf16_t* Rb = WSP(const bf16_t, WS_RB) + ub;
        const bf16_t* Vs = Vsrc + ub; const bf16_t* Vf = WSP(const bf16_t, WS_VFIRST) + ub; const bf16_t* Vg = WSP(const bf16_t, WS_VGT) + ub; bf16_t* Yd = WSP(bf16_t, WS_YS) + (size_t)dir * M * D + ub;
        float kkv[8], kav[8], rkv[8];
        { const float* pkk = INP(I_RWKV_K_K) + jj * D + hh * 64 + 8 * pkg; const float* pka = INP(I_RWKV_K_A) + jj * D + hh * 64 + 8 * pkg; const float* prk = INP(I_RWKV_R_K) + jj * D + hh * 64 + 8 * pkg;
#pragma unroll
          for (int j = 0; j < 8; ++j) { kkv[j] = pkk[j]; kav[j] = pka[j]; rkv[j] = prk[j]; } }
        float* Bon = WSP(float, WS_LOGITS) + ((size_t)dir * M + (size_t)b * TPB) * 16 + hh;
        constexpr int NCK = TPB / 64;
#define CK_ROW(st) ((dir == 0) ? (st) : (((st) < CTXL) ? (CTXL - 1 - (st)) : (TPB - 1 - ((st) - CTXL))))
        unsigned glw[8]; v4u gk, ga, gr, gv, gvf, gvg;
#define CK_GLOADW(c) do { const int rb_ = CK_ROW((c) * 64), sg_ = (dir == 0) ? RS : -RS;        \
        const bf16_t* wl_ = Wd + (size_t)rb_ * RS + (pk & ~1) + (long)sg_ * (8 * pseg); _Pragma("unroll") for (int j = 0; j < 8; ++j) glw[j] = *(const unsigned*)(wl_ + (long)sg_ * j); } while (0)
#define CK_GLOAD(c) do { const int rb_ = CK_ROW((c) * 64), sg_ = (dir == 0) ? RS : -RS; \
        const size_t ro = (size_t)((long)rb_ * RS + (long)sg_ * pt) + 8 * pkg; gk = *(const v4u*)(Kb + ro); ga = *(const v4u*)(Ad + ro); gr = *(const v4u*)(Rb + ro); gv = *(const v4u*)(Vs + ro); \
        if (jj > 0) { gvf = *(const v4u*)(Vf + ro); gvg = *(const v4u*)(Vg + ro); } } while (0)
        f32x4 SaccT[2] = {z4, z4};
        __syncthreads();
        CK_GLOADW(0); CK_GLOAD(0);
        float cl[8];
#define CK_LW(j) ((pk & 1) ? bfhi(glw[j]) : bflo(glw[j]))
#define CK_CUMSEG() do { cl[0] = CK_LW(0); _Pragma("unroll") for (int j = 1; j < 8; ++j) cl[j] = cl[j - 1] + CK_LW(j); SEG[pseg * 64 + pk] = cl[7]; } while (0)
        CK_CUMSEG();
        __syncthreads();
        for (int c = 0; c < NCK; ++c) {
            if (c + 1 < NCK) CK_GLOADW(c + 1);
            const v4u yprev = *(const LAS v4u*)(CKB(CB_N2) + pt * (CK_P * 2) + 16 * pkg);
#pragma unroll
            for (int q = 0; q < 2; ++q) ck_st_t(CKB(CB_SB), tr16, tc0 + 16 * q, l15, g, SaccT[q]);
            { float pre = 0.f;
#pragma unroll
              for (int s2 = 0; s2 < 7; ++s2) pre += (s2 < pseg) ? SEG[s2 * 64 + pk] : 0.f;
#pragma unroll
              for (int j = 0; j < 8; ++j) CW[(8 * pseg + j) * 64 + pk] = __expf(cl[j] + pre);
              if (pseg == 7) WC[pk] = __expf(cl[7] + pre); }
            __syncthreads();
            { const f32x4 c0 = *(const LAS f32x4*)(CW + pt * 64 + 8 * pkg), c1 = *(const LAS f32x4*)(CW + pt * 64 + 8 * pkg + 4);
              f32x4 p0 = (f32x4){1.f, 1.f, 1.f, 1.f}, p1 = p0;
              if (pt > 0) { p0 = *(const LAS f32x4*)(CW + (pt - 1) * 64 + 8 * pkg); p1 = *(const LAS f32x4*)(CW + (pt - 1) * 64 + 8 * pkg + 4); }
              float fa[8], fb[8], fk[8], fr[8], xk[8], xa[8], kkj[8];
              const unsigned wk_[4] = {gk.x, gk.y, gk.z, gk.w}, wa_[4] = {ga.x, ga.y, ga.z, ga.w}, wr[4] = {gr.x, gr.y, gr.z, gr.w};
              float ss = 0.f;
#pragma unroll
              for (int j = 0; j < 8; ++j) { xk[j] = (j & 1) ? bfhi(wk_[j >> 1]) : bflo(wk_[j >> 1]); xa[j] = (j & 1) ? bfhi(wa_[j >> 1]) : bflo(wa_[j >> 1]); kkj[j] = xk[j] * kkv[j]; ss += kkj[j] * kkj[j]; }
              ss += dpp_xor1(ss); ss += dpp_xor2(ss); ss += dpp_hmir(ss);
              const float rn = rsqrtf(fmaxf(ss, 1e-24f)); float bs = 0.f;
#pragma unroll
              for (int j = 0; j < 8; ++j) { const float cwj = (j < 4) ? c0[j & 3] : c1[j & 3], cpj = (j < 4) ? p0[j & 3] : p1[j & 3];
                  const float Wt = cwj, Wi = __builtin_amdgcn_rcpf(Wt), Wp = cpj;
                  const float xr = (j & 1) ? bfhi(wr[j >> 1]) : bflo(wr[j >> 1]), kn = kkj[j] * rn;
                  const float kd = xk[j] * ((xa[j] - 1.f) * kav[j] + 1.f);
                  fa[j] = -kn * Wp; fb[j] = kn * xa[j] * Wi; fk[j] = kd * Wi; fr[j] = xr * Wt; bs += xr * kd * rkv[j]; }
              bs += dpp_xor1(bs); bs += dpp_xor2(bs); bs += dpp_hmir(bs);
              if (pkg == 0) Bon[(size_t)CK_ROW(c * 64 + pt) * 16] = bs;
              if (jj > 0) {
                  const unsigned wv_[4] = {gv.x, gv.y, gv.z, gv.w}, wf_[4] = {gvf.x, gvf.y, gvf.z, gvf.w}, wg_[4] = {gvg.x, gvg.y, gvg.z, gvg.w}; float vm[8];
#pragma unroll
                  for (int j = 0; j < 8; ++j) { const float a_ = (j & 1) ? bfhi(wv_[j >> 1]) : bflo(wv_[j >> 1]), f_ = (j & 1) ? bfhi(wf_[j >> 1]) : bflo(wf_[j >> 1]), g_ = (j & 1) ? bfhi(wg_[j >> 1]) : bflo(wg_[j >> 1]); vm[j] = a_ + (f_ - a_) * g_; }
                  gv.x = pk2(vm[0], vm[1]); gv.y = pk2(vm[2], vm[3]); gv.z = pk2(vm[4], vm[5]); gv.w = pk2(vm[6], vm[7]); }
              v4u oa, ob, ok, orr;
              oa.x = pk2(fa[0], fa[1]); oa.y = pk2(fa[2], fa[3]); oa.z = pk2(fa[4], fa[5]); oa.w = pk2(fa[6], fa[7]);
              ob.x = pk2(fb[0], fb[1]); ob.y = pk2(fb[2], fb[3]); ob.z = pk2(fb[4], fb[5]); ob.w = pk2(fb[6], fb[7]);
              ok.x = pk2(fk[0], fk[1]); ok.y = pk2(fk[2], fk[3]); ok.z = pk2(fk[4], fk[5]); ok.w = pk2(fk[6], fk[7]);
              orr.x = pk2(fr[0], fr[1]); orr.y = pk2(fr[2], fr[3]); orr.z = pk2(fr[4], fr[5]); orr.w = pk2(fr[6], fr[7]);
              const int ro = pt * (CK_P * 2) + 16 * pkg;
              const int rt = pt * (CK_PT * 2) + 16 * pkg;
              *(LAS v4u*)(CKB(CB_AT) + ro) = oa; *(LAS v4u*)(CKT(CT_BM) + rt) = ob; *(LAS v4u*)(CKT(CT_KM) + rt) = ok; *(LAS v4u*)(CKB(CB_RM) + ro) = orr; *(LAS v4u*)(CKT(CT_VM) + rt) = gv; }
            if (c > 0) *(v4u*)(Yd + (size_t)CK_ROW((c - 1) * 64 + pt) * RS + 8 * pkg) = yprev;
            if (c + 1 < NCK) CK_GLOAD(c + 1);
            __syncthreads();
            { const CkFrag aBM = ck_ld<CK_PT * 2>(CKT(CT_BM), tr16, l15, g), aKM = ck_ld<CK_PT * 2>(CKT(CT_KM), tr16, l15, g);
#pragma unroll
              for (int q = 0; q < 2; ++q) { const int tc16 = tc0 + 16 * q; const bool dg = (tr16 == tc16);
                const CkFrag bAT = ck_ld(CKB(CB_AT), tc16, l15, g), bRM = ck_ld(CKB(CB_RM), tc16, l15, g);
                f32x4 pq = ck_mm(z4, aBM, bAT);
                f32x4 lak = ck_mm(z4, aKM, bAT), lrb = ck_mm(z4, aBM, bRM), lrk = ck_mm(z4, aKM, bRM);
#pragma unroll
                for (int r = 0; r < 4; ++r) { const int i = tr16 + 4 * g + r, t = tc16 + l15; if (!(i < t)) { pq[r] = 0.f; lak[r] = 0.f; } if (!(i <= t)) { lrb[r] = 0.f; lrk[r] = 0.f; } }
                if (dg) {
                    const CkFrag aAT = ck_ld(CKB(CB_AT), tr16, l15, g), bBM = ck_ld<CK_PT * 2>(CKT(CT_BM), tc16, l15, g);
                    f32x4 cn = ck_mm(z4, aAT, bBM);
#pragma unroll
                    for (int r = 0; r < 4; ++r) { const int t = tr16 + 4 * g + r, i = tc16 + l15; if (!(i < t)) cn[r] = 0.f; }
                    f32x4 cq = pq, Tt;
#pragma unroll
                    for (int r = 0; r < 4; ++r) Tt[r] = cq[r] + ((4 * g + r == l15) ? 1.f : 0.f);
                    unsigned zz = 0u; asm volatile("" : "+v"(zz));
#define CK_PACK(x) __builtin_bit_cast(bf16x8, (v4u){pk2((x)[0], (x)[1]), pk2((x)[2], (x)[3]), zz, zz})
#pragma unroll
                    for (int lv = 1; lv <= 3; ++lv) {
                        const bf16x8 on = CK_PACK(cn), oq = CK_PACK(cq);
                        cn = mm16(z4, oq, on);
                        if (lv < 3) cq = mm16(z4, on, oq);
                        Tt = mm16(Tt, CK_PACK(cn), CK_PACK(Tt));
                    }
#undef CK_PACK
                    sm_st_t(CKB(CB_N2) + (tr16 >> 4) * 1024, l15, g, Tt);
                    pq = z4;
                }
                ck_st_t(CKB(CB_N1), tr16, tc16, l15, g, pq);
                ck_st_t(CKB(CB_LAK), tr16, tc16, l15, g, lak); ck_st_t(CKB(CB_LRB), tr16, tc16, l15, g, lrb); ck_st_t(CKB(CB_LRK), tr16, tc16, l15, g, lrk);
                } }
            __syncthreads();
            if (wv < 4) {
                const int vb = 16 * wv; unsigned zz = 0u; asm volatile("" : "+v"(zz));
                const CkFrag bSB = ck_ld(CKB(CB_SB), vb, l15, g), bVT = ck_ld_tr(CKT(CT_VM), vb, l15, g);
                CkFrag aAT[4], aLAK[4]; v2u lw_[6], tw[4];
#pragma unroll
                for (int b2 = 0; b2 < 4; ++b2) { aAT[b2] = ck_ld(CKB(CB_AT), 16 * b2, l15, g); aLAK[b2] = ck_ld(CKB(CB_LAK), 16 * b2, l15, g); tw[b2] = *(const LAS v2u*)(CKB(CB_N2) + b2 * 1024 + l15 * 64 + g * 8); }
#pragma unroll
                for (int b2 = 1; b2 < 4; ++b2)
#pragma unroll
                    for (int j2 = 0; j2 < b2; ++j2) lw_[b2 * (b2 - 1) / 2 + j2] = *(const LAS v2u*)(CKB(CB_N1) + (16 * b2 + l15) * (CK_P * 2) + (16 * j2 + 4 * g) * 2);
                f32x4 R[4];
#pragma unroll
                for (int b2 = 0; b2 < 4; ++b2) { R[b2] = ck_mm(z4, aAT[b2], bSB); R[b2] = ck_mm(R[b2], aLAK[b2], bVT); }
#pragma unroll
                for (int b2 = 0; b2 < 4; ++b2) {
                    const f32x4 U = mm16(z4, __builtin_bit_cast(bf16x8, (v4u){tw[b2].x, tw[b2].y, zz, zz}), __builtin_bit_cast(bf16x8, (v4u){pk2(R[b2][0], R[b2][1]), pk2(R[b2][2], R[b2][3]), zz, zz}));
                    const bf16x8 Up = __builtin_bit_cast(bf16x8, (v4u){pk2(U[0], U[1]), pk2(U[2], U[3]), zz, zz});
                    ck_st_t(CKB(CB_N0), 16 * b2, vb, l15, g, U);
#pragma unroll
                    for (int b3 = b2 + 1; b3 < 4; ++b3) R[b3] = mm16(R[b3], __builtin_bit_cast(bf16x8, (v4u){lw_[b3 * (b3 - 1) / 2 + b2].x, lw_[b3 * (b3 - 1) / 2 + b2].y, zz, zz}), Up);
                }
            }
            __syncthreads();
            { const CkFrag aSB = ck_ld(CKB(CB_SB), tr16, l15, g), aUT = ck_ld(CKB(CB_N0), tr16, l15, g), aVT = ck_ld_tr(CKT(CT_VM), tr16, l15, g), aBMT = ck_ld_tr(CKT(CT_BM), tr16, l15, g), aKMT = ck_ld_tr(CKT(CT_KM), tr16, l15, g);
              const f32x4 wc = *(const LAS f32x4*)(WC + tr16 + 4 * g);
#pragma unroll
              for (int q = 0; q < 2; ++q) { const int tc16 = tc0 + 16 * q;
                const CkFrag bRM = ck_ld(CKB(CB_RM), tc16, l15, g), bLRB = ck_ld(CKB(CB_LRB), tc16, l15, g), bLRK = ck_ld(CKB(CB_LRK), tc16, l15, g), bUT = ck_ld(CKB(CB_N0), tc16, l15, g), bVT = ck_ld_tr(CKT(CT_VM), tc16, l15, g);
                f32x4 yt = ck_mm(z4, aSB, bRM); yt = ck_mm(yt, aUT, bLRB); yt = ck_mm(yt, aVT, bLRK);
                ck_st_t(CKB(CB_N2), tr16, tc16, l15, g, yt);
                SaccT[q] = ck_mm(SaccT[q], aBMT, bUT); SaccT[q] = ck_mm(SaccT[q], aKMT, bVT); SaccT[q] = SaccT[q] * wc; } }
            if (c + 1 < NCK) CK_CUMSEG();
            __syncthreads();
        }
        *(v4u*)(Yd + (size_t)CK_ROW((NCK - 1) * 64 + pt) * RS + 8 * pkg) = *(const LAS v4u*)(CKB(CB_N2) + pt * (CK_P * 2) + 16 * pkg);
#undef CK_CUMSEG
#undef CK_LW
#undef CK_ROW
#undef CK_GLOAD
#undef CK_GLOADW
    }
#undef CKB
#undef CKT
}
#endif
__device__ __forceinline__ void pR6_out(Frame& F, int jj) {
    const float* ln_w = INP(I_RWKV_LN_W) + jj * D; const float* ln_b = INP(I_RWKV_LN_B) + jj * D;
    v2u ry[4], ry1[4], rg[4], rv[4], rvf[4], rvg[4]; float rb0[4], rb1[4];
#define R6_ROW(P_, r_, dst_) do { _Pragma("unroll") for (int q = 0; q < 4; ++q) dst_[q] = __builtin_nontemporal_load(&((const v2u*)(WSP(const bf16_t, P_) + (size_t)(r_) * D))[F.lane + 64 * q]); } while (0)
#define R6_LOAD(r_) do { R6_ROW(WS_YS, (r_), ry); R6_ROW(WS_YS, (size_t)M + (r_), ry1); R6_ROW(WS_GB, (r_), rg); \
        if (jj == 0) R6_ROW(WS_VFIRST, (r_), rv); else { R6_ROW(WS_VB, (r_), rv); R6_ROW(WS_VFIRST, (r_), rvf); R6_ROW(WS_VGT, (r_), rvg); } \
        const float* bon_ = WSP(const float, WS_LOGITS) + (size_t)(r_) * 16 + (F.lane >> 4);        \
        _Pragma("unroll") for (int q = 0; q < 4; ++q) { rb0[q] = bon_[4 * q]; rb1[q] = bon_[(size_t)M * 16 + 4 * q]; } } while (0)
#define R6_UNP(w_) ((f32x4){bflo((w_).x), bfhi((w_).x), bflo((w_).y), bfhi((w_).y)})
    if (F.gw < M) R6_LOAD(F.gw);
    for (int r = F.gw; r < M; r += F.NGW) {
        f32x4 yy[4], v[4], g[4]; float bonus[4];
#pragma unroll
        for (int q = 0; q < 4; ++q) { yy[q] = R6_UNP(ry[q]) + R6_UNP(ry1[q]); g[q] = R6_UNP(rg[q]); v[q] = R6_UNP(rv[q]); bonus[q] = rb0[q] + rb1[q];
            if (jj != 0) { const f32x4 vf = R6_UNP(rvf[q]), vg = R6_UNP(rvg[q]); v[q] = v[q] + (vf - v[q]) * vg; } }
        if (r + F.NGW < M) R6_LOAD(r + F.NGW);
        f32x4 o[4];
#pragma unroll
        for (int q = 0; q < 4; ++q) {
            const float mu = head_sum((yy[q].x + yy[q].y) + (yy[q].z + yy[q].w)) * (1.f / 64.f);
            const f32x4 dlt = yy[q] - mu;
            const float var = head_sum((dlt.x * dlt.x + dlt.y * dlt.y) + (dlt.z * dlt.z + dlt.w * dlt.w)) * (1.f / 64.f);
            const f32x4 yn = dlt * rsqrtf(var + GN_EPS) * ((const f32x4*)ln_w)[F.lane + 64 * q] + ((const f32x4*)ln_b)[F.lane + 64 * q];
            o[q] = (yn + v[q] * bonus[q]) * g[q];
        }
        st_row_bf16(WSP(bf16_t, WS_OB) + (size_t)r * D, F.lane, o);
    }
#undef R6_ROW
#undef R6_LOAD
#undef R6_UNP
}
#define RWKV_PHASES(p0, L, J) \
    { const unsigned char* swo = (const unsigned char*)F.ws + WS_SMALLW + SW_OD + (size_t)(J) * OD_BYTES; \
    if (IN((p0) + 0)) { pR1_mix(F, (J)); SEAM((p0) + 0); } \
    if (IN((p0) + 1)) { MultiOrder<7> S; const char* xm = (const char*)(F.ws + WS_XMIX); \
        S.s[0] = SubGemm{xm + 0 * ROWB2, (const char*)(swo + OD_WR), 2048, 1024, 4, 0}; S.s[1] = SubGemm{xm + 2 * ROWB2, (const char*)(swo + OD_WK), 2048, 1024, 4, 1}; \
        S.s[2] = SubGemm{xm + 3 * ROWB2, (const char*)(swo + OD_WV), 2048, 1024, 4, 2}; S.s[3] = SubGemm{xm + 1 * ROWB2, (const char*)(swo + OD_W1C), 2048, 1024, 1, 3}; \
        S.s[4] = SubGemm{xm + 4 * ROWB2, (const char*)(swo + OD_A1C), 2048, 1024, 1, 4}; S.s[5] = SubGemm{xm + 5 * ROWB2, (const char*)(swo + OD_G1), 2048, 1024, 1, 5}; \
        S.s[6] = SubGemm{xm + 3 * ROWB2, (const char*)(swo + OD_V1), 2048, 1024, ((J) > 0) ? 1 : 0, 6}; S.init(F.G, F.bid, 1); \
        EpiR2 E; E.dst[0] = WSP(bf16_t, WS_RB); E.dst[1] = WSP(bf16_t, WS_KB); E.dst[2] = WSP(bf16_t, ((J) == 0) ? WS_VFIRST : WS_VB); E.dst[3] = WSP(bf16_t, WS_LW); E.dst[4] = WSP(bf16_t, WS_LA); \
        E.dst[5] = WSP(bf16_t, WS_LG); E.dst[6] = WSP(bf16_t, WS_LV); pg8::gemm_phase(ring, S, E, F.wave); SEAM((p0) + 1); } \
    if (IN((p0) + 2)) { MultiOrder<4> S; \
        S.s[0] = SubGemm{(const char*)(F.ws + WS_LW), (const char*)(swo + OD_W2C), 256, 128, 8, 0}; S.s[1] = SubGemm{(const char*)(F.ws + WS_LA), (const char*)(swo + OD_A2C), 256, 128, 8, 1}; \
        S.s[2] = SubGemm{(const char*)(F.ws + WS_LG), (const char*)(swo + OD_G2), 256, 128, 4, 2}; S.s[3] = SubGemm{(const char*)(F.ws + WS_LV), (const char*)(swo + OD_V2), 256, 128, ((J) > 0) ? 4 : 0, 3}; S.init(F.G, F.bid); \
        EpiR3 E{WSP(bf16_t, WS_WDEC), WSP(bf16_t, WS_AD), WSP(bf16_t, WS_GB), WSP(bf16_t, WS_VGT), INP(I_RWKV_W0) + (size_t)(J) * 2 * D, INP(I_RWKV_A0) + (size_t)(J) * 2 * D, INP(I_RWKV_V0)}; \
        pg8::gemm_phase(ring, S, E, F.wave); SEAM((p0) + 2); } \
      \
    if (IN((p0) + 4)) { pR5_scan(F, (J)); SEAM((p0) + 4); } \
    if (IN((p0) + 5)) { pR6_out(F, (J)); SEAM((p0) + 5); } \
    if (IN((p0) + 6)) { MultiOrder<1> S; S.s[0] = SubGemm{(const char*)(F.ws + WS_OB), (const char*)(swo + OD_WO), 2048, 1024, 4, 0}; S.init(F.G, F.bid); \
        EpiResidual E{WSP(bf16_t, WS_XR), WSP(const float, WS_MOD) + (size_t)(L) * 9 * 6144 + 2 * 1024}; pg8::gemm_phase(ring, S, E, F.wave); SEAM((p0) + 6); } }
#define MOE_PHASES(p0, L) \
    if (IN((p0) + 0)) { pF1R_norm_router(F, args, (L)); SEAM((p0) + 0); } \
      \
    if (IN((p0) + 2) && F.G * NWAVES * 17 < M) { pF3_route(F, (L)); SEAM((p0) + 2); }     \
    if (IN((p0) + 3)) { const int tt = moe_table(F, (L)); MoeOrder<8, 4, 2> S; int z_ = 0; asm volatile("" : "+s"(z_)); S.tb = (const LAS int*)(F.lds + LDSCTL_OFF + z_); S.A = (const char*)(F.ws + WS_HB); \
        S.W = (const char*)(F.ws + WS_W1T) + (size_t)(L) * 32 * 2048 * 1024 * 2; S.RI = WSP(const int, WS_ROWIDX); S.G = F.G; S.c = F.bid; S.nwg = ((tt + 3) / 4) * 4 * 8; \
        EpiSwiglu E{WSP(bf16_t, WS_ACT), INP(I_MOE_B1) + (size_t)(L) * 32 * 2048}; pg8::gemm_phase<EpiSwiglu, MoeOrder<8, 4, 2>, 2>(ring, S, E, F.wave); SEAM((p0) + 3); } \
    if (IN((p0) + 4)) { const int tt = moe_table(F, (L)); MoeOrder<4, 8, 0> S; int z_ = 0; asm volatile("" : "+s"(z_)); S.tb = (const LAS int*)(F.lds + LDSCTL_OFF + z_); S.A = (const char*)(F.ws + WS_ACT); \
        S.W = (const char*)(F.ws + WS_W2T) + (size_t)(L) * 32 * 1024 * 1024 * 2; S.RI = WSP(const int, WS_ROWIDX); S.G = F.G; S.c = F.bid; S.nwg = ((tt + 7) / 8) * 8 * 4; \
        EpiMoeDown E{WSP(bf16_t, WS_YB), INP(I_MOE_B2) + (size_t)(L) * 32 * 1024}; pg8::gemm_phase<EpiMoeDown, MoeOrder<4, 8, 0>, 0>(ring, S, E, F.wave); SEAM((p0) + 4); } \
    if (IN((p0) + 5)) { pF6_combine(F, args, (L)); SEAM((p0) + 5); }
constexpr int PH_P0 = 0, PH_P1 = 1, PH_LAYER0 = 2, PH_PER_PAIR = 25, PH_COPY = PH_LAYER0 + 2 * PH_PER_PAIR, PH_TOTAL = PH_COPY + 1;
__global__ void __launch_bounds__(NTHREADS, 2) fwd(Args args) {
    extern __shared__ __attribute__((aligned(16))) unsigned char lds_raw[];
    Frame F;
    F.lds = (LAS unsigned char*)lds_raw;
    F.MISC = (volatile LAS unsigned*)(F.lds + MISC_OFF);
    F.tid = threadIdx.x; F.lane = F.tid & 63; F.wave = __builtin_amdgcn_readfirstlane(F.tid >> 6);
    F.G = gridDim.x; F.bid = blockIdx.x; F.gw = F.bid * NWAVES + F.wave; F.NGW = F.G * NWAVES;
    F.ws = (GAS unsigned char*)args.ws; F.ctl = (gu32*)(args.ws + WS_CTL);
    for (int u = F.tid; u < (LDS_BYTES - LDSCTL_OFF) / 4; u += NTHREADS) ((LAS unsigned*)(F.lds + LDSCTL_OFF))[u] = 0u;
    __syncthreads();
    if (F.tid <= N_IN) { const unsigned long long pv = (F.tid < N_IN) ? (unsigned long long)args.in[F.tid] : (unsigned long long)args.out; *(LAS unsigned long long*)(F.lds + PTR_OFF + 8 * F.tid) = pv; }
    __syncthreads();
    XcdBarrier bar = xcd_barrier_post((unsigned*)(F.ctl + CW_BAR) + args.bli * XCD_BAR_WORDS, F.MISC + 8);
    const int lo = args.ph_lo, hi = args.ph_hi;
#define IN(k) (lo <= (k) && (k) < hi && phase_fence(F))
#define SEAM(k) do { if (lo <= (k) + 1 && (k) + 1 < hi) { XcdBarrier b2_ = bar; asm volatile("" : "+s"(b2_.bar), "+s"(b2_.x), "+s"(b2_.w)); xcd_barrier(b2_); } } while (0)
    if (IN(PH_P0)) { p0_prologue(F, args); SEAM(PH_P0); }
    if (IN(PH_P1)) { p1_init(F, args); SEAM(PH_P1); }
    LAS unsigned char* ring = F.lds + RING_OFF;
    for (int lp = 0; lp < 2; ++lp) {
        const int pb = PH_LAYER0 + lp * PH_PER_PAIR;
        if (hi <= pb) break;
        {
            const int layer = 2 * lp, e = lp;
            const unsigned char* swe = (const unsigned char*)F.ws + WS_SMALLW + SW_EV + (size_t)e * EV_BYTES;
            if (IN(pb + 0)) {
                MultiOrder<1> S; S.s[0] = SubGemm{(const char*)(F.ws + WS_HB), (const char*)(swe + EV_WIN), 2048, 1024, 7, 0}; S.init(F.G, F.bid);
                EpiStoreBf16 E{WSP(bf16_t, WS_PROJ), PROJ_LD, PROJ_LD};
                pg8::gemm_phase(ring, S, E, F.wave); SEAM(pb + 0); }
            if (IN(pb + 1)) { pA2_proj_norms(F, args, e); SEAM(pb + 1); }
            if (IN(pb + 2)) {
                MultiOrder<2> S; S.s[0] = SubGemm{(const char*)(F.ws + WS_PROJ) + C_ZQ * 2, (const char*)(swe + EV_WUQ), PROJ_LD * 2, 384, 3, 0};
                S.s[1] = SubGemm{(const char*)(F.ws + WS_PROJ) + C_ZKV * 2, (const char*)(swe + EV_WUKV), PROJ_LD * 2, 256, 4, 1}; S.init(F.G, F.bid);
                EpiStore2 E{WSP(bf16_t, WS_QM), 768, WSP(bf16_t, WS_KVM), 1024};
                pg8::gemm_phase(ring, S, E, F.wave); SEAM(pb + 2); }
            if (IN(pb + 3)) { pA4_mla_norms(F, args, e); SEAM(pb + 3); }
            if (IN(pb + 4)) { pA5_attention(F, lp == 0); SEAM(pb + 4); }
            if (IN(pb + 5)) {
                MultiOrder<1> S; S.s[0] = SubGemm{(const char*)(F.ws + WS_OB), (const char*)(swe + EV_WOUT), 2048, 1024, 4, 0}; S.init(F.G, F.bid);
                EpiResidual E{WSP(bf16_t, WS_XR), WSP(const float, WS_MOD) + (size_t)layer * 9 * 6144 + 2 * 1024};
                pg8::gemm_phase(ring, S, E, F.wave); SEAM(pb + 5); }
            MOE_PHASES(pb + 6, layer)
        }
        {
            const int layer = 2 * lp + 1, jj = lp;
            RWKV_PHASES(pb + 12, layer, jj)
            MOE_PHASES(pb + 19, layer)
        }
    }
    if (IN(PH_COPY)) { p_copy_out(F, args); }
#ifdef MK_SCANVAR
    for (int v_ = 0; v_ < 128; v_ += 64) if (IN(60 + v_)) pR5_scan(F, 1, v_);
#endif
#undef IN
#undef SEAM
}

extern "C" void kernel_launch(void* const* d_in, const int* in_sizes, int n_in, void* d_out, int out_size, void* d_ws, size_t ws_size, hipStream_t stream) {
    static int grid = 0;
    if (grid == 0) {
        if (n_in != N_IN || out_size != NB * SEQ * D || ws_size < WS_END) { fprintf(stderr, "kernel_launch: unexpected shapes: n_in %d out %d ws %zu (need %zu)\n", n_in, out_size, ws_size, (size_t)WS_END); grid = -1; return; }
        int dev = 0, cus = 0, per_cu = 0;
        if (hipGetDevice(&dev) != hipSuccess || hipDeviceGetAttribute(&cus, hipDeviceAttributeMultiprocessorCount, dev) != hipSuccess) { grid = -1; return; }
        if (hipFuncSetAttribute((const void*)fwd, hipFuncAttributeMaxDynamicSharedMemorySize, LDS_BYTES) != hipSuccess) { fprintf(stderr, "kernel_launch: hipFuncSetAttribute failed\n"); grid = -1; return; }
        if (hipOccupancyMaxActiveBlocksPerMultiprocessor(&per_cu, (const void*)fwd, NTHREADS, LDS_BYTES) != hipSuccess || per_cu < 1) { fprintf(stderr, "kernel_launch: occupancy query says %d\n", per_cu); }
        (void)hipGetLastError();
        grid = cus;
        if (grid > 256) grid = 256;
    }
    if (grid < 0) return;
    (void)hipMemsetAsync((char*)d_ws + WS_CTL, 0, CTL_BYTES, stream);
    (void)hipMemsetAsync((char*)d_ws + WS_SMALLW, 0, SMALLW_BYTES, stream);
    Args a{};
    for (int i = 0; i < N_IN; ++i) a.in[i] = (const float*)d_in[i];
    a.out = (float*)d_out; a.ws = (unsigned char*)d_ws;
#ifdef MK_RANGES
    { static const int ranges[][2] = { MK_RANGES };
      for (unsigned i = 0; i < sizeof(ranges) / sizeof(ranges[0]); ++i) { a.ph_lo = ranges[i][0]; a.ph_hi = ranges[i][1]; a.bli = (int)i; hipLaunchKernelGGL(fwd, dim3(grid), dim3(NTHREADS), LDS_BYTES, stream, a); } }
#elif MK_PER_PHASE
    for (int p = 0; p < PH_COPY; ++p) { a.ph_lo = p; a.ph_hi = p + 1; hipLaunchKernelGGL(fwd, dim3(grid), dim3(NTHREADS), LDS_BYTES, stream, a); }
#else
    a.ph_lo = 0; a.ph_hi = PH_COPY;
    hipLaunchKernelGGL(fwd, dim3(grid), dim3(NTHREADS), LDS_BYTES, stream, a);
#endif
}
```

```cpp
#include <hip/hip_runtime.h>
#include <cstdio>
#include <cstdint>

#ifndef MK_PER_PHASE
#define MK_PER_PHASE 0
#endif
#ifndef MK_LAST_PHASE
#define MK_LAST_PHASE 9999
#endif

#define GAS __attribute__((address_space(1)))
#define LAS __attribute__((address_space(3)))
typedef unsigned short bf16_t;
typedef unsigned v4u __attribute__((ext_vector_type(4)));
typedef unsigned v2u __attribute__((ext_vector_type(2)));
typedef float f32x4 __attribute__((ext_vector_type(4)));
typedef float f32x2 __attribute__((ext_vector_type(2)));
typedef float f32x16 __attribute__((ext_vector_type(16)));
typedef short bf16x8 __attribute__((ext_vector_type(8)));
typedef short s16x4 __attribute__((ext_vector_type(4)));
typedef GAS unsigned gu32;
#define RLX_AGENT __ATOMIC_RELAXED, __HIP_MEMORY_SCOPE_AGENT
#define LDS_WAIT() asm volatile("s_waitcnt lgkmcnt(0)" ::: "memory")
#define VM_WAIT() asm volatile("s_waitcnt vmcnt(0)" ::: "memory")

constexpr int D = 1024, NB = 8, SEQ = 4096, CTXL = 256, DEPTH = 4;
constexpr int TPB = SEQ + CTXL;
constexpr int M = NB * TPB;
constexpr int NPANEL = M / 256;
constexpr int NMOD = 6;
constexpr int PROJ_LD = 1792;
constexpr int C_ZQ = 0, C_ZKV = 384, C_ZR = 640, C_GQ = 704, C_GK = 1216, C_GV = 1472;
constexpr int NE = 32, TOPK = 4, FF = 1024;
constexpr int CAP = M;
constexpr float NORM_EPS = 1e-6f, GN_EPS = 64e-5f;
constexpr float MLA_SCALE = 0.07216878364870322f;
constexpr float GQA_SCALE = 0.08838834764831845f;
constexpr int NWAVES = 8, NTHREADS = 512;

enum { I_X = 0, I_C, I_CTX, I_CCTX, I_ADA_W, I_ADA_B, I_NORM_MIX, I_NORM_FFN, I_ATTN_W_IN, I_MLA_Q_NORM, I_MLA_W_UQ, I_MLA_KV_NORM, I_MLA_W_UKV,
       I_MLA_QN_G, I_MLA_QR_G, I_MLA_KN_G, I_MLA_KR_G, I_GQA_Q_G, I_GQA_K_G, I_ATTN_W_OUT, I_RWKV_MIX, I_RWKV_W_R, I_RWKV_W_K, I_RWKV_W_V, I_RWKV_W_O,
       I_RWKV_W0, I_RWKV_W1, I_RWKV_W2, I_RWKV_A0, I_RWKV_A1, I_RWKV_A2, I_RWKV_V0, I_RWKV_V1, I_RWKV_V2, I_RWKV_G1, I_RWKV_G2, I_RWKV_K_K, I_RWKV_K_A,
       I_RWKV_R_K, I_RWKV_LN_W, I_RWKV_LN_B, I_MOE_ROUTER_W, I_MOE_ROUTER_B, I_MOE_W1, I_MOE_B1, I_MOE_W2, I_MOE_B2, N_IN };

constexpr size_t MiB = 1u << 20;
constexpr size_t WS_CTL = 0, CTL_BYTES = 1 * MiB;
constexpr size_t WS_MOD = WS_CTL + CTL_BYTES;
constexpr size_t WS_SMALLW = WS_MOD + 1 * MiB;
constexpr size_t EV_WIN = 0, EV_WUQ = EV_WIN + (size_t)1792 * 1024 * 2, EV_WUKV = EV_WUQ + (size_t)768 * 384 * 2, EV_WOUT = EV_WUKV + (size_t)1024 * 256 * 2,
                 EV_BYTES = EV_WOUT + (size_t)1024 * 1024 * 2;
constexpr size_t OD_WR = 0, OD_WK = OD_WR + 2 * MiB, OD_WV = OD_WK + 2 * MiB, OD_WO = OD_WV + 2 * MiB, OD_W1C = OD_WO + 2 * MiB, OD_A1C = OD_W1C + 512 * 1024,
                 OD_G1 = OD_A1C + 512 * 1024, OD_V1 = OD_G1 + 512 * 1024, OD_W2C = OD_V1 + 512 * 1024, OD_A2C = OD_W2C + 512 * 1024, OD_G2 = OD_A2C + 512 * 1024,
                 OD_V2 = OD_G2 + 256 * 1024, OD_BYTES = OD_V2 + 256 * 1024;
constexpr size_t RT_BYTES = (size_t)256 * 1024 * 2;
constexpr size_t SW_EV = 0, SW_OD = SW_EV + 2 * EV_BYTES, SW_RT = SW_OD + 2 * OD_BYTES, SMALLW_BYTES = ((SW_RT + 4 * RT_BYTES + MiB - 1) / MiB) * MiB;
constexpr size_t WS_W1T = WS_SMALLW + SMALLW_BYTES;
constexpr size_t WS_W2T = WS_W1T + (size_t)128 * 2048 * 1024 * 2;
constexpr size_t WS_XR = WS_W2T + (size_t)128 * 1024 * 1024 * 2;
constexpr size_t ROWB2 = (size_t)M * 1024 * 2;
constexpr size_t WS_HB = WS_XR + 2 * ROWB2;
constexpr size_t WS_OB = WS_HB + ROWB2;
constexpr size_t WS_LOGITS = WS_OB + ROWB2;
constexpr size_t WS_TOPI = WS_LOGITS + (size_t)M * 32 * 4;
constexpr size_t WS_TOPG = WS_TOPI + (size_t)M * 16;
constexpr size_t WS_ROWIDX = WS_TOPG + (size_t)M * 16;
constexpr size_t WS_ACT = ((WS_ROWIDX + (size_t)NE * CAP * 4 + MiB - 1) / MiB) * MiB;
constexpr size_t WS_YB = WS_ACT + 4 * ROWB2;
constexpr size_t WS_MIX = WS_YB + 4 * ROWB2;
constexpr size_t WS_PROJ = WS_MIX;
constexpr size_t WS_QM = WS_PROJ + (size_t)M * PROJ_LD * 2;
constexpr size_t WS_KVM = WS_QM + (size_t)M * 768 * 2;
constexpr size_t WS_ATT_END = WS_KVM + ROWB2;
constexpr size_t WS_XMIX = WS_MIX;
constexpr size_t WS_RB = WS_XMIX + 6 * ROWB2, WS_KB = WS_RB + ROWB2, WS_VB = WS_KB + ROWB2;
constexpr size_t WS_LW = WS_VB + ROWB2, LORA_B = (size_t)M * 128 * 2, WS_LA = WS_LW + LORA_B, WS_LG = WS_LA + LORA_B, WS_LV = WS_LG + LORA_B;
constexpr size_t WS_WDEC = WS_LV + LORA_B;
constexpr size_t WS_AD = WS_WDEC + 4 * ROWB2;
constexpr size_t WS_GB = WS_AD + 2 * ROWB2, WS_VGT = WS_GB + ROWB2;
constexpr size_t WS_KK = WS_VGT + ROWB2, WS_KD = WS_KK + ROWB2, WS_BD = WS_KD + 2 * ROWB2, WS_V2 = WS_BD + 2 * ROWB2;
constexpr size_t WS_YS = WS_V2 + ROWB2;
constexpr size_t WS_RWKV_END = WS_YS + 4 * ROWB2;
constexpr size_t WS_VFIRST = WS_RWKV_END;
constexpr size_t WS_END = WS_VFIRST + ROWB2;
static_assert(WS_ATT_END <= WS_RWKV_END, "mixer scratch overlay");
static_assert(WS_END <= (size_t)4096 * MiB, "d_ws map must fit 4 GiB");

constexpr int CW_TMO = 0, CW_CODE = 1;
constexpr int CW_ECNT = 1024;
constexpr int CW_BAR = 16384;
constexpr int MAX_BAR_REGIONS = 64;
static_assert(CW_ECNT + 4 * 32 * 64 <= CW_BAR && (CW_BAR + MAX_BAR_REGIONS * 3456) * 4 <= (int)CTL_BYTES, "CTL words inside the memset region");

constexpr int RING_OFF = 0, RING_BYTES = 153600;
constexpr int LDSCTL_OFF = RING_BYTES, MISC_OFF = LDSCTL_OFF + 320;
constexpr int LDS_BYTES = RING_BYTES + 4096;
static_assert(MISC_OFF + 128 <= LDS_BYTES, "LDS map");

__device__ __forceinline__ unsigned f2bf(float f) { unsigned u = __builtin_bit_cast(unsigned, f); return (u + 0x7fffu + ((u >> 16) & 1u)) >> 16; }
typedef __bf16 bf16x2_t __attribute__((ext_vector_type(2)));
__device__ __forceinline__ unsigned pk2(float lo, float hi) { const f32x2 v = {lo, hi}; const bf16x2_t b = __builtin_convertvector(v, bf16x2_t); return __builtin_bit_cast(unsigned, b); }
__device__ __forceinline__ float bf2f(unsigned short h) { return __builtin_bit_cast(float, (unsigned)h << 16); }
__device__ __forceinline__ float bflo(unsigned w) { return __builtin_bit_cast(float, w << 16); }
__device__ __forceinline__ float bfhi(unsigned w) { return __builtin_bit_cast(float, w & 0xffff0000u); }
__device__ __forceinline__ int lane_now() { int l; asm volatile("v_mbcnt_lo_u32_b32 %0, -1, 0\n\tv_mbcnt_hi_u32_b32 %0, -1, %0" : "=v"(l)); return l; }
__device__ __forceinline__ int opaque_tid(int wave) { int t = wave * 64 + lane_now(); asm volatile("" : "+v"(t)); return t; }
__device__ __forceinline__ int lanes_get(int v, int src_lane) { return __builtin_amdgcn_ds_bpermute(src_lane << 2, v); }
__device__ __forceinline__ float lanes_xor(float v, int m) { return __builtin_bit_cast(float, __builtin_amdgcn_ds_bpermute((lane_now() ^ m) << 2, __builtin_bit_cast(int, v))); }
__device__ __forceinline__ float dpp_xor1(float x) { return __builtin_bit_cast(float, __builtin_amdgcn_update_dpp(0, __builtin_bit_cast(int, x), 0xB1, 0xF, 0xF, true)); }
__device__ __forceinline__ float dpp_xor2(float x) { return __builtin_bit_cast(float, __builtin_amdgcn_update_dpp(0, __builtin_bit_cast(int, x), 0x4E, 0xF, 0xF, true)); }
__device__ __forceinline__ float dpp_hmir(float x) { return __builtin_bit_cast(float, __builtin_amdgcn_update_dpp(0, __builtin_bit_cast(int, x), 0x141, 0xF, 0xF, true)); }
__device__ __forceinline__ float sum8(float x) { x += dpp_xor1(x); x += dpp_xor2(x); x += dpp_hmir(x); return x; }
__device__ __forceinline__ float dpp_rmir(float x) { return __builtin_bit_cast(float, __builtin_amdgcn_update_dpp(0, __builtin_bit_cast(int, x), 0x140, 0xF, 0xF, true)); }
__device__ __forceinline__ float sum16(float x) { x += dpp_xor1(x); x += dpp_xor2(x); x += dpp_hmir(x); x += dpp_rmir(x); return x; }
__device__ __forceinline__ float wave_sum(float v) {
    const int s = __builtin_bit_cast(int, sum16(v));
    return (__builtin_bit_cast(float, __builtin_amdgcn_readlane(s, 0)) + __builtin_bit_cast(float, __builtin_amdgcn_readlane(s, 16))) + (__builtin_bit_cast(float, __builtin_amdgcn_readlane(s, 32)) + __builtin_bit_cast(float, __builtin_amdgcn_readlane(s, 48)));
}
__device__ __forceinline__ float sigmoidf_(float x) { return __builtin_amdgcn_rcpf(1.f + __expf(-x)); }
__device__ __forceinline__ float siluf_(float x) { return x * __builtin_amdgcn_rcpf(1.f + __expf(-x)); }
#define XB_TMO      128
#define XB_XCNT(j)  (256  + 64 * (j))
#define XB_XSUB(j)  (1280 + 64 * (j))
#define XB_XGEN(j)  (2304 + 64 * (j))
#define XB_TOP      3328
#define XB_TOPGEN   3392
#define XCD_BAR_WORDS 3456
#define XB_SPIN_CAP (1u << 18)

__device__ __forceinline__ unsigned xb_ld(unsigned* p)              { return __hip_atomic_load(p, __ATOMIC_RELAXED, __HIP_MEMORY_SCOPE_AGENT); }
__device__ __forceinline__ unsigned xb_add(unsigned* p, unsigned v) { return __hip_atomic_fetch_add(p, v, __ATOMIC_RELAXED, __HIP_MEMORY_SCOPE_AGENT); }
__device__ __forceinline__ unsigned xb_xcc_id() { return (unsigned)__builtin_amdgcn_s_getreg((3 << 11) | 20) & 0xFu; }
#define XB_SPIN(cond, bar) do { unsigned _sp = 0; while (cond) { __builtin_amdgcn_s_sleep(1); \
    if ((++_sp & 255u) == 0u) { if (xb_ld(&(bar)[XB_TMO])) break; if (_sp > XB_SPIN_CAP) { atomicAdd(&(bar)[XB_TMO], 1u); break; } } } } while (0)

struct XcdBarrier {
    unsigned* bar; unsigned x; int w;
    volatile LAS unsigned* st;
};

__device__ __forceinline__ XcdBarrier xcd_barrier_post(unsigned* bar, volatile LAS unsigned* st) {
    XcdBarrier b; b.bar = bar; b.x = xb_xcc_id(); b.st = st; b.w = __builtin_amdgcn_readfirstlane((int)threadIdx.x >> 6);
    if (threadIdx.x == 0) (void)xb_add(&bar[XB_XCNT(b.x)], 1u);
    return b;
}
__device__ __forceinline__ void xcd_barrier_complete(unsigned* bar, unsigned x, unsigned& nloc, unsigned& nx) {
    const unsigned G = gridDim.x * gridDim.y * gridDim.z;
    unsigned sum, cnt, mine, sp = 0u;
    for (;;) {
        sum = 0u; cnt = 0u; mine = 0u;
#pragma unroll
        for (unsigned j = 0; j < 16; ++j) { const unsigned c = xb_ld(&bar[XB_XCNT(j)]); sum += c; cnt += (c > 0u) ? 1u : 0u; mine = (j == x) ? c : mine; }
        if (sum == G) break;
        __builtin_amdgcn_s_sleep(1);
        if ((++sp & 255u) == 0u) { if (xb_ld(&bar[XB_TMO])) break; if (sp > XB_SPIN_CAP) { atomicAdd(&bar[XB_TMO], 1u); break; } }
    }
    nloc = mine > 0u ? mine : 1u; nx = cnt > 0u ? cnt : 1u;
}

__device__ __forceinline__ void xcd_barrier(const XcdBarrier& b) {
    asm volatile("s_waitcnt vmcnt(0)" ::: "memory");
    __syncthreads();
    if (b.w == 0 && lane_now() == 0) {
        unsigned* bar = b.bar;
        __builtin_amdgcn_s_waitcnt(0);
        unsigned nloc = b.st[0], nx = b.st[1];
        if (nloc == 0u) { xcd_barrier_complete(bar, b.x, nloc, nx); b.st[0] = nloc; b.st[1] = nx; }
        const unsigned old = xb_add(&bar[XB_XSUB(b.x)], 1u);
        const unsigned gen = old / nloc;
        if (old + 1u == (gen + 1u) * nloc) {
            __builtin_amdgcn_fence(__ATOMIC_RELEASE, "agent");
            asm volatile("s_waitcnt vmcnt(0)" ::: "memory");
            const unsigned og = xb_add(&bar[XB_TOP], 1u);
            const unsigned tg = og / nx;
            if (og + 1u == (tg + 1u) * nx) xb_add(&bar[XB_TOPGEN], 1u);
            else XB_SPIN(xb_ld(&bar[XB_TOPGEN]) == tg, bar);
            __builtin_amdgcn_fence(__ATOMIC_ACQUIRE, "agent");
            xb_add(&bar[XB_XGEN(b.x)], 1u);
            asm volatile("s_waitcnt vmcnt(0)" ::: "memory");
        } else {
            XB_SPIN(xb_ld(&bar[XB_XGEN(b.x)]) == gen, bar);
            __builtin_amdgcn_fence(__ATOMIC_ACQUIRE, "agent");
            asm volatile("s_waitcnt vmcnt(0)" ::: "memory");
        }
    }
    __syncthreads();
}
namespace pg8 {
constexpr int BM = 256, BK = 64, HALF = 128, HTB = HALF * BK * 2  , STAGE_BYTES = 8 * HTB, IDX_OFF = STAGE_BYTES  ,
              TAB_OFF = IDX_OFF + 16384  ;

__host__ __device__ __forceinline__ int lds_byte(int r, int c) { const int st = (r >> 4) * 2 + (c >> 5), rr = r & 15, cc = c & 31, ob = rr * 64 + cc * 2; return st * 1024 + (ob ^ (((ob >> 9) & 1) << 5)); }
__host__ __device__ __forceinline__ void stage_rc(int b, int& R, int& C) { const int st = b / 1024, sb = b % 1024, swz = sb ^ (((sb >> 9) & 1) << 5); R = (st >> 1) * 16 + swz / 64; C = (st & 1) * 32 + (swz % 64) / 2; }
__host__ __device__ __forceinline__ int perm32(int rho) { const int n = rho >> 4, i = rho & 15; return 8 * (i >> 2) + 4 * n + (i & 3); }

struct Unit {
    const char* A; const char* B;
    int lda;
    int K;
    int pm, pn;
    int kind;
    int e;
    int nrows;
    const int* ridx;
};

__device__ __forceinline__ int rfl(int v) { return __builtin_amdgcn_readfirstlane(v); }
template <class T> __device__ __forceinline__ T* rflp(T* p) { const unsigned long long v = (unsigned long long)p; const unsigned lo = __builtin_amdgcn_readfirstlane((unsigned)v), hi = __builtin_amdgcn_readfirstlane((unsigned)(v >> 32));
    return (T*)(((unsigned long long)hi << 32) | lo); }
__device__ __forceinline__ void uniformize(Unit& u) { u.A = rflp(u.A); u.B = rflp(u.B); u.lda = rfl(u.lda); u.K = rfl(u.K); u.pm = rfl(u.pm); u.pn = rfl(u.pn); u.kind = rfl(u.kind); u.e = rfl(u.e); u.nrows = rfl(u.nrows); u.ridx = rflp(u.ridx); }
__device__ __forceinline__ unsigned cvt_pk_bf16(float lo, float hi) { unsigned r; asm volatile("v_cvt_pk_bf16_f32 %0, %1, %2" : "=v"(r) : "v"(lo), "v"(hi)); return r; }

template <class T, class = void> struct epi_has_tab { static constexpr bool value = false; };
template <class T> struct epi_has_tab<T, decltype((void)T::HAS_TAB)> { static constexpr bool value = true; };
template <class Epi, bool PRE = false>
__device__ __forceinline__ void run_epilogue(const Epi& E, const f32x4 (&acc)[2][2][4][2], const Unit& u, int wr, int wc, int fr, int fq, const LAS unsigned char* tab = nullptr) {
    typename Epi::Ctx c;
    const int lrow0 = wr * 64 + fr, lcol0 = wc * 32 + 8 * fq;
    if constexpr (PRE) E.begin_pre(c, u, lrow0, lcol0, tab); else E.begin(c, u, lrow0, lcol0);
#pragma unroll
    for (int ai = 0; ai < 2; ++ai) {
        E.begin_half(c, u, ai, lrow0, lcol0);
#pragma unroll
        for (int m = 0; m < 4; ++m)
#pragma unroll
            for (int bj = 0; bj < 2; ++bj) E.row8(c, u, ai * 4 + m, bj, lrow0 + ai * HALF + m * 16, lcol0 + bj * HALF, acc[ai][bj][m][0], acc[ai][bj][m][1]);
    }
}

template <class Epi, class Sched, int GSH = -1>
__device__ __forceinline__ void gemm_phase(LAS unsigned char* lds, const Sched& S, const Epi& E, int wave_) {
    const int tid = opaque_tid(wave_), wid = __builtin_amdgcn_readfirstlane(tid >> 6), lane = tid & 63, wr = wid >> 2, wc = wid & 3, fr = lane & 15, fq = lane >> 4;
    int R0, C0, R1, C1; stage_rc(tid * 16, R0, C0); stage_rc(tid * 16 + 8192, R1, C1);
    const int Rb0 = (R0 & ~31) + perm32(R0 & 31), Rb1 = (R1 & ~31) + perm32(R1 & 31);
    const unsigned ldsw = (unsigned)wid * 1024u;
    const int aoff = lds_byte(wr * 64 + fr, fq * 8), boff = lds_byte(wc * 32 + fr, fq * 8);
#define PG8_SA(b, h) (((b) * 2 + (h)) * HTB)
#define PG8_SB(b, h) ((4 + (b) * 2 + (h)) * HTB)
#define PG8_STAGE2(bufoff, gbase, o0, o1) do { \
        __builtin_amdgcn_global_load_lds((const unsigned*)((const char*)(gbase) + (o0)), (LAS unsigned*)(lds + (bufoff) + ldsw), 16, 0, 0); \
        __builtin_amdgcn_global_load_lds((const unsigned*)((const char*)(gbase) + (o1)), (LAS unsigned*)(lds + (bufoff) + ldsw + 8192), 16, 0, 0); } while (0)
#define PG8_LDA(dst, b, h) do { _Pragma("unroll") for (int m = 0; m < 4; ++m) _Pragma("unroll") for (int k = 0; k < 2; ++k) dst[m][k] = *(const LAS bf16x8*)(lds + PG8_SA(b, h) + aoff + m * 2048 + k * 1024); } while (0)
#define PG8_LDB(dst, b, h) do { _Pragma("unroll") for (int n = 0; n < 2; ++n) _Pragma("unroll") for (int k = 0; k < 2; ++k) dst[n][k] = *(const LAS bf16x8*)(lds + PG8_SB(b, h) + boff + n * 2048 + k * 1024); } while (0)
#define PG8_MMA(ai, bj, At, Bt) do { __builtin_amdgcn_s_setprio(1); _Pragma("unroll") for (int m = 0; m < 4; ++m) _Pragma("unroll") for (int n = 0; n < 2; ++n) _Pragma("unroll") for (int k = 0; k < 2; ++k) \
        acc[ai][bj][m][n] = __builtin_amdgcn_mfma_f32_16x16x32_bf16(Bt[n][k], At[m][k], acc[ai][bj][m][n], 0, 0, 0); __builtin_amdgcn_s_setprio(0); } while (0)
#define PG8_WAIT_V(n) asm volatile("s_waitcnt vmcnt(" #n ")" ::: "memory")
#define PG8_WAIT_L(n) asm volatile("s_waitcnt lgkmcnt(" #n ")" ::: "memory")
#define PG8_BAR __builtin_amdgcn_s_barrier()
#define PG8_SCHED __builtin_amdgcn_sched_barrier(0)
#define PG8_OFFS(u, a00, a01, a10, a11, b0, b1, hs) do { \
        if constexpr (GSH >= 0) { \
            const int i00 = (R0 < (u).nrows) ? (u).ridx[R0] : 0, i01 = (R1 < (u).nrows) ? (u).ridx[R1] : 0; \
            const int i10 = (HALF + R0 < (u).nrows) ? (u).ridx[HALF + R0] : 0, i11 = (HALF + R1 < (u).nrows) ? (u).ridx[HALF + R1] : 0; \
            a00 = (unsigned)(i00 >> GSH) * (unsigned)(u).lda + C0 * 2; a01 = (unsigned)(i01 >> GSH) * (unsigned)(u).lda + C1 * 2; \
            a10 = (unsigned)(i10 >> GSH) * (unsigned)(u).lda + C0 * 2; a11 = (unsigned)(i11 >> GSH) * (unsigned)(u).lda + C1 * 2; \
        } else { \
            const unsigned rb = (unsigned)((u).pm * BM) * (unsigned)(u).lda; \
            a00 = rb + (unsigned)R0 * (unsigned)(u).lda + C0 * 2; a01 = rb + (unsigned)R1 * (unsigned)(u).lda + C1 * 2; \
            a10 = a00 + (unsigned)HALF * (unsigned)(u).lda; a11 = a01 + (unsigned)HALF * (unsigned)(u).lda; } \
        b0 = (unsigned)(Rb0 * (u).K + C0) * 2u; b1 = (unsigned)(Rb1 * (u).K + C1) * 2u; hs = (unsigned)HALF * (unsigned)(u).K * 2u; } while (0)
    Unit cur, nxt; int ui = 0;
    if (!S.next(0, cur)) return;
    uniformize(cur);
    f32x4 acc[2][2][4][2];
#pragma unroll
    for (int a = 0; a < 2; ++a)
#pragma unroll
        for (int b = 0; b < 2; ++b)
#pragma unroll
            for (int m = 0; m < 4; ++m)
#pragma unroll
                for (int n = 0; n < 2; ++n) acc[a][b][m][n] = (f32x4){0.f, 0.f, 0.f, 0.f};
    bf16x8 At[4][2], B0[2][2], B1[2][2];
    unsigned ca00, ca01, ca10, ca11, cb0, cb1, chs;
    unsigned na00, na01, na10, na11, nb0, nb1, nhs;
    PG8_OFFS(cur, ca00, ca01, ca10, ca11, cb0, cb1, chs);
    const char* cA = cur.A; const char* cB = cur.B;
    constexpr unsigned kstep = BK * 2;
    PG8_STAGE2(PG8_SB(0, 0), cB, cb0, cb1); PG8_STAGE2(PG8_SB(0, 1), cB + chs, cb0, cb1); PG8_STAGE2(PG8_SA(0, 0), cA, ca00, ca01); PG8_STAGE2(PG8_SA(0, 1), cA, ca10, ca11);
    if (wr == 1) PG8_BAR;
    PG8_WAIT_V(2); PG8_BAR;
    PG8_STAGE2(PG8_SB(1, 0), cB + kstep, cb0, cb1); PG8_STAGE2(PG8_SA(1, 0), cA + kstep, ca00, ca01); PG8_STAGE2(PG8_SB(1, 1), cB + chs + kstep, cb0, cb1);
    PG8_WAIT_V(6); PG8_BAR;
    for (;;) {
        if constexpr (GSH >= 0) {
            LAS unsigned char* tb = lds + TAB_OFF + (ui & 1) * 2048;
            if (wid < 4) __builtin_amdgcn_global_load_lds((const unsigned*)(cur.ridx + wid * 64 + lane), (LAS unsigned*)(tb + wid * 256), 4, 0, 0);
            else __builtin_amdgcn_global_load_lds((const unsigned*)(E.bias_of(cur) + (wid - 4) * 64 + lane), (LAS unsigned*)(tb + 1024 + (wid - 4) * 256), 4, 0, 0);
        }
        else if constexpr (epi_has_tab<Epi>::value) {
            if (wid >= 4) __builtin_amdgcn_global_load_lds((const unsigned*)(E.bias_of(cur) + (wid - 4) * 64 + lane), (LAS unsigned*)(lds + TAB_OFF + (ui & 1) * 2048 + 1024 + (wid - 4) * 256), 4, 0, 0);
        }
        const bool has_next = S.next(ui + 1, nxt); uniformize(nxt);
        const char* nA = cA; const char* nB = cB; na00 = ca00; na01 = ca01; na10 = ca10; na11 = ca11; nb0 = cb0; nb1 = cb1; nhs = chs;
        if (has_next) { nA = nxt.A; nB = nxt.B;
            if constexpr (GSH >= 0) {
                nb0 = (unsigned)(Rb0 * nxt.K + C0) * 2u; nb1 = (unsigned)(Rb1 * nxt.K + C1) * 2u; nhs = (unsigned)HALF * (unsigned)nxt.K * 2u;
                LAS unsigned char* ib = lds + IDX_OFF + (ui & 1) * 8192 + wid * 1024;
                __builtin_amdgcn_global_load_lds((const unsigned*)(nxt.ridx + R0), (LAS unsigned*)(ib), 4, 0, 0);
                __builtin_amdgcn_global_load_lds((const unsigned*)(nxt.ridx + R1), (LAS unsigned*)(ib + 256), 4, 0, 0);
                __builtin_amdgcn_global_load_lds((const unsigned*)(nxt.ridx + HALF + R0), (LAS unsigned*)(ib + 512), 4, 0, 0);
                __builtin_amdgcn_global_load_lds((const unsigned*)(nxt.ridx + HALF + R1), (LAS unsigned*)(ib + 768), 4, 0, 0);
            } else { PG8_OFFS(nxt, na00, na01, na10, na11, nb0, nb1, nhs); } }
        const int nt = cur.K / BK;
        for (int t = 0; t < nt; t += 2) {
            const bool last = (t == nt - 2);
            if constexpr (GSH >= 0) { if (last && has_next) {
                const LAS unsigned char* ib = lds + IDX_OFF + (ui & 1) * 8192 + wid * 1024 + lane * 4;
                int i00 = *(const LAS int*)(ib), i01 = *(const LAS int*)(ib + 256), i10 = *(const LAS int*)(ib + 512), i11 = *(const LAS int*)(ib + 768);
                i00 = (R0 < nxt.nrows) ? i00 : 0; i01 = (R1 < nxt.nrows) ? i01 : 0; i10 = (HALF + R0 < nxt.nrows) ? i10 : 0; i11 = (HALF + R1 < nxt.nrows) ? i11 : 0;
                na00 = (unsigned)(i00 >> GSH) * (unsigned)nxt.lda + C0 * 2; na01 = (unsigned)(i01 >> GSH) * (unsigned)nxt.lda + C1 * 2;
                na10 = (unsigned)(i10 >> GSH) * (unsigned)nxt.lda + C0 * 2; na11 = (unsigned)(i11 >> GSH) * (unsigned)nxt.lda + C1 * 2; } }
            const char* a1 = cA + (size_t)(t + 1) * kstep;
            const char* a2 = last ? nA : cA + (size_t)(t + 2) * kstep; const char* b2 = last ? nB : cB + (size_t)(t + 2) * kstep;
            const char* a3 = a2 + kstep; const char* b3 = b2 + kstep;
            const unsigned xa00 = last ? na00 : ca00, xa01 = last ? na01 : ca01, xa10 = last ? na10 : ca10, xa11 = last ? na11 : ca11;
            const unsigned xb0 = last ? nb0 : cb0, xb1 = last ? nb1 : cb1, xhs = last ? nhs : chs;
            PG8_LDB(B0, 0, 0); PG8_LDB(B1, 0, 1); PG8_SCHED; PG8_LDA(At, 0, 0); PG8_STAGE2(PG8_SA(1, 1), a1, ca10, ca11);
            PG8_WAIT_V(8); PG8_WAIT_L(0); PG8_BAR; PG8_MMA(0, 0, At, B0); PG8_MMA(0, 1, At, B1); PG8_BAR; PG8_SCHED;
            PG8_LDA(At, 0, 1); PG8_STAGE2(PG8_SB(0, 0), b2, xb0, xb1); PG8_STAGE2(PG8_SB(0, 1), b2 + xhs, xb0, xb1); PG8_STAGE2(PG8_SA(0, 0), a2, xa00, xa01);
            PG8_WAIT_V(8); PG8_WAIT_L(0); PG8_BAR; PG8_MMA(1, 0, At, B0); PG8_MMA(1, 1, At, B1); PG8_BAR; PG8_SCHED;
            PG8_LDB(B0, 1, 0); PG8_LDB(B1, 1, 1); PG8_SCHED; PG8_LDA(At, 1, 0); PG8_STAGE2(PG8_SA(0, 1), a2, xa10, xa11);
            PG8_WAIT_V(8); PG8_WAIT_L(0); PG8_BAR; PG8_MMA(0, 0, At, B0); PG8_MMA(0, 1, At, B1); PG8_BAR; PG8_SCHED;
            PG8_LDA(At, 1, 1); PG8_STAGE2(PG8_SB(1, 0), b3, xb0, xb1); PG8_STAGE2(PG8_SB(1, 1), b3 + xhs, xb0, xb1); PG8_STAGE2(PG8_SA(1, 0), a3, xa00, xa01);
            PG8_WAIT_V(8); PG8_WAIT_L(0); PG8_BAR; PG8_MMA(1, 0, At, B0); PG8_MMA(1, 1, At, B1); PG8_BAR; PG8_SCHED;
        }
        if (wr == 0) PG8_BAR;
        if constexpr (GSH >= 0 || epi_has_tab<Epi>::value) run_epilogue<Epi, true>(E, acc, cur, wr, wc, fr, fq, lds + TAB_OFF + (ui & 1) * 2048); else run_epilogue(E, acc, cur, wr, wc, fr, fq);
        if (!has_next) break;
#pragma unroll
        for (int a = 0; a < 2; ++a)
#pragma unroll
            for (int b = 0; b < 2; ++b)
#pragma unroll
                for (int m = 0; m < 4; ++m)
#pragma unroll
                    for (int n = 0; n < 2; ++n) acc[a][b][m][n] = (f32x4){0.f, 0.f, 0.f, 0.f};
        cur = nxt; cA = nA; cB = nB; ca00 = na00; ca01 = na01; ca10 = na10; ca11 = na11; cb0 = nb0; cb1 = nb1; chs = nhs; ++ui;
        if (wr == 1) PG8_BAR;
    }
    PG8_WAIT_V(0);
    PG8_BAR;
#undef PG8_SA
#undef PG8_SB
#undef PG8_STAGE2
#undef PG8_LDA
#undef PG8_LDB
#undef PG8_MMA
#undef PG8_WAIT_V
#undef PG8_WAIT_L
#undef PG8_BAR
#undef PG8_SCHED
#undef PG8_OFFS
}
}
namespace att {
constexpr int NW = 8, QBLK = 32, KVBLK = 64;
constexpr float THR = 8.f;
constexpr int SHM_V = KVBLK * 128 * 2, SHM_K = KVBLK * 128 * 2, SHM_R = KVBLK * 64 * 2;
constexpr int OFF_V = 0, OFF_K = 2 * SHM_V, OFF_R = OFF_K + 2 * SHM_K, OFF_WS = OFF_R + 2 * SHM_R, OFF_QR = OFF_WS + NW * 64 * 4, ATTN_LDS_GQA = OFF_QR, QL_MAX = 8, ATTN_LDS = OFF_QR + NW * QL_MAX * 1024;
#define KSWZ(row, colB) ((row) * 256 + ((colB) ^ (((row) & 7) << 4)))
#define RSWZ(row, colB) ((row) * 128 + ((colB) ^ ((((row) >> 1) & 7) << 4)))
#define SBAR() __builtin_amdgcn_sched_barrier(0)
__device__ __forceinline__ int crow(int r, int hi) { return (r & 3) + 8 * (r >> 2) + 4 * hi; }
__device__ __forceinline__ unsigned cvtpk(float lo, float hi) { unsigned r; asm volatile("v_cvt_pk_bf16_f32 %0, %1, %2" : "=v"(r) : "v"(lo), "v"(hi)); return r; }

template <int DK>
__device__ __forceinline__ void partialSM(f32x16& p0, f32x16& p1, float& m_reg, float& mn, float& alpha) {
  constexpr float SCALE = (DK == 192) ? MLA_SCALE : GQA_SCALE;
  constexpr float C = SCALE * 1.4426950408889634f;
  float pmax = p0[0];
#pragma unroll
  for (int r = 1; r < 16; ++r) pmax = fmaxf(pmax, p0[r]);
#pragma unroll
  for (int r = 0; r < 16; ++r) pmax = fmaxf(pmax, p1[r]);
  { auto rr = __builtin_amdgcn_permlane32_swap(__float_as_uint(pmax), __float_as_uint(pmax), false, false);
    pmax = fmaxf(__uint_as_float(rr[0]), __uint_as_float(rr[1])); }
  if (__builtin_expect(__all(pmax - m_reg <= THR / SCALE), 1)) { mn = m_reg; alpha = 1.f; }
  else { mn = fmaxf(m_reg, pmax); alpha = __builtin_amdgcn_exp2f((m_reg - mn) * C); m_reg = mn; }
  float mnC = -mn * C;
#pragma unroll
  for (int r = 0; r < 16; ++r) p0[r] = fmaf(p0[r], C, mnC);
#pragma unroll
  for (int r = 0; r < 16; ++r) p1[r] = fmaf(p1[r], C, mnC);
#pragma unroll
  for (int r = 0; r < 16; ++r) p0[r] = __builtin_amdgcn_exp2f(p0[r]);
}
__device__ __forceinline__ void finishSM(f32x16& p0, f32x16& p1, float alpha, float& l_reg, bf16x8& pa0, bf16x8& pa1, bf16x8& pa2, bf16x8& pa3) {
#pragma unroll
  for (int r = 0; r < 16; ++r) p1[r] = __builtin_amdgcn_exp2f(p1[r]);
  float ps = 0;
#pragma unroll
  for (int r = 0; r < 16; ++r) ps += p0[r];
#pragma unroll
  for (int r = 0; r < 16; ++r) ps += p1[r];
  { auto rr = __builtin_amdgcn_permlane32_swap(__float_as_uint(ps), __float_as_uint(ps), false, false);
    ps = __uint_as_float(rr[0]) + __uint_as_float(rr[1]); }
  l_reg = l_reg * alpha + ps;
#define PK4(P, BASE, OUT) do { unsigned a0 = cvtpk(P[BASE + 0], P[BASE + 1]), a1 = cvtpk(P[BASE + 2], P[BASE + 3]);   \
    unsigned b0 = cvtpk(P[BASE + 4], P[BASE + 5]), b1 = cvtpk(P[BASE + 6], P[BASE + 7]);                              \
    auto r0 = __builtin_amdgcn_permlane32_swap(a0, b0, false, false); auto r1 = __builtin_amdgcn_permlane32_swap(a1, b1, false, false); \
    v4u w = {r0[0], r1[0], r0[1], r1[1]}; OUT = __builtin_bit_cast(bf16x8, w); } while (0)
  PK4(p0, 0, pa0); PK4(p0, 8, pa1); PK4(p1, 0, pa2); PK4(p1, 8, pa3);
#undef PK4
}
template <int DK, int QREG, bool QSB = (DK == 192)>
__device__ __forceinline__ void qkt(f32x16& p0, f32x16& p1, const char* Ks, const char* Rs, const bf16x8* qr, const char* Qrl, int r32, int hi) {
  p0 = f32x16{}; p1 = f32x16{};
#pragma unroll
  for (int d0 = 0; d0 < 8; ++d0) { const int cb = (d0 * 16 + hi * 8) * 2;
    bf16x8 b0 = *reinterpret_cast<const bf16x8*>(Ks + KSWZ(r32, cb));
    bf16x8 b1 = *reinterpret_cast<const bf16x8*>(Ks + KSWZ(32 + r32, cb));
    bf16x8 qf; if constexpr (true) { if (d0 < QREG) qf = qr[d0 < QREG ? d0 : 0]; else qf = *reinterpret_cast<const bf16x8*>(Qrl + (d0 - QREG) * (NW * 1024)); }
    p0 = __builtin_amdgcn_mfma_f32_32x32x16_bf16(b0, qf, p0, 0, 0, 0);
    p1 = __builtin_amdgcn_mfma_f32_32x32x16_bf16(b1, qf, p1, 0, 0, 0);
    if (QSB && (d0 & 3) == 3) SBAR(); }
  if constexpr (DK == 192) {
#pragma unroll
    for (int d0 = 0; d0 < 4; ++d0) { const int cb = (d0 * 16 + hi * 8) * 2;
      bf16x8 b0 = *reinterpret_cast<const bf16x8*>(Rs + RSWZ(r32, cb));
      bf16x8 b1 = *reinterpret_cast<const bf16x8*>(Rs + RSWZ(32 + r32, cb));
      const bf16x8 qf = *reinterpret_cast<const bf16x8*>(Qrl + (8 + d0 - QREG) * (NW * 1024));
      p0 = __builtin_amdgcn_mfma_f32_32x32x16_bf16(b0, qf, p0, 0, 0, 0);
      p1 = __builtin_amdgcn_mfma_f32_32x32x16_bf16(b1, qf, p1, 0, 0, 0); }
  }
}
__device__ __forceinline__ int v_st(int k, int c) { const int kk = (k & ~0xC) | ((k & 4) << 1) | ((k & 8) >> 1); return ((kk >> 3) * 4 + (c >> 5)) * 512 + ((kk & 7) * 32 + (c & 31)) * 2; }
__device__ __forceinline__ int v_rd_base(int lane) { return ((lane & 3) << 3) | (((lane >> 2) & 3) << 6) | (((lane >> 4) & 1) << 5) | (((lane >> 5) & 1) << 8); }
constexpr int v_rd_off(int d0, int ks, int half) { return d0 * 512 + ks * 4096 + half * 2048; }
template <int OFF> __device__ __forceinline__ s16x4 tr_read(int vb) {
  s16x4 r; asm volatile("ds_read_b64_tr_b16 %0, %1 offset:%2" : "=&v"(r) : "v"(vb), "i"(OFF) : "memory"); return r;
}
template <int D0> __device__ __forceinline__ void pv_one(f32x16& od, int vb, bf16x8 pa0, bf16x8 pa1, bf16x8 pa2, bf16x8 pa3) {
  const s16x4 l0 = tr_read<v_rd_off(D0, 0, 0)>(vb), h0 = tr_read<v_rd_off(D0, 0, 1)>(vb), l1 = tr_read<v_rd_off(D0, 1, 0)>(vb), h1 = tr_read<v_rd_off(D0, 1, 1)>(vb);
  const s16x4 l2 = tr_read<v_rd_off(D0, 2, 0)>(vb), h2 = tr_read<v_rd_off(D0, 2, 1)>(vb), l3 = tr_read<v_rd_off(D0, 3, 0)>(vb), h3 = tr_read<v_rd_off(D0, 3, 1)>(vb);
  asm volatile("s_waitcnt lgkmcnt(0)" ::: "memory"); SBAR();
#define PK(L, H) (bf16x8){L[0], L[1], L[2], L[3], H[0], H[1], H[2], H[3]}
  od = __builtin_amdgcn_mfma_f32_32x32x16_bf16(pa0, PK(l0, h0), od, 0, 0, 0);
  od = __builtin_amdgcn_mfma_f32_32x32x16_bf16(pa1, PK(l1, h1), od, 0, 0, 0);
  od = __builtin_amdgcn_mfma_f32_32x32x16_bf16(pa2, PK(l2, h2), od, 0, 0, 0);
  od = __builtin_amdgcn_mfma_f32_32x32x16_bf16(pa3, PK(l3, h3), od, 0, 0, 0);
#undef PK
}
__device__ __forceinline__ void pv_d0(f32x16* o, int vb, bf16x8 pa0, bf16x8 pa1, bf16x8 pa2, bf16x8 pa3) {
  pv_one<0>(o[0], vb, pa0, pa1, pa2, pa3); pv_one<1>(o[1], vb, pa0, pa1, pa2, pa3); pv_one<2>(o[2], vb, pa0, pa1, pa2, pa3); pv_one<3>(o[3], vb, pa0, pa1, pa2, pa3);
}

template <int DK, int SDEPTH, int QREG, int LDQ, int LDK, int LDR, int LDV, int LDO>
__device__ __forceinline__ void attn_unit(const bf16_t* __restrict__ Qb, const bf16_t* __restrict__ Kh, const bf16_t* __restrict__ Rh,
                                          const bf16_t* __restrict__ Vh, bf16_t* __restrict__ Ob, int seq, char* lds, int wave_) {
  const int tid = opaque_tid(wave_), wid = tid >> 6, lane = tid & 63, r32 = lane & 31, hi = lane >> 5;
  char* V_lds = lds + OFF_V; char* K_lds = lds + OFF_K; char* R_lds = lds + OFF_R;
  float* ws = (float*)(lds + OFF_WS) + wid * 64; float* li_l = ws; float* al_l = ws + 32;
  float m_reg = -1e30f, l_reg = 0; f32x16 o[4] = {}; bf16x8 qr[QREG];
  static_assert(DK / 16 - QREG <= QL_MAX, "q fragments in LDS");
  char* Qrl = lds + OFF_QR + wid * 1024 + lane * 16;
  const bf16_t* Qw = Qb + (long)(wid * QBLK + r32) * LDQ + hi * 8;
#pragma unroll
  for (int d0 = 0; d0 < QREG; ++d0) qr[d0] = *reinterpret_cast<const bf16x8*>(Qw + d0 * 16);
#pragma unroll
  for (int d0 = QREG; d0 < DK / 16; ++d0) *reinterpret_cast<bf16x8*>(Qrl + (d0 - QREG) * (NW * 1024)) = *reinterpret_cast<const bf16x8*>(Qw + d0 * 16);
  const int sr = tid >> 4, sc = (tid & 15) * 8, vst0 = v_st(sr, sc), vst1 = v_st(32 + sr, sc);
  const int rr_ = tid >> 3, rc_ = (tid & 7) * 8;
  const int vb0 = (int)(uintptr_t)V_lds + v_rd_base(lane);
  struct { bf16x8 vs0, vs1, ks0, ks1; } sr_[SDEPTH];
  bf16x8 rs_[SDEPTH];
  const unsigned voV = (unsigned)(sr * LDV + sc) * 2u, voK = (unsigned)(sr * LDK + sc) * 2u, voR = (unsigned)(rr_ * LDR + rc_) * 2u;
#define GLD(base, uoff, voff) (*reinterpret_cast<const bf16x8*>((const char*)(base) + (size_t)(uoff) + (voff)))
#define SLOAD(i, k0) do { sr_[i].vs0 = GLD(Vh, (size_t)(k0) * LDV * 2, voV); sr_[i].vs1 = GLD(Vh, (size_t)((k0) + 32) * LDV * 2, voV); \
    sr_[i].ks0 = GLD(Kh, (size_t)(k0) * LDK * 2, voK); sr_[i].ks1 = GLD(Kh, (size_t)((k0) + 32) * LDK * 2, voK); \
    if constexpr (DK == 192) rs_[i] = GLD(Rh, (size_t)(k0) * LDR * 2, voR); } while (0)
#define SWRITE(b, i) do { *(bf16x8*)(V_lds + (b) * SHM_V + vst0) = sr_[i].vs0;          \
    *(bf16x8*)(V_lds + (b) * SHM_V + vst1) = sr_[i].vs1; const int kc = sc * 2;               \
    *(bf16x8*)(K_lds + (b) * SHM_K + KSWZ(sr, kc)) = sr_[i].ks0;                       \
    *(bf16x8*)(K_lds + (b) * SHM_K + KSWZ(32 + sr, kc)) = sr_[i].ks1;                  \
    if constexpr (DK == 192) *(bf16x8*)(R_lds + (b) * SHM_R + RSWZ(rr_, rc_ * 2)) = rs_[i]; } while (0)
#define SWAIT() do { if constexpr (SDEPTH == 2) { if constexpr (DK == 192) asm volatile("s_waitcnt vmcnt(5)" ::: "memory"); else asm volatile("s_waitcnt vmcnt(4)" ::: "memory"); } \
    else asm volatile("s_waitcnt vmcnt(0)" ::: "memory"); } while (0)
#define RESC(a) do { if (__any((a) < 1.f)) { if (hi == 0) al_l[r32] = (a); asm volatile("s_waitcnt lgkmcnt(0)" ::: "memory"); \
    _Pragma("unroll") for (int d = 0; d < 4; ++d) _Pragma("unroll") for (int r = 0; r < 16; ++r) o[d][r] *= al_l[crow(r, hi)]; } } while (0)
  f32x16 pA0, pA1, pB0, pB1; float mnA, mnB, alA, alB; bf16x8 pa0, pa1, pa2, pa3; const int NT = seq / KVBLK;
  constexpr int SE = 0, SO = SDEPTH - 1;
  SLOAD(SE, 0); asm volatile("s_waitcnt vmcnt(0)" ::: "memory"); SWRITE(0, SE); __syncthreads();
  qkt<DK, QREG>(pA0, pA1, K_lds, R_lds, qr, Qrl, r32, hi); partialSM<DK>(pA0, pA1, m_reg, mnA, alA);
  SLOAD(SO, KVBLK); if constexpr (SDEPTH == 2) { if (2 < NT) SLOAD(SE, 2 * KVBLK); }
  SWAIT(); SWRITE(1, SO); __syncthreads();
  for (int j = 1; j + 1 < NT; j += 2) {
    SBAR(); qkt<DK, QREG>(pB0, pB1, K_lds + SHM_K, R_lds + SHM_R, qr, Qrl, r32, hi);
    finishSM(pA0, pA1, alA, l_reg, pa0, pa1, pa2, pa3); SBAR();
    SLOAD(SO, (j + SDEPTH) * KVBLK); SBAR();
    pv_d0(o, vb0, pa0, pa1, pa2, pa3); partialSM<DK>(pB0, pB1, m_reg, mnB, alB);
    __syncthreads(); SWAIT(); SWRITE(0, SE);
    RESC(alB); __syncthreads();
    SBAR(); qkt<DK, QREG>(pA0, pA1, K_lds, R_lds, qr, Qrl, r32, hi);
    finishSM(pB0, pB1, alB, l_reg, pa0, pa1, pa2, pa3); SBAR();
    if (SDEPTH == 1 || j + 3 < NT) SLOAD(SE, (j + 1 + SDEPTH) * KVBLK); SBAR();
    pv_d0(o, vb0 + (int)SHM_V, pa0, pa1, pa2, pa3); partialSM<DK>(pA0, pA1, m_reg, mnA, alA);
    __syncthreads(); SWAIT(); SWRITE(1, SO);
    RESC(alA); __syncthreads();
  }
  SBAR(); qkt<DK, QREG>(pB0, pB1, K_lds + SHM_K, R_lds + SHM_R, qr, Qrl, r32, hi);
  finishSM(pA0, pA1, alA, l_reg, pa0, pa1, pa2, pa3); SBAR();
  pv_d0(o, vb0, pa0, pa1, pa2, pa3); partialSM<DK>(pB0, pB1, m_reg, mnB, alB);
  __syncthreads(); RESC(alB);
  finishSM(pB0, pB1, alB, l_reg, pa0, pa1, pa2, pa3); SBAR();
  pv_d0(o, vb0 + (int)SHM_V, pa0, pa1, pa2, pa3);
  if (hi == 0) li_l[r32] = l_reg; asm volatile("s_waitcnt lgkmcnt(0)" ::: "memory");
  float rli[16];
#pragma unroll
  for (int r = 0; r < 16; ++r) rli[r] = __builtin_amdgcn_rcpf(li_l[crow(r, hi)]);
  bf16_t* Ow = Ob + (long)(wid * QBLK) * LDO;
#pragma unroll
  for (int r = 0; r < 16; ++r) { const int orow = crow(r, hi);
#pragma unroll
    for (int d0 = 0; d0 < 4; ++d0) Ow[(long)orow * LDO + d0 * 32 + r32] = (bf16_t)f2bf(o[d0][r] * rli[r]); }
  __syncthreads();
#undef SLOAD
#undef GLD
#undef SWRITE
#undef SWAIT
#undef RESC
}
#undef KSWZ
#undef RSWZ
#undef SBAR
}
struct Args { const float* in[N_IN]; float* out; unsigned char* ws; int ph_lo, ph_hi, bli, pad; };
struct Frame {
    LAS unsigned char* lds;
    volatile LAS unsigned* MISC;
    gu32* ctl;
    int tid, lane, wave, bid, G, gw, NGW;
    GAS unsigned char* ws;
};
#define WSP(T, off) ((T*)(GAS T*)(F.ws + (off)))
constexpr int PTR_OFF = LDSCTL_OFF + 1024;
__device__ __forceinline__ const float* inp(const Frame& F, int i) {
    int z = 0; asm volatile("" : "+s"(z));
    const LAS unsigned* t = (const LAS unsigned*)(F.lds + PTR_OFF + z) + 2 * i;
    const unsigned lo = __builtin_amdgcn_readfirstlane(t[0]), hi = __builtin_amdgcn_readfirstlane(t[1]);
    return (const float*)(GAS const float*)(((unsigned long long)hi << 32) | lo);
}
#define INP(i) inp(F, (i))
__device__ __forceinline__ bool phase_fence(Frame& F) { asm volatile("" : "+s"(F.ws), "+s"(F.ctl), "+s"(F.G), "+s"(F.bid), "+s"(F.wave));
    F.tid = opaque_tid(F.wave); F.lane = F.tid & 63; F.gw = F.bid * NWAVES + F.wave; F.NGW = F.G * NWAVES; return true; }

__device__ __forceinline__ void row_bj(int r, int& b, int& j) { b = r / TPB; j = r - b * TPB; }
__device__ __forceinline__ const float* mod_ptr(const Frame& F, int layer, int mrow, int which) { return WSP(const float, WS_MOD) + ((size_t)(layer * 9 + mrow) * NMOD + which) * D; }

__device__ __forceinline__ void ld_row_f32(const float* p, int lane, f32x4 (&v)[4]) {
#pragma unroll
    for (int j = 0; j < 4; ++j) v[j] = ((const f32x4*)p)[lane + 64 * j];
}
__device__ __forceinline__ void st_row_f32(float* p, int lane, const f32x4 (&v)[4]) {
#pragma unroll
    for (int j = 0; j < 4; ++j) ((f32x4*)p)[lane + 64 * j] = v[j];
}
__device__ __forceinline__ void ld_row_bf16(const bf16_t* p, int lane, f32x4 (&v)[4]) {
#pragma unroll
    for (int j = 0; j < 4; ++j) { const v2u w = ((const v2u*)p)[lane + 64 * j]; v[j] = (f32x4){bflo(w.x), bfhi(w.x), bflo(w.y), bfhi(w.y)}; }
}
__device__ __forceinline__ void st_row_bf16(bf16_t* p, int lane, const f32x4 (&v)[4]) {
#pragma unroll
    for (int j = 0; j < 4; ++j) { v2u w; w.x = pk2(v[j].x, v[j].y); w.y = pk2(v[j].z, v[j].w); ((v2u*)p)[lane + 64 * j] = w; }
}
__device__ __forceinline__ void rms_mod(f32x4 (&v)[4], int lane, const float* gain, const float* shift, const float* scale) {
    float ss = 0.f;
#pragma unroll
    for (int j = 0; j < 4; ++j) ss += (v[j].x * v[j].x + v[j].y * v[j].y) + (v[j].z * v[j].z + v[j].w * v[j].w);
    const float rs = rsqrtf(wave_sum(ss) * (1.f / D) + NORM_EPS);
#pragma unroll
    for (int j = 0; j < 4; ++j) {
        const f32x4 g = ((const f32x4*)gain)[lane + 64 * j], sh = ((const f32x4*)shift)[lane + 64 * j], sc = ((const f32x4*)scale)[lane + 64 * j];
        v[j] = (v[j] * rs) * g * (sc + 1.f) + sh;
    }
}

__device__ __forceinline__ void p0_transpose_item(const float* W, int K, int N, bf16_t* WT, int ld, LAS float* scr, int item, int lane) {
    const int nblk = N / 32, kb = item / nblk, nb = item - kb * nblk, k0 = 64 * kb, n0 = 32 * nb;
#pragma unroll 8
    for (int i = 0; i < 32; ++i) { const int kk = 2 * i + (lane >> 5); scr[kk * 33 + (lane & 31)] = (k0 + kk < K) ? W[(size_t)(k0 + kk) * N + n0 + (lane & 31)] : 0.f; }
    LDS_WAIT(); asm volatile("" ::: "memory");
    const int c = lane & 7;
    if (k0 + 8 * c < K) {
#pragma unroll
        for (int j = 0; j < 4; ++j) { const int n = (lane >> 3) + 8 * j; const LAS float* s = scr + (8 * c) * 33 + n;
            v4u o; o.x = pk2(s[0 * 33], s[1 * 33]); o.y = pk2(s[2 * 33], s[3 * 33]); o.z = pk2(s[4 * 33], s[5 * 33]); o.w = pk2(s[6 * 33], s[7 * 33]);
            *(GAS v4u*)(WT + (size_t)(n0 + n) * ld + k0 + 8 * c) = o; }
    }
    LDS_WAIT(); asm volatile("" ::: "memory");
}
__device__ __forceinline__ void p0_transpose_item64(const float* W, int N, bf16_t* WT, int ld, LAS float* scr, int kb, int nb, int lane) {
    const int k0 = 64 * kb, n0 = 64 * nb, lr = lane >> 4, lc = 4 * (lane & 15);
    const float* src = W + (size_t)(k0 + lr) * N + n0 + lc;
    f32x4 v[16];
#pragma unroll
    for (int q = 0; q < 16; ++q) v[q] = __builtin_nontemporal_load((const f32x4*)(src + (size_t)(4 * q) * N));
#pragma unroll
    for (int q = 0; q < 16; ++q) *(LAS f32x4*)(scr + (4 * q + lr) * 68 + lc) = v[q];
    LDS_WAIT(); asm volatile("" ::: "memory");
    const int ln = lane >> 3, kc = lane & 7;
#pragma unroll
    for (int rr = 0; rr < 8; ++rr) { const int n = 8 * rr + ln; const LAS float* s = scr + (8 * kc) * 68 + n;
        v4u o; o.x = pk2(s[0 * 68], s[1 * 68]); o.y = pk2(s[2 * 68], s[3 * 68]); o.z = pk2(s[4 * 68], s[5 * 68]); o.w = pk2(s[6 * 68], s[7 * 68]);
        *(GAS v4u*)(WT + (size_t)(n0 + n) * ld + k0 + 8 * kc) = o; }
    LDS_WAIT(); asm volatile("" ::: "memory");
}
struct TJob { int in_idx; unsigned src_off; int K, N; unsigned long long dst_off; int ld; int count; unsigned src_stride; unsigned dst_stride; };
constexpr unsigned long long SWE(int e, size_t o) { return WS_SMALLW + SW_EV + (size_t)e * EV_BYTES + o; }
constexpr unsigned long long SWO(int j, size_t o) { return WS_SMALLW + SW_OD + (size_t)j * OD_BYTES + o; }
constexpr int NJOBS = 33;
__device__ const TJob g_jobs[NJOBS] = {
    {I_MOE_W1, 0, 1024, 2048, WS_W1T, 1024, 128, 1024u * 2048u, 2048u * 1024u},
    {I_MOE_W2, 0, 1024, 1024, WS_W2T, 1024, 128, 1024u * 1024u, 1024u * 1024u},
    {I_ATTN_W_IN, 0, 1024, 1728, SWE(0, EV_WIN), 1024, 2, 1024u * 1728u, (unsigned)(EV_BYTES / 2)},
    {I_MLA_W_UQ, 0, 384, 768, SWE(0, EV_WUQ), 384, 2, 384u * 768u, (unsigned)(EV_BYTES / 2)},
    {I_MLA_W_UKV, 0, 256, 1024, SWE(0, EV_WUKV), 256, 2, 256u * 1024u, (unsigned)(EV_BYTES / 2)},
    {I_ATTN_W_OUT, 0, 1024, 1024, SWE(0, EV_WOUT), 1024, 2, 1024u * 1024u, (unsigned)(EV_BYTES / 2)},
    {I_RWKV_W_R, 0, 1024, 1024, SWO(0, OD_WR), 1024, 2, 1024u * 1024u, (unsigned)(OD_BYTES / 2)},
    {I_RWKV_W_K, 0, 1024, 1024, SWO(0, OD_WK), 1024, 2, 1024u * 1024u, (unsigned)(OD_BYTES / 2)},
    {I_RWKV_W_V, 0, 1024, 1024, SWO(0, OD_WV), 1024, 2, 1024u * 1024u, (unsigned)(OD_BYTES / 2)},
    {I_RWKV_W_O, 0, 1024, 1024, SWO(0, OD_WO), 1024, 2, 1024u * 1024u, (unsigned)(OD_BYTES / 2)},
    {I_RWKV_W1, 0 * 65536u, 1024, 64, SWO(0, OD_W1C) + 0 * 64 * 2048, 1024, 1, 0, 0},
    {I_RWKV_W1, 1 * 65536u, 1024, 64, SWO(0, OD_W1C) + 1 * 64 * 2048, 1024, 1, 0, 0},
    {I_RWKV_W1, 2 * 65536u, 1024, 64, SWO(1, OD_W1C) + 0 * 64 * 2048, 1024, 1, 0, 0},
    {I_RWKV_W1, 3 * 65536u, 1024, 64, SWO(1, OD_W1C) + 1 * 64 * 2048, 1024, 1, 0, 0},
    {I_RWKV_A1, 0 * 65536u, 1024, 64, SWO(0, OD_A1C) + 0 * 64 * 2048, 1024, 1, 0, 0},
    {I_RWKV_A1, 1 * 65536u, 1024, 64, SWO(0, OD_A1C) + 1 * 64 * 2048, 1024, 1, 0, 0},
    {I_RWKV_A1, 2 * 65536u, 1024, 64, SWO(1, OD_A1C) + 0 * 64 * 2048, 1024, 1, 0, 0},
    {I_RWKV_A1, 3 * 65536u, 1024, 64, SWO(1, OD_A1C) + 1 * 64 * 2048, 1024, 1, 0, 0},
    {I_RWKV_G1, 0, 1024, 128, SWO(0, OD_G1), 1024, 2, 1024u * 128u, (unsigned)(OD_BYTES / 2)},
    {I_RWKV_V1, 0, 1024, 32, SWO(1, OD_V1), 1024, 1, 0, 0},
    {I_RWKV_W2, 0 * 65536u, 64, 1024, SWO(0, OD_W2C) + (0 * 1024 * 128 + 0 * 64) * 2, 128, 1, 0, 0},
    {I_RWKV_W2, 1 * 65536u, 64, 1024, SWO(0, OD_W2C) + (1 * 1024 * 128 + 1 * 64) * 2, 128, 1, 0, 0},
    {I_RWKV_W2, 2 * 65536u, 64, 1024, SWO(1, OD_W2C) + (0 * 1024 * 128 + 0 * 64) * 2, 128, 1, 0, 0},
    {I_RWKV_W2, 3 * 65536u, 64, 1024, SWO(1, OD_W2C) + (1 * 1024 * 128 + 1 * 64) * 2, 128, 1, 0, 0},
    {I_RWKV_A2, 0 * 65536u, 64, 1024, SWO(0, OD_A2C) + (0 * 1024 * 128 + 0 * 64) * 2, 128, 1, 0, 0},
    {I_RWKV_A2, 1 * 65536u, 64, 1024, SWO(0, OD_A2C) + (1 * 1024 * 128 + 1 * 64) * 2, 128, 1, 0, 0},
    {I_RWKV_A2, 2 * 65536u, 64, 1024, SWO(1, OD_A2C) + (0 * 1024 * 128 + 0 * 64) * 2, 128, 1, 0, 0},
    {I_RWKV_A2, 3 * 65536u, 64, 1024, SWO(1, OD_A2C) + (1 * 1024 * 128 + 1 * 64) * 2, 128, 1, 0, 0},
    {I_RWKV_G2, 0, 128, 1024, SWO(0, OD_G2), 128, 2, 128u * 1024u, (unsigned)(OD_BYTES / 2)},
    {I_RWKV_V2, 0, 32, 1024, SWO(1, OD_V2), 128, 1, 0, 0},
    {I_MOE_ROUTER_W, 0, 1024, 32, WS_SMALLW + SW_RT, 1024, 4, 1024u * 32u, (unsigned)(RT_BYTES / 2)},
    {-1, 0, 64, 32, 0, 0, 0, 0, 0},
    {-1, 0, 64, 32, 0, 0, 0, 0, 0},
};
__device__ __forceinline__ bool job_fast(const TJob& j) { return (j.K % 64 == 0) && (j.N % 64 == 0); }
__device__ __forceinline__ int job_per(const TJob& j) { return job_fast(j) ? (j.K / 64) * (j.N / 64) : ((j.K + 63) / 64) * (j.N / 32); }
__device__ __forceinline__ int job_items(const TJob& j) { return j.count * job_per(j); }

struct TItem { const float* W; bf16_t* WT; int K, N, ld, item; bool fast; };
__device__ __forceinline__ TItem p0_decode(const Frame& F, int jlo, int it) {
    int r = it, j = jlo;
    for (;; ++j) { if (g_jobs[j].in_idx < 0) continue; const int n = job_items(g_jobs[j]); if (r < n) break; r -= n; }
    const TJob jb = g_jobs[j];
    const int per = job_per(jb), mi = r / per;
    TItem t; t.W = INP(jb.in_idx) + jb.src_off + (size_t)mi * jb.src_stride; t.WT = (bf16_t*)(GAS bf16_t*)(F.ws + jb.dst_off) + (size_t)mi * jb.dst_stride; t.K = jb.K; t.N = jb.N; t.ld = jb.ld; t.item = r - mi * per; t.fast = job_fast(jb);
    return t;
}
__device__ __forceinline__ void p0_load64(const TItem& t, int lane, f32x4 (&v)[16]) {
    const int nblk = t.N / 64, kb = t.item / nblk, nb = t.item - kb * nblk;
    const float* src = t.W + (size_t)(64 * kb + (lane >> 4)) * t.N + 64 * nb + 4 * (lane & 15);
#pragma unroll
    for (int q = 0; q < 16; ++q) v[q] = __builtin_nontemporal_load((const f32x4*)(src + (size_t)(4 * q) * t.N));
}
__device__ __forceinline__ void p0_finish64(const TItem& t, int lane, const f32x4 (&v)[16], LAS float* scr) {
    const int nblk = t.N / 64, kb = t.item / nblk, nb = t.item - kb * nblk, k0 = 64 * kb, n0 = 64 * nb, lr = lane >> 4, lc = 4 * (lane & 15);
#pragma unroll
    for (int q = 0; q < 16; ++q) *(LAS f32x4*)(scr + (4 * q + lr) * 68 + lc) = v[q];
    LDS_WAIT(); asm volatile("" ::: "memory");
    const int ln = lane >> 3, kc = lane & 7;
#pragma unroll
    for (int rr = 0; rr < 8; ++rr) { const int n = 8 * rr + ln; const LAS float* s = scr + (8 * kc) * 68 + n;
        v4u o; o.x = pk2(s[0 * 68], s[1 * 68]); o.y = pk2(s[2 * 68], s[3 * 68]); o.z = pk2(s[4 * 68], s[5 * 68]); o.w = pk2(s[6 * 68], s[7 * 68]);
        __builtin_nontemporal_store(o, (GAS v4u*)(t.WT + (size_t)(n0 + n) * t.ld + k0 + 8 * kc)); }
    LDS_WAIT(); asm volatile("" ::: "memory");
}
__device__ __forceinline__ void p0_transposes_fast(Frame& F, int jlo, int jhi, int first, int stride) {
    LAS float* scr = (LAS float*)(F.lds + RING_OFF + F.wave * 17408);
    int total = 0;
    for (int j = jlo; j < jhi; ++j) if (g_jobs[j].in_idx >= 0) total += job_items(g_jobs[j]);
    if (first >= total) return;
    f32x4 va[16], vb[16];
    TItem ta = p0_decode(F, jlo, first), tb = ta; p0_load64(ta, F.lane, va);
    for (int it = first; it < total; it += 2 * stride) {
        const bool hb = it + stride < total, ha2 = it + 2 * stride < total;
        if (hb) { tb = p0_decode(F, jlo, it + stride); p0_load64(tb, F.lane, vb); }
        p0_finish64(ta, F.lane, va, scr);
        if (ha2) { ta = p0_decode(F, jlo, it + 2 * stride); p0_load64(ta, F.lane, va); }
        if (hb) p0_finish64(tb, F.lane, vb, scr);
    }
}
__device__ __forceinline__ void p0_transposes(Frame& F, int jlo, int jhi, int first, int stride) {
    LAS float* scr = (LAS float*)(F.lds + RING_OFF + F.wave * 17408);
    int total = 0;
    for (int j = jlo; j < jhi; ++j) if (g_jobs[j].in_idx >= 0) total += job_items(g_jobs[j]);
    for (int it = first; it < total; it += stride) {
        const TItem t = p0_decode(F, jlo, it);
        if (t.fast) { const int nblk = t.N / 64; p0_transpose_item64(t.W, t.N, t.WT, t.ld, scr, t.item / nblk, t.item % nblk, F.lane); }
        else p0_transpose_item(t.W, t.K, t.N, t.WT, t.ld, scr, t.item, F.lane);
    }
}
__device__ __forceinline__ void p0_prologue(Frame& F, const Args& args) {
    {
        LAS float* Ssil = (LAS float*)(F.lds + RING_OFF);
        LAS float* Part = (LAS float*)(F.lds + RING_OFF + 40960);
        bool have = false;
        for (int it = F.bid; it < 96; it += F.G) {
            if (!have) {
                for (int idx = F.tid; idx < 9 * 1024; idx += NTHREADS) { const int r = idx >> 10, k = idx & 1023; const float cv = (r < 8) ? INP(I_C)[r * 1024 + k] : INP(I_CCTX)[k]; Ssil[idx] = siluf_(cv); }
                __syncthreads(); have = true;
            }
            const int l = it / 24, n0 = (it % 24) * 256;
            const float* Wb = INP(I_ADA_W) + (size_t)l * 1024 * 6144 + n0 + 4 * F.lane;
            f32x4 acc[9];
#pragma unroll
            for (int r = 0; r < 9; ++r) acc[r] = (f32x4){0.f, 0.f, 0.f, 0.f};
            const int kb = F.wave * 128;
            for (int k = 0; k < 128; k += 8) {
                f32x4 wv[8];
#pragma unroll
                for (int u = 0; u < 8; ++u) wv[u] = *(const f32x4*)(Wb + (size_t)(kb + k + u) * 6144);
#pragma unroll
                for (int u = 0; u < 8; ++u)
#pragma unroll
                    for (int r = 0; r < 9; ++r) acc[r] = acc[r] + wv[u] * Ssil[r * 1024 + kb + k + u];
            }
#pragma unroll
            for (int r = 0; r < 9; ++r) *(LAS f32x4*)(Part + (F.wave * 9 + r) * 256 + 4 * F.lane) = acc[r];
            __syncthreads();
            for (int idx = F.tid; idx < 9 * 256; idx += NTHREADS) {
                const int r = idx >> 8, n = idx & 255; float s = INP(I_ADA_B)[l * 6144 + n0 + n];
#pragma unroll
                for (int w = 0; w < 8; ++w) s += Part[(w * 9 + r) * 256 + n];
                WSP(float, WS_MOD)[(size_t)(l * 9 + r) * 6144 + n0 + n] = s;
            }
            __syncthreads();
        }
        __syncthreads();
    }
    if (F.G > 2 * 96) { if (F.bid >= 96) p0_transposes(F, 2, NJOBS, (F.bid - 96) * NWAVES + F.wave, (F.G - 96) * NWAVES); }
    else p0_transposes(F, 2, NJOBS, F.gw, F.NGW);
}
__device__ __forceinline__ void p1_init(Frame& F, const Args& args) {
    const float* gain = INP(I_NORM_MIX);
    f32x4 raw[4];
#define P1_LOAD(r_) do { int b_, j_; row_bj((r_), b_, j_); const float* src_ = (j_ < CTXL) ? INP(I_CTX) + ((size_t)b_ * CTXL + j_) * D : INP(I_X) + ((size_t)b_ * SEQ + (j_ - CTXL)) * D; ld_row_f32(src_, F.lane, raw); } while (0)
    if (F.gw < M) P1_LOAD(F.gw);
    for (int r = F.gw; r < M; r += F.NGW) {
        int b, j; row_bj(r, b, j);
        f32x4 v[4];
#pragma unroll
        for (int q = 0; q < 4; ++q) v[q] = raw[q];
        asm volatile("" : "+v"(v[0]), "+v"(v[1]), "+v"(v[2]), "+v"(v[3]));
        if (r + F.NGW < M) P1_LOAD(r + F.NGW);
        st_row_bf16(WSP(bf16_t, WS_XR) + (size_t)r * D, F.lane, v);
        const int mrow = (j < CTXL) ? 8 : b;
        rms_mod(v, F.lane, gain, mod_ptr(F, 0, mrow, 0), mod_ptr(F, 0, mrow, 1));
        st_row_bf16(WSP(bf16_t, WS_HB) + (size_t)r * D, F.lane, v);
    }
#undef P1_LOAD
}
__device__ __forceinline__ void p_copy_out(Frame& F, const Args& args) {
    for (int r = F.gw; r < M; r += F.NGW) {
        int b, j; row_bj(r, b, j); if (j < CTXL) continue;
        f32x4 v[4]; ld_row_bf16(WSP(const bf16_t, WS_XR) + (size_t)r * D, F.lane, v);
        st_row_f32(((float*)INP(N_IN)) + ((size_t)b * SEQ + (j - CTXL)) * D, F.lane, v);
    }
}
struct SubGemm { const char* A; const char* Bt; int lda; int K; int ntn; int kind; };
template <int NS>
struct MultiOrder {
    SubGemm s[NS]; int ntn_total, nwg, G, c, submajor;
    __device__ __forceinline__ void init(int G_, int c_, int submajor_ = 0) { ntn_total = 0; submajor = submajor_;
#pragma unroll
        for (int i = 0; i < NS; ++i) ntn_total += s[i].ntn;
        nwg = NPANEL * ntn_total; G = G_; c = c_; }
    __device__ __forceinline__ bool next(int i, pg8::Unit& u) const {
        const long L = (long)i * G + c; if (L >= nwg) return false;
        int wgid = (int)L; { const int q = nwg / 8, r = nwg % 8, xcd = wgid % 8, off = wgid / 8; wgid = (xcd < r ? xcd * (q + 1) : r * (q + 1) + (xcd - r) * q) + off; }
        const char* A = s[0].A; const char* Bt = s[0].Bt; int lda = s[0].lda, K = s[0].K, kind = s[0].kind; int pm, pn;
        if (submajor) {
            int nN = s[0].ntn, base = 0, acc = NPANEL * s[0].ntn;
#pragma unroll
            for (int k = 1; k < NS; ++k) { const bool ge = wgid >= acc; A = ge ? s[k].A : A; Bt = ge ? s[k].Bt : Bt; lda = ge ? s[k].lda : lda; K = ge ? s[k].K : K; kind = ge ? s[k].kind : kind; nN = ge ? s[k].ntn : nN; base = ge ? acc : base; acc += NPANEL * s[k].ntn; }
            const int lid = wgid - base, nig = 8 * nN, gid = lid / nig, fm = gid * 8, gsz = (NPANEL - fm) < 8 ? (NPANEL - fm) : 8;
            pm = fm + ((lid % nig) % gsz); pn = (lid % nig) / gsz;
        } else {
            const int nig = 8 * ntn_total, gid = wgid / nig, fm = gid * 8, gsz = (NPANEL - fm) < 8 ? (NPANEL - fm) : 8;
            pm = fm + ((wgid % nig) % gsz); const int vpn = (wgid % nig) / gsz; pn = vpn; int base = 0;
#pragma unroll
            for (int k = 1; k < NS; ++k) { base += s[k - 1].ntn; const bool ge = vpn >= base; A = ge ? s[k].A : A; Bt = ge ? s[k].Bt : Bt; lda = ge ? s[k].lda : lda; K = ge ? s[k].K : K; kind = ge ? s[k].kind : kind; pn = ge ? vpn - base : pn; }
        }
        u.A = A; u.B = Bt + (size_t)pn * 256 * K * 2; u.lda = lda; u.K = K; u.pm = pm; u.pn = pn; u.kind = kind; u.e = 0; u.nrows = 256; u.ridx = nullptr;
        return true;
    }
};

__device__ __forceinline__ v4u pack8(f32x4 v0, f32x4 v1) { v4u w; w.x = pk2(v0[0], v0[1]); w.y = pk2(v0[2], v0[3]); w.z = pk2(v1[0], v1[1]); w.w = pk2(v1[2], v1[3]); return w; }
struct NoCtx {};
struct EpiStoreBf16 {
    typedef NoCtx Ctx;
    bf16_t* O; int ldc; int ncols;
    __device__ __forceinline__ void begin(Ctx&, const pg8::Unit&, int, int) const {}
    __device__ __forceinline__ void begin_half(Ctx&, const pg8::Unit&, int, int, int) const {}
    __device__ __forceinline__ void row8(const Ctx&, const pg8::Unit& u, int, int, int lrow, int lcol, f32x4 v0, f32x4 v1) const {
        const int col = u.pn * 256 + lcol; if (col >= ncols) return;
        *(v4u*)(O + (size_t)(u.pm * 256 + lrow) * ldc + col) = pack8(v0, v1);
    }
};
struct EpiStore2 {
    typedef NoCtx Ctx;
    bf16_t* O0; int ld0; bf16_t* O1; int ld1;
    __device__ __forceinline__ void begin(Ctx&, const pg8::Unit&, int, int) const {}
    __device__ __forceinline__ void begin_half(Ctx&, const pg8::Unit&, int, int, int) const {}
    __device__ __forceinline__ void row8(const Ctx&, const pg8::Unit& u, int, int, int lrow, int lcol, f32x4 v0, f32x4 v1) const {
        bf16_t* O = u.kind ? O1 : O0; const int ld = u.kind ? ld1 : ld0;
        *(v4u*)(O + (size_t)(u.pm * 256 + lrow) * ld + u.pn * 256 + lcol) = pack8(v0, v1);
    }
};
struct EpiResidual {
    struct Ctx { f32x4 g[2][2]; v4u x[8][2]; };
    bf16_t* XR; const float* mod_base;
    __device__ __forceinline__ void begin(Ctx& c, const pg8::Unit& u, int lrow0, int lcol0) const {
        const int b = u.pm / 17, mrow = (u.pm - b * 17 == 0) ? 8 : b;
        const float* g = mod_base + (size_t)mrow * 6144 + u.pn * 256 + lcol0;
#pragma unroll
        for (int bj = 0; bj < 2; ++bj) { c.g[bj][0] = *(const f32x4*)(g + bj * 128); c.g[bj][1] = *(const f32x4*)(g + bj * 128 + 4); }
#pragma unroll
        for (int ai = 0; ai < 2; ++ai) {
            const bf16_t* x = XR + (size_t)(u.pm * 256 + lrow0 + ai * 128) * D + u.pn * 256 + lcol0;
#pragma unroll
            for (int m = 0; m < 4; ++m)
#pragma unroll
                for (int bj = 0; bj < 2; ++bj) c.x[ai * 4 + m][bj] = *(const v4u*)(x + (size_t)m * 16 * D + bj * 128); }
    }
    __device__ __forceinline__ void begin_half(Ctx&, const pg8::Unit&, int, int, int) const {}
    __device__ __forceinline__ void row8(const Ctx& c, const pg8::Unit& u, int slot, int bj, int lrow, int lcol, f32x4 v0, f32x4 v1) const {
        bf16_t* x = XR + (size_t)(u.pm * 256 + lrow) * D + u.pn * 256 + lcol; const v4u xo = c.x[slot][bj];
        const f32x4 x0 = (f32x4){bflo(xo.x), bfhi(xo.x), bflo(xo.y), bfhi(xo.y)}, x1 = (f32x4){bflo(xo.z), bfhi(xo.z), bflo(xo.w), bfhi(xo.w)};
        const f32x4 r0 = x0 + c.g[bj][0] * v0, r1 = x1 + c.g[bj][1] * v1;
        v4u w; w.x = pk2(r0[0], r0[1]); w.y = pk2(r0[2], r0[3]); w.z = pk2(r1[0], r1[1]); w.w = pk2(r1[2], r1[3]);
        *(v4u*)x = w;
    }
};
struct EpiRouter {
    struct Ctx { f32x4 b0, b1; };
    float* L; const float* bias;
    __device__ __forceinline__ void begin(Ctx& c, const pg8::Unit&, int, int lcol0) const { const int lc = lcol0 < 32 ? lcol0 : 0; c.b0 = *(const f32x4*)(bias + lc); c.b1 = *(const f32x4*)(bias + lc + 4); }
    __device__ __forceinline__ void begin_half(Ctx&, const pg8::Unit&, int, int, int) const {}
    __device__ __forceinline__ void row8(const Ctx& c, const pg8::Unit& u, int, int, int lrow, int lcol, f32x4 v0, f32x4 v1) const {
        if (lcol >= 32) return;
        float* o = L + (size_t)(u.pm * 256 + lrow) * 32 + lcol;
        *(f32x4*)o = v0 + c.b0; *(f32x4*)(o + 4) = v1 + c.b1;
    }
};
struct MoeCtx { int orow[8]; f32x4 b[2][2]; };
__device__ __forceinline__ void moe_begin(MoeCtx& c, const pg8::Unit& u, int lrow0, int lcol0, const float* bias_e) {
#pragma unroll
    for (int s = 0; s < 8; ++s) { const int lr = lrow0 + (s >> 2) * 128 + (s & 3) * 16; c.orow[s] = (lr < u.nrows) ? u.ridx[lr] : -1; }
    const float* bb = bias_e + u.pn * 256 + lcol0;
#pragma unroll
    for (int bj = 0; bj < 2; ++bj) { c.b[bj][0] = *(const f32x4*)(bb + bj * 128); c.b[bj][1] = *(const f32x4*)(bb + bj * 128 + 4); }
}
__device__ __forceinline__ void moe_begin_pre(MoeCtx& c, const pg8::Unit& u, int lrow0, int lcol0, const LAS unsigned char* tab) {
#pragma unroll
    for (int s = 0; s < 8; ++s) { const int lr = lrow0 + (s >> 2) * 128 + (s & 3) * 16; const int v = ((const LAS int*)tab)[lr]; c.orow[s] = (lr < u.nrows) ? v : -1; }
    const LAS float* bb = (const LAS float*)(tab + 1024) + lcol0;
#pragma unroll
    for (int bj = 0; bj < 2; ++bj) { c.b[bj][0] = *(const LAS f32x4*)(bb + bj * 128); c.b[bj][1] = *(const LAS f32x4*)(bb + bj * 128 + 4); }
}
struct EpiSwiglu {
    typedef MoeCtx Ctx;
    bf16_t* ACT; const float* b1;
    __device__ __forceinline__ void begin(Ctx& c, const pg8::Unit& u, int lrow0, int lcol0) const { moe_begin(c, u, lrow0, lcol0, b1 + (size_t)u.e * 2048); }
    __device__ __forceinline__ const float* bias_of(const pg8::Unit& u) const { return b1 + (size_t)u.e * 2048 + u.pn * 256; }
    __device__ __forceinline__ void begin_pre(Ctx& c, const pg8::Unit& u, int lrow0, int lcol0, const LAS unsigned char* tab) const { moe_begin_pre(c, u, lrow0, lcol0, tab); }
    __device__ __forceinline__ void begin_half(Ctx&, const pg8::Unit&, int, int, int) const {}
    __device__ __forceinline__ void row8(const Ctx& c, const pg8::Unit& u, int slot, int bj, int, int lcol, f32x4 v0, f32x4 v1) const {
        const int orow = c.orow[slot]; if (orow < 0) return;
        const int col = u.pn * 256 + lcol;
        v0 = v0 + c.b[bj][0]; v1 = v1 + c.b[bj][1];
        float o[4];
#pragma unroll
        for (int p = 0; p < 4; ++p) {
            float g = (p < 2) ? v0[2 * p] : v1[2 * (p - 2)], l = (p < 2) ? v0[2 * p + 1] : v1[2 * (p - 2) + 1];
            g = fminf(g, 7.f); l = fminf(fmaxf(l, -7.f), 7.f);
            o[p] = g * sigmoidf_(1.702f * g) * (l + 1.f);
        }
        v2u w; w.x = pk2(o[0], o[1]); w.y = pk2(o[2], o[3]);
        *(v2u*)(ACT + (size_t)orow * FF + (col >> 1)) = w;
    }
};
struct EpiMoeDown {
    typedef MoeCtx Ctx;
    bf16_t* Y; const float* b2;
    __device__ __forceinline__ void begin(Ctx& c, const pg8::Unit& u, int lrow0, int lcol0) const { moe_begin(c, u, lrow0, lcol0, b2 + (size_t)u.e * 1024); }
    __device__ __forceinline__ const float* bias_of(const pg8::Unit& u) const { return b2 + (size_t)u.e * 1024 + u.pn * 256; }
    __device__ __forceinline__ void begin_pre(Ctx& c, const pg8::Unit& u, int lrow0, int lcol0, const LAS unsigned char* tab) const { moe_begin_pre(c, u, lrow0, lcol0, tab); }
    __device__ __forceinline__ void begin_half(Ctx&, const pg8::Unit&, int, int, int) const {}
    __device__ __forceinline__ void row8(const Ctx& c, const pg8::Unit& u, int slot, int bj, int, int lcol, f32x4 v0, f32x4 v1) const {
        const int orow = c.orow[slot]; if (orow < 0) return;
        *(v4u*)(Y + (size_t)orow * D + u.pn * 256 + lcol) = pack8(v0 + c.b[bj][0], v1 + c.b[bj][1]);
    }
};

__device__ __forceinline__ void rope_pair(float& v, int lane, int half  , float cs, float sn) {
    const unsigned x_ = __builtin_bit_cast(unsigned, v);
    float p;
    if (half == 16) { const auto r_ = __builtin_amdgcn_permlane16_swap(x_, x_, false, false); p = __builtin_bit_cast(float, (unsigned)((lane & 16) ? r_[0] : r_[1])); }
    else { const auto r_ = __builtin_amdgcn_permlane32_swap(x_, x_, false, false); p = __builtin_bit_cast(float, (unsigned)((lane & 32) ? r_[0] : r_[1])); }
    v = ((lane & half) == 0) ? (v * cs - p * sn) : (v * cs + p * sn);
}
__device__ __forceinline__ void pA2_proj_norms(Frame& F, const Args& args, int e) {
    const float* q_norm = INP(I_MLA_Q_NORM) + e * 384; const float* kv_norm = INP(I_MLA_KV_NORM) + e * 256; const float* kr_g = INP(I_MLA_KR_G) + e * 64;
    const float* gq_g = INP(I_GQA_Q_G) + e * 128; const float* gk_g = INP(I_GQA_K_G) + e * 128;
    const int lane = F.lane;
    float gqn[6], gkvn[4];
#pragma unroll
    for (int g = 0; g < 6; ++g) gqn[g] = q_norm[64 * g + lane];
#pragma unroll
    for (int g = 0; g < 4; ++g) gkvn[g] = kv_norm[64 * g + lane];
    const float gkr = kr_g[lane], gq0 = gq_g[lane], gq1 = gq_g[64 + lane], gk0 = gk_g[lane], gk1 = gk_g[64 + lane];
    const float LOG2_THETA = 13.287712379549449f;
    const float ifm = __builtin_amdgcn_exp2f(-(float)(2 * (lane & 15)) * (1.f / 32.f) * LOG2_THETA);
    const float ifg = __builtin_amdgcn_exp2f(-(float)(2 * (lane & 31)) * (1.f / 64.f) * LOG2_THETA);
    unsigned short raw[23];
#define A2_LOAD(r_) do { const bf16_t* p_ = WSP(const bf16_t, WS_PROJ) + (size_t)(r_) * PROJ_LD; _Pragma("unroll") for (int g = 0; g < 23; ++g) raw[g] = p_[64 * g + lane]; } while (0)
    if (F.gw < M) A2_LOAD(F.gw);
    for (int r = F.gw; r < M; r += F.NGW) {
        int b, j; row_bj(r, b, j);
        bf16_t* p = WSP(bf16_t, WS_PROJ) + (size_t)r * PROJ_LD;
        float v[23];
#pragma unroll
        for (int g = 0; g < 23; ++g) v[g] = bf2f(raw[g]);
        if (r + F.NGW < M) A2_LOAD(r + F.NGW);
        const bool lat = j >= CTXL; const int t = j - CTXL; const float prow = (float)(t >> 6), pcol = (float)(t & 63);
        { float ss = 0.f;
#pragma unroll
          for (int g = 0; g < 6; ++g) ss += v[g] * v[g];
          const float rs = rsqrtf(wave_sum(ss) * (1.f / 384.f) + NORM_EPS);
#pragma unroll
          for (int g = 0; g < 6; ++g) v[g] = v[g] * rs * gqn[g]; }
        { float ss = 0.f;
#pragma unroll
          for (int g = 0; g < 4; ++g) ss += v[6 + g] * v[6 + g];
          const float rs = rsqrtf(wave_sum(ss) * (1.f / 256.f) + NORM_EPS);
#pragma unroll
          for (int g = 0; g < 4; ++g) v[6 + g] = v[6 + g] * rs * gkvn[g]; }
        { const float rs = rsqrtf(wave_sum(v[10] * v[10]) * (1.f / 64.f) + NORM_EPS); v[10] = v[10] * rs * gkr;
          if (lat) { const float ang = ((lane < 32) ? prow : pcol) * ifm; rope_pair(v[10], lane, 16, __cosf(ang), __sinf(ang)); } }
        float c0 = 1.f, s0 = 0.f, c1 = 1.f, s1 = 0.f;
        if (lat) { const float a0 = prow * ifg, a1 = pcol * ifg; c0 = __cosf(a0); s0 = __sinf(a0); c1 = __cosf(a1); s1 = __sinf(a1); }
#pragma unroll
        for (int h = 0; h < 6; ++h) {
            const int g0 = 11 + 2 * h; const float w0 = (h < 4) ? gq0 : gk0, w1 = (h < 4) ? gq1 : gk1;
            const float rs = rsqrtf(wave_sum(v[g0] * v[g0] + v[g0 + 1] * v[g0 + 1]) * (1.f / 128.f) + NORM_EPS);
            v[g0] = v[g0] * rs * w0; v[g0 + 1] = v[g0 + 1] * rs * w1;
            if (lat) { rope_pair(v[g0], lane, 32, c0, s0); rope_pair(v[g0 + 1], lane, 32, c1, s1); }
        }
#pragma unroll
        for (int g = 0; g < 23; ++g) p[64 * g + lane] = (bf16_t)f2bf(v[g]);
    }
#undef A2_LOAD
}
__device__ __forceinline__ void pA4_mla_norms(Frame& F, const Args& args, int e) {
    const float* qn_g = INP(I_MLA_QN_G) + e * 128; const float* qr_g = INP(I_MLA_QR_G) + e * 64; const float* kn_g = INP(I_MLA_KN_G) + e * 128;
    const int lane = F.lane;
    const float qn0 = qn_g[lane], qn1 = qn_g[64 + lane], qr = qr_g[lane], kn0 = kn_g[lane], kn1 = kn_g[64 + lane];
    const float LOG2_THETA = 13.287712379549449f;
    const float ifm = __builtin_amdgcn_exp2f(-(float)(2 * (lane & 15)) * (1.f / 32.f) * LOG2_THETA);
    unsigned short rq[12], rk[8];
#define A4_LOAD(r_) do { const bf16_t* q_ = WSP(const bf16_t, WS_QM) + (size_t)(r_) * 768; const bf16_t* kv_ = WSP(const bf16_t, WS_KVM) + (size_t)(r_) * 1024; \
        _Pragma("unroll") for (int g = 0; g < 12; ++g) rq[g] = q_[64 * g + lane]; _Pragma("unroll") for (int h = 0; h < 4; ++h) { rk[2 * h] = kv_[256 * h + lane]; rk[2 * h + 1] = kv_[256 * h + 64 + lane]; } } while (0)
    if (F.gw < M) A4_LOAD(F.gw);
    for (int r = F.gw; r < M; r += F.NGW) {
        int b, j; row_bj(r, b, j);
        const bool lat = j >= CTXL; const int t = j - CTXL;
        float cs = 1.f, sn = 0.f;
        if (lat) { const float ang = ((lane < 32) ? (float)(t >> 6) : (float)(t & 63)) * ifm; cs = __cosf(ang); sn = __sinf(ang); }
        bf16_t* q = WSP(bf16_t, WS_QM) + (size_t)r * 768;
        bf16_t* kv = WSP(bf16_t, WS_KVM) + (size_t)r * 1024;
        float vq[12], vk[8];
#pragma unroll
        for (int g = 0; g < 12; ++g) vq[g] = bf2f(rq[g]);
#pragma unroll
        for (int h = 0; h < 8; ++h) vk[h] = bf2f(rk[h]);
        if (r + F.NGW < M) A4_LOAD(r + F.NGW);
#pragma unroll
        for (int h = 0; h < 4; ++h) {
            float rs = rsqrtf(wave_sum(vq[3 * h] * vq[3 * h] + vq[3 * h + 1] * vq[3 * h + 1]) * (1.f / 128.f) + NORM_EPS);
            vq[3 * h] = vq[3 * h] * rs * qn0; vq[3 * h + 1] = vq[3 * h + 1] * rs * qn1;
            rs = rsqrtf(wave_sum(vq[3 * h + 2] * vq[3 * h + 2]) * (1.f / 64.f) + NORM_EPS);
            vq[3 * h + 2] = vq[3 * h + 2] * rs * qr;
            if (lat) rope_pair(vq[3 * h + 2], lane, 16, cs, sn);
            rs = rsqrtf(wave_sum(vk[2 * h] * vk[2 * h] + vk[2 * h + 1] * vk[2 * h + 1]) * (1.f / 128.f) + NORM_EPS);
            vk[2 * h] = vk[2 * h] * rs * kn0; vk[2 * h + 1] = vk[2 * h + 1] * rs * kn1;
        }
#pragma unroll
        for (int g = 0; g < 12; ++g) q[64 * g + lane] = (bf16_t)f2bf(vq[g]);
#pragma unroll
        for (int h = 0; h < 4; ++h) { kv[256 * h + lane] = (bf16_t)f2bf(vk[2 * h]); kv[256 * h + 64 + lane] = (bf16_t)f2bf(vk[2 * h + 1]); }
    }
#undef A4_LOAD
}
template <bool MLA>
__device__ __forceinline__ void attn_one(Frame& F, int b, int h, int qb) {
    static_assert(att::ATTN_LDS <= RING_BYTES, "attention LDS");
    char* lds = (char*)(F.lds + RING_OFF);
    const bf16_t* PROJ = WSP(const bf16_t, WS_PROJ); bf16_t* OB = WSP(bf16_t, WS_OB);
    const size_t row0 = (size_t)b * TPB + (size_t)qb * 256, krow0 = (size_t)b * TPB; const int seq = qb ? TPB : CTXL;
    if constexpr (MLA) { const bf16_t* QM = WSP(const bf16_t, WS_QM); const bf16_t* KVM = WSP(const bf16_t, WS_KVM);
        att::attn_unit<192, 1, 8, 768, 1024, PROJ_LD, 1024, D>(QM + row0 * 768 + 192 * h, KVM + krow0 * 1024 + 256 * h, PROJ + krow0 * PROJ_LD + C_ZR,
                                          KVM + krow0 * 1024 + 256 * h + 128, OB + row0 * D + 128 * h, seq, lds, F.wave);
    } else { const int g = h - 4, kvh = g >> 1;
        att::attn_unit<128, 1, 8, PROJ_LD, PROJ_LD, PROJ_LD, PROJ_LD, D>(PROJ + row0 * PROJ_LD + C_GQ + 128 * g, PROJ + krow0 * PROJ_LD + C_GK + 128 * kvh, nullptr,
                                      PROJ + krow0 * PROJ_LD + C_GV + 128 * kvh, OB + row0 * D + 512 + 128 * g, seq, lds, F.wave); }
}
__device__ __forceinline__ void moe_convert_share(Frame& F, bool doit) {
    if (!doit) return;
    p0_transposes_fast(F, 0, 2, F.gw, F.NGW);
    __syncthreads();
}
template <bool MLA>
__device__ __forceinline__ void pA5_attention_half(Frame& F, int conv_phase  ) {
    const int x = F.bid & 7, lc = F.bid >> 3;
    const int nunits = NB * 4 * 17, niter = (F.G == 256) ? 3 : (nunits + F.G - 1) / F.G;
#pragma unroll 1
    for (int i = 0; i < niter; ++i) {
        if (i < 2) moe_convert_share(F, conv_phase == (MLA ? 0 : 3) + i);
        int b, h, qb;
        if (F.G == 256) { b = x; if (i < 2) { h = 2 * i + (lc >> 4); qb = 1 + (lc & 15); } else { if (lc >= 4) break; h = lc; qb = 0; } }
        else { const int u = i * F.G + F.bid; if (u >= nunits) break; b = u / (4 * 17); h = (u / 17) % 4; qb = u % 17; }
        attn_one<MLA>(F, b, (MLA ? 0 : 4) + h, qb);
    }
}
__device__ __forceinline__ void pA5_attention(Frame& F, bool convert) {
    const int cp = convert ? (F.bid % 5) : -1;
    pA5_attention_half<true>(F, cp); moe_convert_share(F, cp == 2); pA5_attention_half<false>(F, cp);
#ifdef MK_PROBE_REP_MLA
    pA5_attention_half<true>(F, -1);
#endif
#ifdef MK_PROBE_REP_GQA
    pA5_attention_half<false>(F, -1);
#endif
}
__device__ __forceinline__ void pF1_ffn_norm(Frame& F, const Args& args, int layer) {
    const float* gain = INP(I_NORM_FFN) + layer * D;
    for (int r = F.gw; r < M; r += F.NGW) {
        int b, j; row_bj(r, b, j); const int mrow = (j < CTXL) ? 8 : b;
        f32x4 v[4]; ld_row_bf16(WSP(const bf16_t, WS_XR) + (size_t)r * D, F.lane, v);
        rms_mod(v, F.lane, gain, mod_ptr(F, layer, mrow, 3), mod_ptr(F, layer, mrow, 4));
        st_row_bf16(WSP(bf16_t, WS_HB) + (size_t)r * D, F.lane, v);
    }
}
__device__ __forceinline__ void route_lane_tokens(Frame& F, int layer, int r, bool valid, const float (&l)[32]);
__device__ __forceinline__ void pF1R_norm_router(Frame& F, const Args& args, int layer) {
    constexpr int RP = 2048 + 16;
    const LAS unsigned char* WR = F.lds + RING_OFF;
    LAS unsigned char* SL = F.lds + RING_OFF + 32 * RP + F.wave * (4 * RP);
    constexpr int RPW = 17;
    LAS float* LT = (LAS float*)(F.lds + RING_OFF + 32 * RP + NWAVES * 4 * RP);
    static_assert(32 * RP + NWAVES * 4 * RP + NWAVES * RPW * 32 * 4 <= RING_BYTES, "F1R LDS");
    const bool fused = (F.G * NWAVES * RPW >= M);
    { const bf16_t* wr = (const bf16_t*)(F.ws + WS_SMALLW + SW_RT + (size_t)layer * RT_BYTES);
      __syncthreads();
      for (int i = F.tid; i < 32 * 128; i += NTHREADS) { const int row = i >> 7, ch = i & 127; *(LAS v4u*)((LAS unsigned char*)WR + row * RP + ch * 16) = *(const v4u*)(wr + (size_t)row * 1024 + ch * 8); }
      __syncthreads(); }
    const float* gain = INP(I_NORM_FFN) + layer * D; const float* rb = INP(I_MOE_ROUTER_B) + layer * 32; float* LG = WSP(float, WS_LOGITS);
    const int lane = F.lane, l15 = lane & 15, g = lane >> 4;
    const float rb0 = rb[l15], rb1 = rb[16 + l15];
    int grp = 0;
    v2u raw[4][4];
#define F1R_LOAD(rb_) do { _Pragma("unroll") for (int i = 0; i < 4; ++i) { const int r = (rb_) + i * F.NGW; if (r < M) { _Pragma("unroll") for (int q = 0; q < 4; ++q) raw[i][q] = __builtin_nontemporal_load(&((const v2u*)(WSP(const bf16_t, WS_XR) + (size_t)r * D))[lane + 64 * q]); } } } while (0)
    F1R_LOAD(F.gw);
    for (int r0 = F.gw; r0 < M; r0 += 4 * F.NGW, ++grp) {
        f32x4 v[4][4];
#pragma unroll
        for (int i = 0; i < 4; ++i)
#pragma unroll
            for (int q = 0; q < 4; ++q) v[i][q] = (f32x4){bflo(raw[i][q].x), bfhi(raw[i][q].x), bflo(raw[i][q].y), bfhi(raw[i][q].y)};
#pragma unroll
        for (int i = 0; i < 4; ++i) { const int r = r0 + i * F.NGW; if (r < M) {
            int b, j; row_bj(r, b, j); const int mrow = (j < CTXL) ? 8 : b;
            rms_mod(v[i], lane, gain, mod_ptr(F, layer, mrow, 3), mod_ptr(F, layer, mrow, 4));
#pragma unroll
            for (int q = 0; q < 4; ++q) { v2u w; w.x = pk2(v[i][q].x, v[i][q].y); w.y = pk2(v[i][q].z, v[i][q].w);
                ((v2u*)(WSP(bf16_t, WS_HB) + (size_t)r * D))[lane + 64 * q] = w; *(LAS v2u*)(SL + i * RP + (lane + 64 * q) * 8) = w; } } }
        if (r0 + 4 * F.NGW < M) F1R_LOAD(r0 + 4 * F.NGW);
        f32x4 acc0 = (f32x4){0.f, 0.f, 0.f, 0.f}, acc1 = acc0;
        const LAS unsigned char* ap = SL + (l15 & 3) * RP + g * 16; const LAS unsigned char* bp = WR + l15 * RP + g * 16;
#pragma unroll 8
        for (int s2 = 0; s2 < 32; ++s2) { const bf16x8 a = *(const LAS bf16x8*)(ap + s2 * 64), b0 = *(const LAS bf16x8*)(bp + s2 * 64), b1 = *(const LAS bf16x8*)(bp + 16 * RP + s2 * 64);
            acc0 = __builtin_amdgcn_mfma_f32_16x16x32_bf16(a, b0, acc0, 0, 0, 0); acc1 = __builtin_amdgcn_mfma_f32_16x16x32_bf16(a, b1, acc1, 0, 0, 0); }
        if (g == 0) {
#pragma unroll
            for (int i = 0; i < 4; ++i) { const int r = r0 + i * F.NGW; if (r < M) {
                if (fused) { LAS float* lt = LT + (F.wave * RPW + grp * 4 + i) * 32; lt[l15] = acc0[i] + rb0; lt[16 + l15] = acc1[i] + rb1; }
                else { LG[(size_t)r * 32 + l15] = acc0[i] + rb0; LG[(size_t)r * 32 + 16 + l15] = acc1[i] + rb1; } } } }
    }
#undef F1R_LOAD
    if (fused) {
        __syncthreads();
        if (F.wave < (NWAVES * RPW + 63) / 64) {
            const int t = F.wave * 64 + lane, w = t / RPW, idx = t - w * RPW, r = F.bid * NWAVES + w + idx * F.NGW;
            bool valid = (t < NWAVES * RPW) && (r < M);
            if (valid) { int b, j; row_bj(r, b, j); valid = !((layer == DEPTH - 1) && j < CTXL); }
            const LAS float* lt = LT + ((t < NWAVES * RPW) ? t : 0) * 32;
            float l[32];
#pragma unroll
            for (int q = 0; q < 8; ++q) { const f32x4 x = ((const LAS f32x4*)lt)[q]; l[4 * q] = x[0]; l[4 * q + 1] = x[1]; l[4 * q + 2] = x[2]; l[4 * q + 3] = x[3]; }
            route_lane_tokens(F, layer, r, valid, l);
        }
    }
}
__device__ __forceinline__ void route_lane_tokens(Frame& F, int layer, int r, bool valid, const float (&l)[32]) {
    float* TG = WSP(float, WS_TOPG); int* RI = WSP(int, WS_ROWIDX);
    unsigned* cnt = (unsigned*)(F.ctl + CW_ECNT + layer * 32 * 64);
    const int lane = F.lane;
    int sel[4]; float val[4]; unsigned used = 0u;
#pragma unroll
    for (int k = 0; k < 4; ++k) { float best = -3.0e38f; int bi = 0;
#pragma unroll
        for (int e = 0; e < 32; ++e) { const bool ok = !((used >> e) & 1u) && (l[e] > best); best = ok ? l[e] : best; bi = ok ? e : bi; }
        sel[k] = bi; val[k] = best; used |= 1u << bi; }
    float p[4], ps = 0.f;
#pragma unroll
    for (int k = 0; k < 4; ++k) { p[k] = __expf(val[k] - val[0]); ps += p[k]; }
    const float inv = 1.f / ps;
    int pre[4] = {0, 0, 0, 0}; unsigned mycnt = 0u;
    const unsigned long long below = (lane == 0) ? 0ull : (~0ull >> (64 - lane));
#pragma unroll
    for (int e = 0; e < 32; ++e) {
        const bool has = valid && ((used >> e) & 1u);
        const unsigned long long m = __ballot(has);
        const int c = __popcll(m), pf = __popcll(m & below);
        if (lane == e) mycnt = (unsigned)c;
#pragma unroll
        for (int k = 0; k < 4; ++k) if (sel[k] == e) pre[k] = pf;
    }
    unsigned base = 0u;
    if (lane < 32 && mycnt) base = __hip_atomic_fetch_add(cnt + lane * 64, mycnt, RLX_AGENT);
    unsigned be[4];
#pragma unroll
    for (int k = 0; k < 4; ++k) be[k] = (unsigned)lanes_get((int)base, sel[k]);
    if (valid) {
#pragma unroll
        for (int k = 0; k < 4; ++k) RI[(size_t)sel[k] * CAP + be[k] + pre[k]] = r * 4 + k;
        *(f32x4*)(TG + (size_t)r * 4) = (f32x4){p[0] * inv, p[1] * inv, p[2] * inv, p[3] * inv};
    }
}
__device__ __forceinline__ void pF3_route(Frame& F, int layer) {
    const float* LG = WSP(const float, WS_LOGITS);
    const int lane = F.lane; const bool lastl = (layer == DEPTH - 1);
    for (int t0 = F.gw * 64; t0 < M; t0 += F.NGW * 64) {
        const int r = t0 + lane; int b, j; row_bj(r, b, j);
        const bool valid = !(lastl && j < CTXL);
        float l[32];
#pragma unroll
        for (int q = 0; q < 8; ++q) { const f32x4 x = ((const f32x4*)(LG + (size_t)r * 32))[q]; l[4 * q] = x[0]; l[4 * q + 1] = x[1]; l[4 * q + 2] = x[2]; l[4 * q + 3] = x[3]; }
        route_lane_tokens(F, layer, r, valid, l);
    }
}
template <int NPN, int GM, int GSH>
struct MoeOrder {
    const LAS int* tb;
    const char* A; const char* W; const int* RI; int G, c, nwg;
    __device__ __forceinline__ bool next(int i, pg8::Unit& u) const {
        const long L = (long)i * G + c;
        int wgid = (int)L;
        if ((G & 7) == 0) {
            const int ng = nwg / (GM * NPN), qg = ng / 8, rg = ng % 8, xcd = wgid % 8, off = wgid / 8;
            const int ngx = qg + (xcd < rg ? 1 : 0), gs = (xcd < rg) ? xcd * (qg + 1) : rg * (qg + 1) + (xcd - rg) * qg;
            if (off >= ngx * (GM * NPN)) return false;
            wgid = gs * (GM * NPN) + off;
        } else {
            if (L >= nwg) return false;
            const int q = nwg / 8, r = nwg % 8, xcd = wgid % 8, off = wgid / 8; wgid = (xcd < r ? xcd * (q + 1) : r * (q + 1) + (xcd - r) * q) + off;
        }
        const int grp = wgid / (GM * NPN), l = wgid % (GM * NPN), mt = grp * GM + (l % GM), pn = l / GM;
        const int ln = lane_now() & 31;
        const int e = __popcll(__ballot(mt >= tb[ln]) & 0xffffffffull) - 1;
        const int total = tb[32];
        const int lt = mt - tb[e], cnt = tb[33 + e];
        u.A = A; u.B = W + ((size_t)e * NPN * 256 + (size_t)pn * 256) * 1024 * 2; u.lda = 2048; u.K = 1024; u.pm = mt; u.pn = pn; u.kind = 0; u.e = e;
        int nr = (mt < total) ? cnt - lt * 256 : 0; nr = nr > 256 ? 256 : nr; u.nrows = nr;
        u.ridx = RI + (size_t)e * CAP + (size_t)lt * 256;
        return true;
    }
};
__device__ __forceinline__ int moe_table(Frame& F, int layer) {
    int z = 0; asm volatile("" : "+s"(z));
    LAS int* tb = (LAS int*)(F.lds + LDSCTL_OFF + z);
    __syncthreads();
    if (F.wave == 0) {
        const int e = F.lane & 31;
        const int c = (int)__hip_atomic_load((unsigned*)(F.ctl + CW_ECNT + (layer * 32 + e) * 64), RLX_AGENT);
        const int t = (c + 255) >> 8; int incl = t;
#pragma unroll
        for (int o = 1; o < 32; o <<= 1) { const int v = lanes_get(incl, (lane_now() - o) & 63); if (e >= o) incl += v; }
        if (F.lane < 32) { tb[e] = incl - t; tb[33 + e] = c; if (e == 31) tb[32] = incl; }
    }
    __syncthreads();
    return tb[32];
}
__device__ __forceinline__ void pF6_combine(Frame& F, const Args& args, int layer) {
    const bool lastl = (layer == DEPTH - 1);
    const bf16_t* Y = WSP(const bf16_t, WS_YB); const float* TG = WSP(const float, WS_TOPG);
    v2u rx[4], ry[4][4]; f32x4 rg;
#define F6_LOAD(r_) do { _Pragma("unroll") for (int q = 0; q < 4; ++q) rx[q] = ((const v2u*)(WSP(const bf16_t, WS_XR) + (size_t)(r_) * D))[F.lane + 64 * q]; rg = *(const f32x4*)(TG + (size_t)(r_) * 4);     \
        _Pragma("unroll") for (int k = 0; k < 4; ++k) _Pragma("unroll") for (int q = 0; q < 4; ++q) ry[k][q] = __builtin_nontemporal_load(&((const v2u*)(Y + ((size_t)(r_) * 4 + k) * D))[F.lane + 64 * q]); } while (0)
    if (F.gw < M) F6_LOAD(F.gw);
    for (int r = F.gw; r < M; r += F.NGW) {
        int b, j; row_bj(r, b, j);
        const int mrow = (j < CTXL) ? 8 : b;
        f32x4 x[4], acc[4]; const f32x4 g = rg;
#pragma unroll
        for (int q = 0; q < 4; ++q) { x[q] = (f32x4){bflo(rx[q].x), bfhi(rx[q].x), bflo(rx[q].y), bfhi(rx[q].y)}; acc[q] = (f32x4){0.f, 0.f, 0.f, 0.f}; }
#pragma unroll
        for (int k = 0; k < 4; ++k)
#pragma unroll
            for (int q = 0; q < 4; ++q) acc[q] = acc[q] + (f32x4){bflo(ry[k][q].x), bfhi(ry[k][q].x), bflo(ry[k][q].y), bfhi(ry[k][q].y)} * g[k];
        if (r + F.NGW < M) F6_LOAD(r + F.NGW);
        if (lastl && j < CTXL) continue;
        const float* m5 = mod_ptr(F, layer, mrow, 5);
#pragma unroll
        for (int q = 0; q < 4; ++q) x[q] = x[q] + ((const f32x4*)m5)[F.lane + 64 * q] * acc[q];
        if (lastl) { st_row_f32(((float*)INP(N_IN)) + ((size_t)b * SEQ + (j - CTXL)) * D, F.lane, x); continue; }
        st_row_bf16(WSP(bf16_t, WS_XR) + (size_t)r * D, F.lane, x);
        rms_mod(x, F.lane, INP(I_NORM_MIX) + (layer + 1) * D, mod_ptr(F, layer + 1, mrow, 0), mod_ptr(F, layer + 1, mrow, 1));
        st_row_bf16(WSP(bf16_t, WS_HB) + (size_t)r * D, F.lane, x);
    }
#undef F6_LOAD
}
__device__ __forceinline__ void pR1_mix(Frame& F, int jj) {
    const float* mix = INP(I_RWKV_MIX) + (size_t)jj * 6 * D;
    const bf16_t* HB = WSP(const bf16_t, WS_HB);
    v2u rh[4], rp[4], rn[4];
#define R1_LOAD(r_) do { int b_, j_; row_bj((r_), b_, j_); const bool hp_ = (j_ != 0) && (j_ != CTXL), hn_ = (j_ != CTXL - 1) && (j_ != TPB - 1); \
        _Pragma("unroll") for (int q = 0; q < 4; ++q) { rh[q] = ((const v2u*)(HB + (size_t)(r_) * D))[F.lane + 64 * q]; \
            rp[q] = hp_ ? ((const v2u*)(HB + (size_t)((r_) - 1) * D))[F.lane + 64 * q] : (v2u){0u, 0u}; rn[q] = hn_ ? ((const v2u*)(HB + (size_t)((r_) + 1) * D))[F.lane + 64 * q] : (v2u){0u, 0u}; } } while (0)
#define R1_UNP(w_) ((f32x4){bflo((w_).x), bfhi((w_).x), bflo((w_).y), bfhi((w_).y)})
    if (F.gw < M) R1_LOAD(F.gw);
    for (int r = F.gw; r < M; r += F.NGW) {
        f32x4 h[4], xx[4];
#pragma unroll
        for (int q = 0; q < 4; ++q) { h[q] = R1_UNP(rh[q]); xx[q] = (R1_UNP(rp[q]) + R1_UNP(rn[q])) * 0.5f - h[q]; }
        if (r + F.NGW < M) R1_LOAD(r + F.NGW);
#pragma unroll
        for (int m = 0; m < 6; ++m) {
            f32x4 o[4];
#pragma unroll
            for (int q = 0; q < 4; ++q) o[q] = h[q] + xx[q] * ((const f32x4*)(mix + m * D))[F.lane + 64 * q];
            st_row_bf16(WSP(bf16_t, WS_XMIX) + ((size_t)m * M + r) * D, F.lane, o);
        }
    }
#undef R1_LOAD
#undef R1_UNP
}
#ifndef MK_SCAN_SEQ
#define MK_SCAN_SEQ 0
#endif
#if MK_SCAN_SEQ
#define SC_DECAY(z) __expf(-0.6065306597126334f * sigmoidf_(z))
#else
#define SC_DECAY(z) (-0.6065306597126334f * sigmoidf_(z))
#endif
struct EpiR2 {
    typedef NoCtx Ctx;
    bf16_t* dst[7];
    __device__ __forceinline__ void begin(Ctx&, const pg8::Unit&, int, int) const {}
    __device__ __forceinline__ void begin_half(Ctx&, const pg8::Unit&, int, int, int) const {}
    __device__ __forceinline__ void row8(const Ctx&, const pg8::Unit& u, int, int, int lrow, int lcol, f32x4 v0, f32x4 v1) const {
        const int row = u.pm * 256 + lrow;
        if (u.kind < 3) { bf16_t* O = (u.kind == 0) ? dst[0] : (u.kind == 1) ? dst[1] : dst[2]; *(v4u*)(O + (size_t)row * D + u.pn * 256 + lcol) = pack8(v0, v1); return; }
        if (lcol >= 128) return;
        bf16_t* O = (u.kind == 3) ? dst[3] : (u.kind == 4) ? dst[4] : (u.kind == 5) ? dst[5] : dst[6];
        if (u.kind == 3) {
#pragma unroll
            for (int q = 0; q < 4; ++q) { v0[q] = 1.f - 2.f * __builtin_amdgcn_rcpf(1.f + __expf(2.f * v0[q])); v1[q] = 1.f - 2.f * __builtin_amdgcn_rcpf(1.f + __expf(2.f * v1[q])); } }
        else if (u.kind == 5) {
#pragma unroll
            for (int q = 0; q < 4; ++q) { v0[q] = sigmoidf_(v0[q]); v1[q] = sigmoidf_(v1[q]); } }
        *(v4u*)(O + (size_t)row * 128 + lcol) = pack8(v0, v1);
    }
};
struct EpiR3 {
    struct Ctx { f32x4 b00, b01, b10, b11; };
    bf16_t* WDEC; bf16_t* AD; bf16_t* GB; bf16_t* VGT; const float* w0; const float* a0; const float* v0b;
    __device__ __forceinline__ void begin(Ctx& c, const pg8::Unit& u, int, int lcol0) const {
        const float* p0 = w0; const float* p1 = a0; const float* p2 = v0b; asm volatile("" : "+s"(p0), "+s"(p1), "+s"(p2));
        const float* bp = (u.kind == 0) ? p0 : (u.kind == 1) ? p1 : p2; const int col = u.pn * 256 + lcol0;
        const float* bb = bp + ((u.kind == 2) ? 0 : col);
        c.b00 = *(const f32x4*)(bb); c.b01 = *(const f32x4*)(bb + 4); c.b10 = *(const f32x4*)(bb + 128); c.b11 = *(const f32x4*)(bb + 132);
    }
    static constexpr bool HAS_TAB = true;
    __device__ __forceinline__ const float* bias_of(const pg8::Unit& u) const {
        const float* p0 = w0; const float* p1 = a0; const float* p2 = v0b; asm volatile("" : "+s"(p0), "+s"(p1), "+s"(p2));
        const float* bp = (u.kind == 0) ? p0 : (u.kind == 1) ? p1 : p2; return bp + ((u.kind == 2) ? 0 : u.pn * 256); }
    __device__ __forceinline__ void begin_pre(Ctx& c, const pg8::Unit&, int, int lcol0, const LAS unsigned char* tab) const {
        const LAS float* bb = (const LAS float*)(tab + 1024) + lcol0;
        c.b00 = *(const LAS f32x4*)(bb); c.b01 = *(const LAS f32x4*)(bb + 4); c.b10 = *(const LAS f32x4*)(bb + 128); c.b11 = *(const LAS f32x4*)(bb + 132); }
    __device__ __forceinline__ void begin_half(Ctx&, const pg8::Unit&, int, int, int) const {}
    __device__ __forceinline__ void row8(const Ctx& c, const pg8::Unit& u, int, int bj, int lrow, int lcol, f32x4 v0, f32x4 v1) const {
        const int row = u.pm * 256 + lrow, col = u.pn * 256 + lcol;
        const f32x4 cb0 = bj ? c.b10 : c.b00, cb1 = bj ? c.b11 : c.b01;
        if (u.kind == 0) {
            bf16_t* o = WDEC + ((size_t)(col >> 10) * M + row) * D + (col & 1023);
            f32x4 z0 = v0 + cb0, z1 = v1 + cb1;
#pragma unroll
            for (int q = 0; q < 4; ++q) { z0[q] = SC_DECAY(z0[q]); z1[q] = SC_DECAY(z1[q]); }
            *(v4u*)o = pack8(z0, z1);
        } else if (u.kind == 1) {
            f32x4 z0 = v0 + cb0, z1 = v1 + cb1;
#pragma unroll
            for (int q = 0; q < 4; ++q) { z0[q] = sigmoidf_(z0[q]); z1[q] = sigmoidf_(z1[q]); }
            *(v4u*)(AD + ((size_t)(col >> 10) * M + row) * D + (col & 1023)) = pack8(z0, z1);
        } else if (u.kind == 2) {
            *(v4u*)(GB + (size_t)row * D + col) = pack8(v0, v1);
        } else {
            f32x4 z0 = v0 + cb0, z1 = v1 + cb1;
#pragma unroll
            for (int q = 0; q < 4; ++q) { z0[q] = sigmoidf_(z0[q]); z1[q] = sigmoidf_(z1[q]); }
            *(v4u*)(VGT + (size_t)row * D + col) = pack8(z0, z1);
        }
    }
};
__device__ __forceinline__ float head_sum(float v) { return sum16(v); }
__device__ __forceinline__ void pR4_scan_prep(Frame& F, int jj) {
    const float* k_k = INP(I_RWKV_K_K) + jj * D; const float* k_a = INP(I_RWKV_K_A) + jj * D;
    for (int r = F.gw; r < M; r += F.NGW) {
        f32x4 k[4], kk[4];
        ld_row_bf16(WSP(const bf16_t, WS_KB) + (size_t)r * D, F.lane, k);
#pragma unroll
        for (int q = 0; q < 4; ++q) {
            kk[q] = k[q] * ((const f32x4*)k_k)[F.lane + 64 * q];
            const float ss = head_sum((kk[q].x * kk[q].x + kk[q].y * kk[q].y) + (kk[q].z * kk[q].z + kk[q].w * kk[q].w));
            kk[q] = kk[q] * rsqrtf(fmaxf(ss, 1e-24f));
        }
        st_row_bf16(WSP(bf16_t, WS_KK) + (size_t)r * D, F.lane, kk);
#pragma unroll
        for (int d = 0; d < 2; ++d) {
            f32x4 a[4], o[4];
            ld_row_bf16(WSP(const bf16_t, WS_AD) + ((size_t)d * M + r) * D, F.lane, a);
#pragma unroll
            for (int q = 0; q < 4; ++q) o[q] = k[q] * ((a[q] - 1.f) * ((const f32x4*)k_a)[F.lane + 64 * q] + 1.f);
            st_row_bf16(WSP(bf16_t, WS_KD) + ((size_t)d * M + r) * D, F.lane, o);
#pragma unroll
            for (int q = 0; q < 4; ++q) o[q] = kk[q] * a[q];
            st_row_bf16(WSP(bf16_t, WS_BD) + ((size_t)d * M + r) * D, F.lane, o);
        }
        if (jj > 0) {
            f32x4 v[4], vf[4], vg[4];
            ld_row_bf16(WSP(const bf16_t, WS_VB) + (size_t)r * D, F.lane, v);
            ld_row_bf16(WSP(const bf16_t, WS_VFIRST) + (size_t)r * D, F.lane, vf);
            ld_row_bf16(WSP(const bf16_t, WS_VGT) + (size_t)r * D, F.lane, vg);
#pragma unroll
            for (int q = 0; q < 4; ++q) v[q] = v[q] + (vf[q] - v[q]) * vg[q];
            st_row_bf16(WSP(bf16_t, WS_V2) + (size_t)r * D, F.lane, v);
        }
    }
}
constexpr int SC_CH = 32;
constexpr int SC_STEP_F = 6 * 64;
constexpr int SC_BUF_F = SC_CH * SC_STEP_F;
constexpr int SC_YOFF = 2 * SC_BUF_F * 4;
static_assert(SC_YOFF + 2 * SC_CH * 64 * 4 <= RING_BYTES, "scan LDS");
#if MK_SCAN_SEQ
struct ScanOps { f32x4 w0, w1, k0, k1, b0, b1, q0, q1, r0, r1; float v; };
__device__ __forceinline__ float fma_s(float a, float b, float c) { float d; asm("v_fma_f32 %0, %1, %2, %3" : "=v"(d) : "v"(a), "v"(b), "v"(c)); return d; }
__device__ __forceinline__ float mul_s(float a, float b) { float d; asm("v_mul_f32_e32 %0, %1, %2" : "=v"(d) : "v"(a), "v"(b)); return d; }
__device__ __forceinline__ float add_s(float a, float b) { float d; asm("v_add_f32_e32 %0, %1, %2" : "=v"(d) : "v"(a), "v"(b)); return d; }
__device__ __forceinline__ float fnma_s(float a, float b, float c) { float d; asm("v_fma_f32 %0, -%1, %2, %3" : "=v"(d) : "v"(a), "v"(b), "v"(c)); return d; }
__device__ __forceinline__ void scan_step(f32x4& Sa, f32x4& Sb, const ScanOps& o, float& y) {
    float a0 = mul_s(Sa[0], o.q0[0]), a1 = mul_s(Sb[0], o.q1[0]);
    a0 = fma_s(Sa[1], o.q0[1], a0); a1 = fma_s(Sb[1], o.q1[1], a1); a0 = fma_s(Sa[2], o.q0[2], a0); a1 = fma_s(Sb[2], o.q1[2], a1); a0 = fma_s(Sa[3], o.q0[3], a0); a1 = fma_s(Sb[3], o.q1[3], a1);
    float sa = add_s(a0, a1);
    f32x4 pa, pb;
#pragma unroll
    for (int j = 0; j < 4; ++j) { pa[j] = mul_s(o.v, o.k0[j]); pb[j] = mul_s(o.v, o.k1[j]); }
#pragma unroll
    for (int j = 0; j < 4; ++j) { pa[j] = fma_s(Sa[j], o.w0[j], pa[j]); pb[j] = fma_s(Sb[j], o.w1[j], pb[j]); }
    sa += dpp_xor1(sa); sa += dpp_xor2(sa); sa += dpp_hmir(sa);
#pragma unroll
    for (int j = 0; j < 4; ++j) { Sa[j] = fnma_s(sa, o.b0[j], pa[j]); Sb[j] = fnma_s(sa, o.b1[j], pb[j]); }
    a0 = mul_s(Sa[0], o.r0[0]); a1 = mul_s(Sb[0], o.r1[0]);
    a0 = fma_s(Sa[1], o.r0[1], a0); a1 = fma_s(Sb[1], o.r1[1], a1); a0 = fma_s(Sa[2], o.r0[2], a0); a1 = fma_s(Sb[2], o.r1[2], a1); a0 = fma_s(Sa[3], o.r0[3], a0); a1 = fma_s(Sb[3], o.r1[3], a1);
    y = add_s(a0, a1);
    y += dpp_xor1(y); y += dpp_xor2(y); y += dpp_hmir(y);
}
__device__ __forceinline__ void pR5_scan(Frame& F, int jj) {
    LAS float* lbuf = (LAS float*)(F.lds + RING_OFF);
    LAS float* ybuf = (LAS float*)(F.lds + RING_OFF + SC_YOFF);
    const int tid = F.tid, vrow = tid >> 3, kq = tid & 7;
    const int sstep = tid >> 4, spart = tid & 15;
    const bf16_t* Vsrc = WSP(const bf16_t, (jj == 0) ? WS_VFIRST : WS_V2);
    for (int u = F.bid; u < NB * 16 * 2; u += F.G) {
        const int dir = u & 1, hh = (u >> 1) & 15, b = u >> 5;
        const size_t rowb = (size_t)b * TPB; const int colh = hh * 64 + 4 * spart;
        const float* Wd = WSP(const float, WS_WDEC) + (size_t)dir * M * D; const bf16_t* Kd = WSP(const bf16_t, WS_KD) + (size_t)dir * M * D; const bf16_t* Bd = WSP(const bf16_t, WS_BD) + (size_t)dir * M * D;
        const bf16_t* Kk = WSP(const bf16_t, WS_KK); const bf16_t* Rb = WSP(const bf16_t, WS_RB);
        float* Yd = WSP(float, WS_YS) + (size_t)dir * M * D;
        f32x4 Sa = (f32x4){0.f, 0.f, 0.f, 0.f}, Sb = (f32x4){0.f, 0.f, 0.f, 0.f};
        constexpr int NCH = TPB / SC_CH;
        f32x4 gw_; v2u gk_, gb_, gkk_, gr_, gv_;
#define SC_ROW(c, s) ((dir == 0) ? ((c) * SC_CH + (s)) : (((c) < CTXL / SC_CH) ? (CTXL - 1 - ((c) * SC_CH + (s))) : (TPB - 1 - ((c) * SC_CH + (s) - CTXL))))
#define SC_GLOAD(c) do { const size_t ro = (rowb + (size_t)SC_ROW(c, sstep)) * D + colh; gw_ = *(const f32x4*)(Wd + ro); gk_ = *(const v2u*)(Kd + ro); gb_ = *(const v2u*)(Bd + ro); \
        gkk_ = *(const v2u*)(Kk + ro); gr_ = *(const v2u*)(Rb + ro); gv_ = *(const v2u*)(Vsrc + ro); } while (0)
#define SC_BF4(w) (f32x4){bflo((w).x), bfhi((w).x), bflo((w).y), bfhi((w).y)}
#define SC_LWRITE(bufi) do { LAS float* d_ = lbuf + (bufi) * SC_BUF_F + sstep * SC_STEP_F + 4 * spart; *(LAS f32x4*)(d_) = gw_; *(LAS f32x4*)(d_ + 64) = SC_BF4(gk_); *(LAS f32x4*)(d_ + 128) = SC_BF4(gb_); \
        *(LAS f32x4*)(d_ + 192) = SC_BF4(gkk_); *(LAS f32x4*)(d_ + 256) = SC_BF4(gr_); *(LAS f32x4*)(d_ + 320) = SC_BF4(gv_); } while (0)
#define SC_LDOPS(o, sb) do { (o).w0 = *(const LAS f32x4*)(sb); (o).w1 = *(const LAS f32x4*)((sb) + 4); (o).k0 = *(const LAS f32x4*)((sb) + 64); (o).k1 = *(const LAS f32x4*)((sb) + 68); \
        (o).b0 = *(const LAS f32x4*)((sb) + 128); (o).b1 = *(const LAS f32x4*)((sb) + 132); (o).q0 = *(const LAS f32x4*)((sb) + 192); (o).q1 = *(const LAS f32x4*)((sb) + 196); \
        (o).r0 = *(const LAS f32x4*)((sb) + 256); (o).r1 = *(const LAS f32x4*)((sb) + 260); (o).v = (sb)[320 - 8 * kq + vrow]; } while (0)
        __syncthreads();
        SC_GLOAD(0); SC_LWRITE(0); __syncthreads();
        for (int c = 0; c < NCH; ++c) {
            if (c + 1 < NCH) SC_GLOAD(c + 1);
            if (c > 0) {
                const f32x4 yv = *(const LAS f32x4*)(ybuf + ((c - 1) & 1) * (SC_CH * 64) + sstep * 64 + 4 * spart);
                *(f32x4*)(Yd + (rowb + (size_t)SC_ROW(c - 1, sstep)) * D + colh) = yv;
            }
            const LAS float* cb = lbuf + (c & 1) * SC_BUF_F + 8 * kq;
            LAS float* yb = ybuf + (c & 1) * (SC_CH * 64) + vrow;
            ScanOps cur, nxt; SC_LDOPS(cur, cb);
#pragma unroll
            for (int s = 0; s < SC_CH; ++s) {
                if (s + 1 < SC_CH) SC_LDOPS(nxt, cb + (s + 1) * SC_STEP_F);
                float y; scan_step(Sa, Sb, cur, y);
                if (kq == 0) yb[s * 64] = y;
                cur = nxt;
            }
            if (c + 1 < NCH) SC_LWRITE((c + 1) & 1);
            __syncthreads();
        }
        {
            const f32x4 yv = *(const LAS f32x4*)(ybuf + ((NCH - 1) & 1) * (SC_CH * 64) + sstep * 64 + 4 * spart);
            *(f32x4*)(Yd + (rowb + (size_t)SC_ROW(NCH - 1, sstep)) * D + colh) = yv;
        }
#undef SC_ROW
#undef SC_GLOAD
#undef SC_BF4
#undef SC_LWRITE
#undef SC_LDOPS
    }
}
#else
constexpr int CK_P = 72, CK_MB = 64 * CK_P * 2;
enum { CB_RM = 0, CB_AT, CB_LAK, CB_LRB, CB_LRK, CB_SB, CB_N0, CB_N1, CB_N2, CB_NBUF };
constexpr int CK_PT = 80, CK_TB = 64 * CK_PT * 2, CK_TOFF = CB_NBUF * CK_MB;
enum { CT_VM = 0, CT_BM, CT_KM, CT_NBUF };
constexpr int CK_CW = CB_N0 * CK_MB;
constexpr int CK_SEG = CK_TOFF + CT_NBUF * CK_TB, CK_WC = CK_SEG + 8 * 64 * 4;
static_assert(CK_WC + 64 * 4 <= RING_BYTES && 2 * CK_MB >= 64 * 64 * 4, "chunked scan LDS");
typedef LAS unsigned char* lptr;
struct CkFrag { bf16x8 lo, hi; };
template <int PITCHB = CK_P * 2>
__device__ __forceinline__ CkFrag ck_ld(lptr Mb, int row0, int l15, int g) { const lptr p = Mb + (row0 + l15) * PITCHB + g * 16; CkFrag f; f.lo = *(const LAS bf16x8*)p; f.hi = *(const LAS bf16x8*)(p + 64); return f; }
typedef short ck_v4i16 __attribute__((ext_vector_type(4))); typedef short ck_v8i16 __attribute__((ext_vector_type(8)));
__device__ __forceinline__ CkFrag ck_ld_tr(lptr Mb, int n0, int l15, int g) {
    const lptr p = Mb + (8 * g + (l15 >> 2)) * (CK_PT * 2) + n0 * 2 + (l15 & 3) * 8;
    const ck_v4i16 a = __builtin_amdgcn_ds_read_tr16_b64_v4i16((LAS ck_v4i16*)(p)), b = __builtin_amdgcn_ds_read_tr16_b64_v4i16((LAS ck_v4i16*)(p + 4 * (CK_PT * 2)));
    const ck_v4i16 c = __builtin_amdgcn_ds_read_tr16_b64_v4i16((LAS ck_v4i16*)(p + 32 * (CK_PT * 2))), d = __builtin_amdgcn_ds_read_tr16_b64_v4i16((LAS ck_v4i16*)(p + 36 * (CK_PT * 2)));
    CkFrag f; f.lo = __builtin_bit_cast(bf16x8, (ck_v8i16)__builtin_shufflevector(a, b, 0, 1, 2, 3, 4, 5, 6, 7)); f.hi = __builtin_bit_cast(bf16x8, (ck_v8i16)__builtin_shufflevector(c, d, 0, 1, 2, 3, 4, 5, 6, 7)); return f; }
__device__ __forceinline__ f32x4 ck_mm(f32x4 acc, const CkFrag& a, const CkFrag& b) {
    acc = __builtin_amdgcn_mfma_f32_16x16x32_bf16(a.lo, b.lo, acc, 0, 0, 0); return __builtin_amdgcn_mfma_f32_16x16x32_bf16(a.hi, b.hi, acc, 0, 0, 0); }
__device__ __forceinline__ void ck_st_t(lptr Mb, int row0, int col0, int l15, int g, f32x4 v) {
    v2u w; w.x = pk2(v[0], v[1]); w.y = pk2(v[2], v[3]);
    *(LAS v2u*)(Mb + (col0 + l15) * (CK_P * 2) + (row0 + 4 * g) * 2) = w;
}
__device__ __forceinline__ bf16x8 sm_ld(lptr img, int l15, int g) { return *(const LAS bf16x8*)(img + l15 * 64 + g * 16); }
__device__ __forceinline__ f32x4 mm16(f32x4 acc, bf16x8 a, bf16x8 b) { return __builtin_amdgcn_mfma_f32_16x16x32_bf16(a, b, acc, 0, 0, 0); }
__device__ __forceinline__ void sm_st_t(lptr img, int l15, int g, f32x4 v) {
    v2u w; w.x = pk2(v[0], v[1]); w.y = pk2(v[2], v[3]);
    *(LAS v2u*)(img + l15 * 64 + g * 8) = w; { unsigned zz = 0u; asm volatile("" : "+v"(zz)); *(LAS v2u*)(img + l15 * 64 + 32 + g * 8) = (v2u){zz, zz}; }
}
#ifdef MK_SCANVAR
__device__ __forceinline__ void pR5_scan(Frame& F, int jj, int var = 0) {
    const bool HM = (var & 64) != 0;
#else
__device__ __forceinline__ void pR5_scan(Frame& F, int jj) {
    constexpr bool HM = false;
#endif
    const lptr L0 = F.lds + RING_OFF;
#define CKB(i) (L0 + (i) * CK_MB)
#define CKT(i) (L0 + CK_TOFF + (i) * CK_TB)
    LAS float* CW = (LAS float*)(L0 + CK_CW); LAS float* SEG = (LAS float*)(L0 + CK_SEG); LAS float* WC = (LAS float*)(L0 + CK_WC);
    const int tid = F.tid, lane = tid & 63, wv = F.wave, l15 = lane & 15, g = lane >> 4;
    const int tr16 = (wv >> 1) * 16, tc0 = (wv & 1) * 32;
    const int pk = tid & 63, pseg = tid >> 6;
    const int pt = tid >> 3, pkg = tid & 7;
    const bf16_t* Vsrc = WSP(const bf16_t, (jj == 0) ? WS_VFIRST : WS_VB);
    const f32x4 z4 = (f32x4){0.f, 0.f, 0.f, 0.f};
    for (int u = F.bid; u < NB * 16 * 2; u += F.G) {
        const int dir = u & 1, hh = (u >> 1) & 15, b = u >> 5;
        const int RS = HM ? 64 : D;
        const size_t ub = HM ? (size_t)(b * 16 + hh) * TPB * 64 : (size_t)b * TPB * D + hh * 64;
        const bf16_t* Wd = WSP(const bf16_t, WS_WDEC) + (size_t)dir * M * D + ub; const bf16_t* Kb = WSP(const bf16_t, WS_KB) + ub;
        const bf16_t* Ad = WSP(const bf16_t, WS_AD) + (size_t)dir * M * D + ub; const bf16_t* Rb = WSP(const bf16_t, WS_RB) + ub;
        const bf16_t* Vs = Vsrc + ub; const bf16_t* Vf = WSP(const bf16_t, WS_VFIRST) + ub; const bf16_t* Vg = WSP(const bf16_t, WS_VGT) + ub; bf16_t* Yd = WSP(bf16_t, WS_YS) + (size_t)dir * M * D + ub;
        float kkv[8], kav[8], rkv[8];
        { const float* pkk = INP(I_RWKV_K_K) + jj * D + hh * 64 + 8 * pkg; const float* pka = INP(I_RWKV_K_A) + jj * D + hh * 64 + 8 * pkg; const float* prk = INP(I_RWKV_R_K) + jj * D + hh * 64 + 8 * pkg;
#pragma unroll
          for (int j = 0; j < 8; ++j) { kkv[j] = pkk[j]; kav[j] = pka[j]; rkv[j] = prk[j]; } }
        float* Bon = WSP(float, WS_LOGITS) + ((size_t)dir * M + (size_t)b * TPB) * 16 + hh;
        constexpr int NCK = TPB / 64;
#define CK_ROW(st) ((dir == 0) ? (st) : (((st) < CTXL) ? (CTXL - 1 - (st)) : (TPB - 1 - ((st) - CTXL))))
        unsigned glw[8]; v4u gk, ga, gr, gv, gvf, gvg;
#define CK_GLOADW(c) do { const int rb_ = CK_ROW((c) * 64), sg_ = (dir == 0) ? RS : -RS;        \
        const bf16_t* wl_ = Wd + (size_t)rb_ * RS + (pk & ~1) + (long)sg_ * (8 * pseg); _Pragma("unroll") for (int j = 0; j < 8; ++j) glw[j] = *(const unsigned*)(wl_ + (long)sg_ * j); } while (0)
#define CK_GLOAD(c) do { const int rb_ = CK_ROW((c) * 64), sg_ = (dir == 0) ? RS : -RS; \
        const size_t ro = (size_t)((long)rb_ * RS + (long)sg_ * pt) + 8 * pkg; gk = __builtin_nontemporal_load((const v4u*)(Kb + ro)); ga = __builtin_nontemporal_load((const v4u*)(Ad + ro)); gr = __builtin_nontemporal_load((const v4u*)(Rb + ro)); gv = __builtin_nontemporal_load((const v4u*)(Vs + ro)); \
        if (jj > 0) { gvf = __builtin_nontemporal_load((const v4u*)(Vf + ro)); gvg = __builtin_nontemporal_load((const v4u*)(Vg + ro)); } } while (0)
        f32x4 SaccT[2] = {z4, z4};
        __syncthreads();
        CK_GLOADW(0); CK_GLOAD(0);
        float cl[8];
#define CK_LW(j) ((pk & 1) ? bfhi(glw[j]) : bflo(glw[j]))
#define CK_CUMSEG() do { cl[0] = CK_LW(0); _Pragma("unroll") for (int j = 1; j < 8; ++j) cl[j] = cl[j - 1] + CK_LW(j); SEG[pseg * 64 + pk] = cl[7]; } while (0)
        CK_CUMSEG();
        __syncthreads();
        for (int c = 0; c < NCK; ++c) {
            if (c + 1 < NCK) CK_GLOADW(c + 1);
            const v4u yprev = *(const LAS v4u*)(CKB(CB_N2) + pt * (CK_P * 2) + 16 * pkg);
#pragma unroll
            for (int q = 0; q < 2; ++q) ck_st_t(CKB(CB_SB), tr16, tc0 + 16 * q, l15, g, SaccT[q]);
            { float pre = 0.f;
#pragma unroll
              for (int s2 = 0; s2 < 7; ++s2) pre += (s2 < pseg) ? SEG[s2 * 64 + pk] : 0.f;
#pragma unroll
              for (int j = 0; j < 8; ++j) CW[(8 * pseg + j) * 64 + pk] = __expf(cl[j] + pre);
              if (pseg == 7) WC[pk] = __expf(cl[7] + pre); }
            __syncthreads();
            { const f32x4 c0 = *(const LAS f32x4*)(CW + pt * 64 + 8 * pkg), c1 = *(const LAS f32x4*)(CW + pt * 64 + 8 * pkg + 4);
              f32x4 p0 = (f32x4){1.f, 1.f, 1.f, 1.f}, p1 = p0;
              if (pt > 0) { p0 = *(const LAS f32x4*)(CW + (pt - 1) * 64 + 8 * pkg); p1 = *(const LAS f32x4*)(CW + (pt - 1) * 64 + 8 * pkg + 4); }
              float fa[8], fb[8], fk[8], fr[8], xk[8], xa[8], kkj[8];
              const unsigned wk_[4] = {gk.x, gk.y, gk.z, gk.w}, wa_[4] = {ga.x, ga.y, ga.z, ga.w}, wr[4] = {gr.x, gr.y, gr.z, gr.w};
              float ss = 0.f;
#pragma unroll
              for (int j = 0; j < 8; ++j) { xk[j] = (j & 1) ? bfhi(wk_[j >> 1]) : bflo(wk_[j >> 1]); xa[j] = (j & 1) ? bfhi(wa_[j >> 1]) : bflo(wa_[j >> 1]); kkj[j] = xk[j] * kkv[j]; ss += kkj[j] * kkj[j]; }
              ss += dpp_xor1(ss); ss += dpp_xor2(ss); ss += dpp_hmir(ss);
              const float rn = rsqrtf(fmaxf(ss, 1e-24f)); float bs = 0.f;
#pragma unroll
              for (int j = 0; j < 8; ++j) { const float cwj = (j < 4) ? c0[j & 3] : c1[j & 3], cpj = (j < 4) ? p0[j & 3] : p1[j & 3];
                  const float Wt = cwj, Wi = __builtin_amdgcn_rcpf(Wt), Wp = cpj;
                  const float xr = (j & 1) ? bfhi(wr[j >> 1]) : bflo(wr[j >> 1]), kn = kkj[j] * rn;
                  const float kd = xk[j] * ((xa[j] - 1.f) * kav[j] + 1.f);
                  fa[j] = -kn * Wp; fb[j] = kn * xa[j] * Wi; fk[j] = kd * Wi; fr[j] = xr * Wt; bs += xr * kd * rkv[j]; }
              bs += dpp_xor1(bs); bs += dpp_xor2(bs); bs += dpp_hmir(bs);
              if (pkg == 0) Bon[(size_t)CK_ROW(c * 64 + pt) * 16] = bs;
              if (jj > 0) {
                  const unsigned wv_[4] = {gv.x, gv.y, gv.z, gv.w}, wf_[4] = {gvf.x, gvf.y, gvf.z, gvf.w}, wg_[4] = {gvg.x, gvg.y, gvg.z, gvg.w}; float vm[8];
#pragma unroll
                  for (int j = 0; j < 8; ++j) { const float a_ = (j & 1) ? bfhi(wv_[j >> 1]) : bflo(wv_[j >> 1]), f_ = (j & 1) ? bfhi(wf_[j >> 1]) : bflo(wf_[j >> 1]), g_ = (j & 1) ? bfhi(wg_[j >> 1]) : bflo(wg_[j >> 1]); vm[j] = a_ + (f_ - a_) * g_; }
                  gv.x = pk2(vm[0], vm[1]); gv.y = pk2(vm[2], vm[3]); gv.z = pk2(vm[4], vm[5]); gv.w = pk2(vm[6], vm[7]); }
              v4u oa, ob, ok, orr;
              oa.x = pk2(fa[0], fa[1]); oa.y = pk2(fa[2], fa[3]); oa.z = pk2(fa[4], fa[5]); oa.w = pk2(fa[6], fa[7]);
              ob.x = pk2(fb[0], fb[1]); ob.y = pk2(fb[2], fb[3]); ob.z = pk2(fb[4], fb[5]); ob.w = pk2(fb[6], fb[7]);
              ok.x = pk2(fk[0], fk[1]); ok.y = pk2(fk[2], fk[3]); ok.z = pk2(fk[4], fk[5]); ok.w = pk2(fk[6], fk[7]);
              orr.x = pk2(fr[0], fr[1]); orr.y = pk2(fr[2], fr[3]); orr.z = pk2(fr[4], fr[5]); orr.w = pk2(fr[6], fr[7]);
              const int ro = pt * (CK_P * 2) + 16 * pkg;
              const int rt = pt * (CK_PT * 2) + 16 * pkg;
              *(LAS v4u*)(CKB(CB_AT) + ro) = oa; *(LAS v4u*)(CKT(CT_BM) + rt) = ob; *(LAS v4u*)(CKT(CT_KM) + rt) = ok; *(LAS v4u*)(CKB(CB_RM) + ro) = orr; *(LAS v4u*)(CKT(CT_VM) + rt) = gv; }
            if (c > 0) *(v4u*)(Yd + (size_t)CK_ROW((c - 1) * 64 + pt) * RS + 8 * pkg) = yprev;
            if (c + 1 < NCK) CK_GLOAD(c + 1);
            __syncthreads();
            { const CkFrag aBM = ck_ld<CK_PT * 2>(CKT(CT_BM), tr16, l15, g), aKM = ck_ld<CK_PT * 2>(CKT(CT_KM), tr16, l15, g);
#pragma unroll
              for (int q = 0; q < 2; ++q) { const int tc16 = tc0 + 16 * q; const bool dg = (tr16 == tc16);
                const CkFrag bAT = ck_ld(CKB(CB_AT), tc16, l15, g), bRM = ck_ld(CKB(CB_RM), tc16, l15, g);
                f32x4 pq = ck_mm(z4, aBM, bAT);
                f32x4 lak = ck_mm(z4, aKM, bAT), lrb = ck_mm(z4, aBM, bRM), lrk = ck_mm(z4, aKM, bRM);
#pragma unroll
                for (int r = 0; r < 4; ++r) { const int i = tr16 + 4 * g + r, t = tc16 + l15; if (!(i < t)) { pq[r] = 0.f; lak[r] = 0.f; } if (!(i <= t)) { lrb[r] = 0.f; lrk[r] = 0.f; } }
                if (dg) {
                    const CkFrag aAT = ck_ld(CKB(CB_AT), tr16, l15, g), bBM = ck_ld<CK_PT * 2>(CKT(CT_BM), tc16, l15, g);
                    f32x4 cn = ck_mm(z4, aAT, bBM);
#pragma unroll
                    for (int r = 0; r < 4; ++r) { const int t = tr16 + 4 * g + r, i = tc16 + l15; if (!(i < t)) cn[r] = 0.f; }
                    f32x4 cq = pq, Tt;
#pragma unroll
                    for (int r = 0; r < 4; ++r) Tt[r] = cq[r] + ((4 * g + r == l15) ? 1.f : 0.f);
                    unsigned zz = 0u; asm volatile("" : "+v"(zz));
#define CK_PACK(x) __builtin_bit_cast(bf16x8, (v4u){pk2((x)[0], (x)[1]), pk2((x)[2], (x)[3]), zz, zz})
#pragma unroll
                    for (int lv = 1; lv <= 3; ++lv) {
                        const bf16x8 on = CK_PACK(cn), oq = CK_PACK(cq);
                        cn = mm16(z4, oq, on);
                        if (lv < 3) cq = mm16(z4, on, oq);
                        Tt = mm16(Tt, CK_PACK(cn), CK_PACK(Tt));
                    }
#undef CK_PACK
                    sm_st_t(CKB(CB_N2) + (tr16 >> 4) * 1024, l15, g, Tt);
                    pq = z4;
                }
                ck_st_t(CKB(CB_N1), tr16, tc16, l15, g, pq);
                ck_st_t(CKB(CB_LAK), tr16, tc16, l15, g, lak); ck_st_t(CKB(CB_LRB), tr16, tc16, l15, g, lrb); ck_st_t(CKB(CB_LRK), tr16, tc16, l15, g, lrk);
                } }
            __syncthreads();
            if (wv < 4) {
                const int vb = 16 * wv; unsigned zz = 0u; asm volatile("" : "+v"(zz));
                const CkFrag bSB = ck_ld(CKB(CB_SB), vb, l15, g), bVT = ck_ld_tr(CKT(CT_VM), vb, l15, g);
                CkFrag aAT[4], aLAK[4]; v2u lw_[6], tw[4];
#pragma unroll
                for (int b2 = 0; b2 < 4; ++b2) { aAT[b2] = ck_ld(CKB(CB_AT), 16 * b2, l15, g); aLAK[b2] = ck_ld(CKB(CB_LAK), 16 * b2, l15, g); tw[b2] = *(const LAS v2u*)(CKB(CB_N2) + b2 * 1024 + l15 * 64 + g * 8); }
#pragma unroll
                for (int b2 = 1; b2 < 4; ++b2)
#pragma unroll
                    for (int j2 = 0; j2 < b2; ++j2) lw_[b2 * (b2 - 1) / 2 + j2] = *(const LAS v2u*)(CKB(CB_N1) + (16 * b2 + l15) * (CK_P * 2) + (16 * j2 + 4 * g) * 2);
                f32x4 R[4];
#pragma unroll
                for (int b2 = 0; b2 < 4; ++b2) { R[b2] = ck_mm(z4, aAT[b2], bSB); R[b2] = ck_mm(R[b2], aLAK[b2], bVT); }
#pragma unroll
                for (int b2 = 0; b2 < 4; ++b2) {
                    const f32x4 U = mm16(z4, __builtin_bit_cast(bf16x8, (v4u){tw[b2].x, tw[b2].y, zz, zz}), __builtin_bit_cast(bf16x8, (v4u){pk2(R[b2][0], R[b2][1]), pk2(R[b2][2], R[b2][3]), zz, zz}));
                    const bf16x8 Up = __builtin_bit_cast(bf16x8, (v4u){pk2(U[0], U[1]), pk2(U[2], U[3]), zz, zz});
                    ck_st_t(CKB(CB_N0), 16 * b2, vb, l15, g, U);
#pragma unroll
                    for (int b3 = b2 + 1; b3 < 4; ++b3) R[b3] = mm16(R[b3], __builtin_bit_cast(bf16x8, (v4u){lw_[b3 * (b3 - 1) / 2 + b2].x, lw_[b3 * (b3 - 1) / 2 + b2].y, zz, zz}), Up);
                }
            }
            __syncthreads();
            { const CkFrag aSB = ck_ld(CKB(CB_SB), tr16, l15, g), aUT = ck_ld(CKB(CB_N0), tr16, l15, g), aVT = ck_ld_tr(CKT(CT_VM), tr16, l15, g), aBMT = ck_ld_tr(CKT(CT_BM), tr16, l15, g), aKMT = ck_ld_tr(CKT(CT_KM), tr16, l15, g);
              const f32x4 wc = *(const LAS f32x4*)(WC + tr16 + 4 * g);
#pragma unroll
              for (int q = 0; q < 2; ++q) { const int tc16 = tc0 + 16 * q;
                const CkFrag bRM = ck_ld(CKB(CB_RM), tc16, l15, g), bLRB = ck_ld(CKB(CB_LRB), tc16, l15, g), bLRK = ck_ld(CKB(CB_LRK), tc16, l15, g), bUT = ck_ld(CKB(CB_N0), tc16, l15, g), bVT = ck_ld_tr(CKT(CT_VM), tc16, l15, g);
                f32x4 yt = ck_mm(z4, aSB, bRM); yt = ck_mm(yt, aUT, bLRB); yt = ck_mm(yt, aVT, bLRK);
                ck_st_t(CKB(CB_N2), tr16, tc16, l15, g, yt);
                SaccT[q] = ck_mm(SaccT[q], aBMT, bUT); SaccT[q] = ck_mm(SaccT[q], aKMT, bVT); SaccT[q] = SaccT[q] * wc; } }
            if (c + 1 < NCK) CK_CUMSEG();
            __syncthreads();
        }
        *(v4u*)(Yd + (size_t)CK_ROW((NCK - 1) * 64 + pt) * RS + 8 * pkg) = *(const LAS v4u*)(CKB(CB_N2) + pt * (CK_P * 2) + 16 * pkg);
#undef CK_CUMSEG
#undef CK_LW
#undef CK_ROW
#undef CK_GLOAD
#undef CK_GLOADW
    }
#undef CKB
#undef CKT
}
#endif
__device__ __forceinline__ void pR6_out(Frame& F, int jj) {
    const float* ln_w = INP(I_RWKV_LN_W) + jj * D; const float* ln_b = INP(I_RWKV_LN_B) + jj * D;
    v2u ry[4], ry1[4], rg[4], rv[4], rvf[4], rvg[4]; float rb0[4], rb1[4];
#define R6_ROW(P_, r_, dst_) do { _Pragma("unroll") for (int q = 0; q < 4; ++q) dst_[q] = __builtin_nontemporal_load(&((const v2u*)(WSP(const bf16_t, P_) + (size_t)(r_) * D))[F.lane + 64 * q]); } while (0)
#define R6_LOAD(r_) do { R6_ROW(WS_YS, (r_), ry); R6_ROW(WS_YS, (size_t)M + (r_), ry1); R6_ROW(WS_GB, (r_), rg); \
        if (jj == 0) R6_ROW(WS_VFIRST, (r_), rv); else { R6_ROW(WS_VB, (r_), rv); R6_ROW(WS_VFIRST, (r_), rvf); R6_ROW(WS_VGT, (r_), rvg); } \
        const float* bon_ = WSP(const float, WS_LOGITS) + (size_t)(r_) * 16 + (F.lane >> 4);        \
        _Pragma("unroll") for (int q = 0; q < 4; ++q) { rb0[q] = bon_[4 * q]; rb1[q] = bon_[(size_t)M * 16 + 4 * q]; } } while (0)
#define R6_UNP(w_) ((f32x4){bflo((w_).x), bfhi((w_).x), bflo((w_).y), bfhi((w_).y)})
    if (F.gw < M) R6_LOAD(F.gw);
    for (int r = F.gw; r < M; r += F.NGW) {
        f32x4 yy[4], v[4], g[4]; float bonus[4];
#pragma unroll
        for (int q = 0; q < 4; ++q) { yy[q] = R6_UNP(ry[q]) + R6_UNP(ry1[q]); g[q] = R6_UNP(rg[q]); v[q] = R6_UNP(rv[q]); bonus[q] = rb0[q] + rb1[q];
            if (jj != 0) { const f32x4 vf = R6_UNP(rvf[q]), vg = R6_UNP(rvg[q]); v[q] = v[q] + (vf - v[q]) * vg; } }
        if (r + F.NGW < M) R6_LOAD(r + F.NGW);
        f32x4 o[4];
#pragma unroll
        for (int q = 0; q < 4; ++q) {
            const float mu = head_sum((yy[q].x + yy[q].y) + (yy[q].z + yy[q].w)) * (1.f / 64.f);
            const f32x4 dlt = yy[q] - mu;
            const float var = head_sum((dlt.x * dlt.x + dlt.y * dlt.y) + (dlt.z * dlt.z + dlt.w * dlt.w)) * (1.f / 64.f);
            const f32x4 yn = dlt * rsqrtf(var + GN_EPS) * ((const f32x4*)ln_w)[F.lane + 64 * q] + ((const f32x4*)ln_b)[F.lane + 64 * q];
            o[q] = (yn + v[q] * bonus[q]) * g[q];
        }
        st_row_bf16(WSP(bf16_t, WS_OB) + (size_t)r * D, F.lane, o);
    }
#undef R6_ROW
#undef R6_LOAD
#undef R6_UNP
}
#define RWKV_PHASES(p0, L, J) \
    { const unsigned char* swo = (const unsigned char*)F.ws + WS_SMALLW + SW_OD + (size_t)(J) * OD_BYTES; \
    if (IN((p0) + 0)) { pR1_mix(F, (J)); SEAM((p0) + 0); } \
    if (IN((p0) + 1)) { MultiOrder<7> S; const char* xm = (const char*)(F.ws + WS_XMIX); \
        S.s[0] = SubGemm{xm + 0 * ROWB2, (const char*)(swo + OD_WR), 2048, 1024, 4, 0}; S.s[1] = SubGemm{xm + 2 * ROWB2, (const char*)(swo + OD_WK), 2048, 1024, 4, 1}; \
        S.s[2] = SubGemm{xm + 3 * ROWB2, (const char*)(swo + OD_WV), 2048, 1024, 4, 2}; S.s[3] = SubGemm{xm + 1 * ROWB2, (const char*)(swo + OD_W1C), 2048, 1024, 1, 3}; \
        S.s[4] = SubGemm{xm + 4 * ROWB2, (const char*)(swo + OD_A1C), 2048, 1024, 1, 4}; S.s[5] = SubGemm{xm + 5 * ROWB2, (const char*)(swo + OD_G1), 2048, 1024, 1, 5}; \
        S.s[6] = SubGemm{xm + 3 * ROWB2, (const char*)(swo + OD_V1), 2048, 1024, ((J) > 0) ? 1 : 0, 6}; S.init(F.G, F.bid, 1); \
        EpiR2 E; E.dst[0] = WSP(bf16_t, WS_RB); E.dst[1] = WSP(bf16_t, WS_KB); E.dst[2] = WSP(bf16_t, ((J) == 0) ? WS_VFIRST : WS_VB); E.dst[3] = WSP(bf16_t, WS_LW); E.dst[4] = WSP(bf16_t, WS_LA); \
        E.dst[5] = WSP(bf16_t, WS_LG); E.dst[6] = WSP(bf16_t, WS_LV); pg8::gemm_phase(ring, S, E, F.wave); SEAM((p0) + 1); } \
    if (IN((p0) + 2)) { MultiOrder<4> S; \
        S.s[0] = SubGemm{(const char*)(F.ws + WS_LW), (const char*)(swo + OD_W2C), 256, 128, 8, 0}; S.s[1] = SubGemm{(const char*)(F.ws + WS_LA), (const char*)(swo + OD_A2C), 256, 128, 8, 1}; \
        S.s[2] = SubGemm{(const char*)(F.ws + WS_LG), (const char*)(swo + OD_G2), 256, 128, 4, 2}; S.s[3] = SubGemm{(const char*)(F.ws + WS_LV), (const char*)(swo + OD_V2), 256, 128, ((J) > 0) ? 4 : 0, 3}; S.init(F.G, F.bid); \
        EpiR3 E{WSP(bf16_t, WS_WDEC), WSP(bf16_t, WS_AD), WSP(bf16_t, WS_GB), WSP(bf16_t, WS_VGT), INP(I_RWKV_W0) + (size_t)(J) * 2 * D, INP(I_RWKV_A0) + (size_t)(J) * 2 * D, INP(I_RWKV_V0)}; \
        pg8::gemm_phase(ring, S, E, F.wave); SEAM((p0) + 2); } \
      \
    if (IN((p0) + 4)) { pR5_scan(F, (J)); SEAM((p0) + 4); } \
    if (IN((p0) + 5)) { pR6_out(F, (J)); SEAM((p0) + 5); } \
    if (IN((p0) + 6)) { MultiOrder<1> S; S.s[0] = SubGemm{(const char*)(F.ws + WS_OB), (const char*)(swo + OD_WO), 2048, 1024, 4, 0}; S.init(F.G, F.bid); \
        EpiResidual E{WSP(bf16_t, WS_XR), WSP(const float, WS_MOD) + (size_t)(L) * 9 * 6144 + 2 * 1024}; pg8::gemm_phase(ring, S, E, F.wave); SEAM((p0) + 6); } }
#define MOE_PHASES(p0, L) \
    if (IN((p0) + 0)) { pF1R_norm_router(F, args, (L)); SEAM((p0) + 0); } \
      \
    if (IN((p0) + 2) && F.G * NWAVES * 17 < M) { pF3_route(F, (L)); SEAM((p0) + 2); }     \
    if (IN((p0) + 3)) { const int tt = moe_table(F, (L)); MoeOrder<8, 4, 2> S; int z_ = 0; asm volatile("" : "+s"(z_)); S.tb = (const LAS int*)(F.lds + LDSCTL_OFF + z_); S.A = (const char*)(F.ws + WS_HB); \
        S.W = (const char*)(F.ws + WS_W1T) + (size_t)(L) * 32 * 2048 * 1024 * 2; S.RI = WSP(const int, WS_ROWIDX); S.G = F.G; S.c = F.bid; S.nwg = ((tt + 3) / 4) * 4 * 8; \
        EpiSwiglu E{WSP(bf16_t, WS_ACT), INP(I_MOE_B1) + (size_t)(L) * 32 * 2048}; pg8::gemm_phase<EpiSwiglu, MoeOrder<8, 4, 2>, 2>(ring, S, E, F.wave); SEAM((p0) + 3); } \
    if (IN((p0) + 4)) { const int tt = moe_table(F, (L)); MoeOrder<4, 8, 0> S; int z_ = 0; asm volatile("" : "+s"(z_)); S.tb = (const LAS int*)(F.lds + LDSCTL_OFF + z_); S.A = (const char*)(F.ws + WS_ACT); \
        S.W = (const char*)(F.ws + WS_W2T) + (size_t)(L) * 32 * 1024 * 1024 * 2; S.RI = WSP(const int, WS_ROWIDX); S.G = F.G; S.c = F.bid; S.nwg = ((tt + 7) / 8) * 8 * 4; \
        EpiMoeDown E{WSP(bf16_t, WS_YB), INP(I_MOE_B2) + (size_t)(L) * 32 * 1024}; pg8::gemm_phase<EpiMoeDown, MoeOrder<4, 8, 0>, 0>(ring, S, E, F.wave); SEAM((p0) + 4); } \
    if (IN((p0) + 5)) { pF6_combine(F, args, (L)); SEAM((p0) + 5); }
constexpr int PH_P0 = 0, PH_P1 = 1, PH_LAYER0 = 2, PH_PER_PAIR = 25, PH_COPY = PH_LAYER0 + 2 * PH_PER_PAIR, PH_TOTAL = PH_COPY + 1;
__global__ void __launch_bounds__(NTHREADS, 2) fwd(Args args) {
    extern __shared__ __attribute__((aligned(16))) unsigned char lds_raw[];
    Frame F;
    F.lds = (LAS unsigned char*)lds_raw;
    F.MISC = (volatile LAS unsigned*)(F.lds + MISC_OFF);
    F.tid = threadIdx.x; F.lane = F.tid & 63; F.wave = __builtin_amdgcn_readfirstlane(F.tid >> 6);
    F.G = gridDim.x; F.bid = blockIdx.x; F.gw = F.bid * NWAVES + F.wave; F.NGW = F.G * NWAVES;
    F.ws = (GAS unsigned char*)args.ws; F.ctl = (gu32*)(args.ws + WS_CTL);
    for (int u = F.tid; u < (LDS_BYTES - LDSCTL_OFF) / 4; u += NTHREADS) ((LAS unsigned*)(F.lds + LDSCTL_OFF))[u] = 0u;
    __syncthreads();
    if (F.tid <= N_IN) { const unsigned long long pv = (F.tid < N_IN) ? (unsigned long long)args.in[F.tid] : (unsigned long long)args.out; *(LAS unsigned long long*)(F.lds + PTR_OFF + 8 * F.tid) = pv; }
    __syncthreads();
    XcdBarrier bar = xcd_barrier_post((unsigned*)(F.ctl + CW_BAR) + args.bli * XCD_BAR_WORDS, F.MISC + 8);
    const int lo = args.ph_lo, hi = args.ph_hi;
#define IN(k) (lo <= (k) && (k) < hi && phase_fence(F))
#define SEAM(k) do { if (lo <= (k) + 1 && (k) + 1 < hi) { XcdBarrier b2_ = bar; asm volatile("" : "+s"(b2_.bar), "+s"(b2_.x), "+s"(b2_.w)); xcd_barrier(b2_); } } while (0)
    if (IN(PH_P0)) { p0_prologue(F, args); SEAM(PH_P0); }
    if (IN(PH_P1)) { p1_init(F, args); SEAM(PH_P1); }
    LAS unsigned char* ring = F.lds + RING_OFF;
    for (int lp = 0; lp < 2; ++lp) {
        const int pb = PH_LAYER0 + lp * PH_PER_PAIR;
        if (hi <= pb) break;
        {
            const int layer = 2 * lp, e = lp;
            const unsigned char* swe = (const unsigned char*)F.ws + WS_SMALLW + SW_EV + (size_t)e * EV_BYTES;
            if (IN(pb + 0)) {
                MultiOrder<1> S; S.s[0] = SubGemm{(const char*)(F.ws + WS_HB), (const char*)(swe + EV_WIN), 2048, 1024, 7, 0}; S.init(F.G, F.bid);
                EpiStoreBf16 E{WSP(bf16_t, WS_PROJ), PROJ_LD, PROJ_LD};
                pg8::gemm_phase(ring, S, E, F.wave); SEAM(pb + 0); }
            if (IN(pb + 1)) { pA2_proj_norms(F, args, e); SEAM(pb + 1); }
            if (IN(pb + 2)) {
                MultiOrder<2> S; S.s[0] = SubGemm{(const char*)(F.ws + WS_PROJ) + C_ZQ * 2, (const char*)(swe + EV_WUQ), PROJ_LD * 2, 384, 3, 0};
                S.s[1] = SubGemm{(const char*)(F.ws + WS_PROJ) + C_ZKV * 2, (const char*)(swe + EV_WUKV), PROJ_LD * 2, 256, 4, 1}; S.init(F.G, F.bid);
                EpiStore2 E{WSP(bf16_t, WS_QM), 768, WSP(bf16_t, WS_KVM), 1024};
                pg8::gemm_phase(ring, S, E, F.wave); SEAM(pb + 2); }
            if (IN(pb + 3)) { pA4_mla_norms(F, args, e); SEAM(pb + 3); }
            if (IN(pb + 4)) { pA5_attention(F, lp == 0); SEAM(pb + 4); }
            if (IN(pb + 5)) {
                MultiOrder<1> S; S.s[0] = SubGemm{(const char*)(F.ws + WS_OB), (const char*)(swe + EV_WOUT), 2048, 1024, 4, 0}; S.init(F.G, F.bid);
                EpiResidual E{WSP(bf16_t, WS_XR), WSP(const float, WS_MOD) + (size_t)layer * 9 * 6144 + 2 * 1024};
                pg8::gemm_phase(ring, S, E, F.wave); SEAM(pb + 5); }
            MOE_PHASES(pb + 6, layer)
        }
        {
            const int layer = 2 * lp + 1, jj = lp;
            RWKV_PHASES(pb + 12, layer, jj)
            MOE_PHASES(pb + 19, layer)
        }
    }
    if (IN(PH_COPY)) { p_copy_out(F, args); }
#ifdef MK_SCANVAR
    for (int v_ = 0; v_ < 128; v_ += 64) if (IN(60 + v_)) pR5_scan(F, 1, v_);
#endif
#undef IN
#undef SEAM
}

extern "C" void kernel_launch(void* const* d_in, const int* in_sizes, int n_in, void* d_out, int out_size, void* d_ws, size_t ws_size, hipStream_t stream) {
    static int grid = 0;
    if (grid == 0) {
        if (n_in != N_IN || out_size != NB * SEQ * D || ws_size < WS_END) { fprintf(stderr, "kernel_launch: unexpected shapes: n_in %d out %d ws %zu (need %zu)\n", n_in, out_size, ws_size, (size_t)WS_END); grid = -1; return; }
        int dev = 0, cus = 0, per_cu = 0;
        if (hipGetDevice(&dev) != hipSuccess || hipDeviceGetAttribute(&cus, hipDeviceAttributeMultiprocessorCount, dev) != hipSuccess) { grid = -1; return; }
        if (hipFuncSetAttribute((const void*)fwd, hipFuncAttributeMaxDynamicSharedMemorySize, LDS_BYTES) != hipSuccess) { fprintf(stderr, "kernel_launch: hipFuncSetAttribute failed\n"); grid = -1; return; }
        if (hipOccupancyMaxActiveBlocksPerMultiprocessor(&per_cu, (const void*)fwd, NTHREADS, LDS_BYTES) != hipSuccess || per_cu < 1) { fprintf(stderr, "kernel_launch: occupancy query says %d\n", per_cu); }
        (void)hipGetLastError();
        grid = cus;
        if (grid > 256) grid = 256;
    }
    if (grid < 0) return;
    (void)hipMemsetAsync((char*)d_ws + WS_CTL, 0, CTL_BYTES, stream);
    (void)hipMemsetAsync((char*)d_ws + WS_SMALLW, 0, SMALLW_BYTES, stream);
    Args a{};
    for (int i = 0; i < N_IN; ++i) a.in[i] = (const float*)d_in[i];
    a.out = (float*)d_out; a.ws = (unsigned char*)d_ws;
#ifdef MK_RANGES
    { static const int ranges[][2] = { MK_RANGES };
      for (unsigned i = 0; i < sizeof(ranges) / sizeof(ranges[0]); ++i) { a.ph_lo = ranges[i][0]; a.ph_hi = ranges[i][1]; a.bli = (int)i; hipLaunchKernelGGL(fwd, dim3(grid), dim3(NTHREADS), LDS_BYTES, stream, a); } }
#elif MK_PER_PHASE
    for (int p = 0; p < PH_COPY; ++p) { a.ph_lo = p; a.ph_hi = p + 1; hipLaunchKernelGGL(fwd, dim3(grid), dim3(NTHREADS), LDS_BYTES, stream, a); }
#else
    a.ph_lo = 0; a.ph_hi = PH_COPY;
    hipLaunchKernelGGL(fwd, dim3(grid), dim3(NTHREADS), LDS_BYTES, stream, a);
#endif
}
```

```cpp
#include <hip/hip_runtime.h>
#include <cstdio>
#include <cstdint>

#ifndef MK_PER_PHASE
#define MK_PER_PHASE 0
#endif
#ifndef MK_LAST_PHASE
#define MK_LAST_PHASE 9999
#endif

#define GAS __attribute__((address_space(1)))
#define LAS __attribute__((address_space(3)))
typedef unsigned short bf16_t;
typedef unsigned v4u __attribute__((ext_vector_type(4)));
typedef unsigned v2u __attribute__((ext_vector_type(2)));
typedef float f32x4 __attribute__((ext_vector_type(4)));
typedef float f32x2 __attribute__((ext_vector_type(2)));
typedef float f32x16 __attribute__((ext_vector_type(16)));
typedef short bf16x8 __attribute__((ext_vector_type(8)));
typedef short s16x4 __attribute__((ext_vector_type(4)));
typedef GAS unsigned gu32;
#define RLX_AGENT __ATOMIC_RELAXED, __HIP_MEMORY_SCOPE_AGENT
#define LDS_WAIT() asm volatile("s_waitcnt lgkmcnt(0)" ::: "memory")
#define VM_WAIT() asm volatile("s_waitcnt vmcnt(0)" ::: "memory")

constexpr int D = 1024, NB = 8, SEQ = 4096, CTXL = 256, DEPTH = 4;
constexpr int TPB = SEQ + CTXL;
constexpr int M = NB * TPB;
constexpr int NPANEL = M / 256;
constexpr int NMOD = 6;
constexpr int PROJ_LD = 1792;
constexpr int C_ZQ = 0, C_ZKV = 384, C_ZR = 640, C_GQ = 704, C_GK = 1216, C_GV = 1472;
constexpr int NE = 32, TOPK = 4, FF = 1024;
constexpr int CAP = M;
constexpr float NORM_EPS = 1e-6f, GN_EPS = 64e-5f;
constexpr float MLA_SCALE = 0.07216878364870322f;
constexpr float GQA_SCALE = 0.08838834764831845f;
constexpr int NWAVES = 8, NTHREADS = 512;

enum { I_X = 0, I_C, I_CTX, I_CCTX, I_ADA_W, I_ADA_B, I_NORM_MIX, I_NORM_FFN, I_ATTN_W_IN, I_MLA_Q_NORM, I_MLA_W_UQ, I_MLA_KV_NORM, I_MLA_W_UKV,
       I_MLA_QN_G, I_MLA_QR_G, I_MLA_KN_G, I_MLA_KR_G, I_GQA_Q_G, I_GQA_K_G, I_ATTN_W_OUT, I_RWKV_MIX, I_RWKV_W_R, I_RWKV_W_K, I_RWKV_W_V, I_RWKV_W_O,
       I_RWKV_W0, I_RWKV_W1, I_RWKV_W2, I_RWKV_A0, I_RWKV_A1, I_RWKV_A2, I_RWKV_V0, I_RWKV_V1, I_RWKV_V2, I_RWKV_G1, I_RWKV_G2, I_RWKV_K_K, I_RWKV_K_A,
       I_RWKV_R_K, I_RWKV_LN_W, I_RWKV_LN_B, I_MOE_ROUTER_W, I_MOE_ROUTER_B, I_MOE_W1, I_MOE_B1, I_MOE_W2, I_MOE_B2, N_IN };

constexpr size_t MiB = 1u << 20;
constexpr size_t WS_CTL = 0, CTL_BYTES = 1 * MiB;
constexpr size_t WS_MOD = WS_CTL + CTL_BYTES;
constexpr size_t WS_SMALLW = WS_MOD + 1 * MiB;
constexpr size_t EV_WIN = 0, EV_WUQ = EV_WIN + (size_t)1792 * 1024 * 2, EV_WUKV = EV_WUQ + (size_t)768 * 384 * 2, EV_WOUT = EV_WUKV + (size_t)1024 * 256 * 2,
                 EV_BYTES = EV_WOUT + (size_t)1024 * 1024 * 2;
constexpr size_t OD_WR = 0, OD_WK = OD_WR + 2 * MiB, OD_WV = OD_WK + 2 * MiB, OD_WO = OD_WV + 2 * MiB, OD_W1C = OD_WO + 2 * MiB, OD_A1C = OD_W1C + 512 * 1024,
                 OD_G1 = OD_A1C + 512 * 1024, OD_V1 = OD_G1 + 512 * 1024, OD_W2C = OD_V1 + 512 * 1024, OD_A2C = OD_W2C + 512 * 1024, OD_G2 = OD_A2C + 512 * 1024,
                 OD_V2 = OD_G2 + 256 * 1024, OD_BYTES = OD_V2 + 256 * 1024;
constexpr size_t RT_BYTES = (size_t)256 * 1024 * 2;
constexpr size_t SW_EV = 0, SW_OD = SW_EV + 2 * EV_BYTES, SW_RT = SW_OD + 2 * OD_BYTES, SMALLW_BYTES = ((SW_RT + 4 * RT_BYTES + MiB - 1) / MiB) * MiB;
constexpr size_t WS_W1T = WS_SMALLW + SMALLW_BYTES;
constexpr size_t WS_W2T = WS_W1T + (size_t)128 * 2048 * 1024 * 2;
constexpr size_t WS_XR = WS_W2T + (size_t)128 * 1024 * 1024 * 2;
constexpr size_t ROWB2 = (size_t)M * 1024 * 2;
constexpr size_t WS_HB = WS_XR + 2 * ROWB2;
constexpr size_t WS_OB = WS_HB + ROWB2;
constexpr size_t WS_LOGITS = WS_OB + ROWB2;
constexpr size_t WS_TOPI = WS_LOGITS + (size_t)M * 32 * 4;
constexpr size_t WS_TOPG = WS_TOPI + (size_t)M * 16;
constexpr size_t WS_ROWIDX = WS_TOPG + (size_t)M * 16;
constexpr size_t WS_ACT = ((WS_ROWIDX + (size_t)NE * CAP * 4 + MiB - 1) / MiB) * MiB;
constexpr size_t WS_YB = WS_ACT + 4 * ROWB2;
constexpr size_t WS_MIX = WS_YB + 4 * ROWB2;
constexpr size_t WS_PROJ = WS_MIX;
constexpr size_t WS_QM = WS_PROJ + (size_t)M * PROJ_LD * 2;
constexpr size_t WS_KVM = WS_QM + (size_t)M * 768 * 2;
constexpr size_t WS_ATT_END = WS_KVM + ROWB2;
constexpr size_t WS_XMIX = WS_MIX;
constexpr size_t WS_RB = WS_XMIX + 6 * ROWB2, WS_KB = WS_RB + ROWB2, WS_VB = WS_KB + ROWB2;
constexpr size_t WS_LW = WS_VB + ROWB2, LORA_B = (size_t)M * 128 * 2, WS_LA = WS_LW + LORA_B, WS_LG = WS_LA + LORA_B, WS_LV = WS_LG + LORA_B;
constexpr size_t WS_WDEC = WS_LV + LORA_B;
constexpr size_t WS_AD = WS_WDEC + 4 * ROWB2;
constexpr size_t WS_GB = WS_AD + 2 * ROWB2, WS_VGT = WS_GB + ROWB2;
constexpr size_t WS_KK = WS_VGT + ROWB2, WS_KD = WS_KK + ROWB2, WS_BD = WS_KD + 2 * ROWB2, WS_V2 = WS_BD + 2 * ROWB2;
constexpr size_t WS_YS = WS_V2 + ROWB2;
constexpr size_t WS_RWKV_END = WS_YS + 4 * ROWB2;
constexpr size_t WS_VFIRST = WS_RWKV_END;
constexpr size_t WS_END = WS_VFIRST + ROWB2;
static_assert(WS_ATT_END <= WS_RWKV_END, "mixer scratch overlay");
static_assert(WS_END <= (size_t)4096 * MiB, "d_ws map must fit 4 GiB");

constexpr int CW_TMO = 0, CW_CODE = 1;
constexpr int CW_ECNT = 1024;
constexpr int CW_BAR = 16384;
constexpr int MAX_BAR_REGIONS = 64;
static_assert(CW_ECNT + 4 * 32 * 64 <= CW_BAR && (CW_BAR + MAX_BAR_REGIONS * 3456) * 4 <= (int)CTL_BYTES, "CTL words inside the memset region");

constexpr int RING_OFF = 0, RING_BYTES = 153600;
constexpr int LDSCTL_OFF = RING_BYTES, MISC_OFF = LDSCTL_OFF + 320;
constexpr int LDS_BYTES = RING_BYTES + 4096;
static_assert(MISC_OFF + 128 <= LDS_BYTES, "LDS map");

__device__ __forceinline__ unsigned f2bf(float f) { unsigned u = __builtin_bit_cast(unsigned, f); return (u + 0x7fffu + ((u >> 16) & 1u)) >> 16; }
typedef __bf16 bf16x2_t __attribute__((ext_vector_type(2)));
__device__ __forceinline__ unsigned pk2(float lo, float hi) { const f32x2 v = {lo, hi}; const bf16x2_t b = __builtin_convertvector(v, bf16x2_t); return __builtin_bit_cast(unsigned, b); }
__device__ __forceinline__ float bf2f(unsigned short h) { return __builtin_bit_cast(float, (unsigned)h << 16); }
__device__ __forceinline__ float bflo(unsigned w) { return __builtin_bit_cast(float, w << 16); }
__device__ __forceinline__ float bfhi(unsigned w) { return __builtin_bit_cast(float, w & 0xffff0000u); }
__device__ __forceinline__ int lane_now() { int l; asm volatile("v_mbcnt_lo_u32_b32 %0, -1, 0\n\tv_mbcnt_hi_u32_b32 %0, -1, %0" : "=v"(l)); return l; }
__device__ __forceinline__ int opaque_tid(int wave) { int t = wave * 64 + lane_now(); asm volatile("" : "+v"(t)); return t; }
__device__ __forceinline__ int lanes_get(int v, int src_lane) { return __builtin_amdgcn_ds_bpermute(src_lane << 2, v); }
__device__ __forceinline__ float lanes_xor(float v, int m) { return __builtin_bit_cast(float, __builtin_amdgcn_ds_bpermute((lane_now() ^ m) << 2, __builtin_bit_cast(int, v))); }
__device__ __forceinline__ float dpp_xor1(float x) { return __builtin_bit_cast(float, __builtin_amdgcn_update_dpp(0, __builtin_bit_cast(int, x), 0xB1, 0xF, 0xF, true)); }
__device__ __forceinline__ float dpp_xor2(float x) { return __builtin_bit_cast(float, __builtin_amdgcn_update_dpp(0, __builtin_bit_cast(int, x), 0x4E, 0xF, 0xF, true)); }
__device__ __forceinline__ float dpp_hmir(float x) { return __builtin_bit_cast(float, __builtin_amdgcn_update_dpp(0, __builtin_bit_cast(int, x), 0x141, 0xF, 0xF, true)); }
__device__ __forceinline__ float sum8(float x) { x += dpp_xor1(x); x += dpp_xor2(x); x += dpp_hmir(x); return x; }
__device__ __forceinline__ float dpp_rmir(float x) { return __builtin_bit_cast(float, __builtin_amdgcn_update_dpp(0, __builtin_bit_cast(int, x), 0x140, 0xF, 0xF, true)); }
__device__ __forceinline__ float sum16(float x) { x += dpp_xor1(x); x += dpp_xor2(x); x += dpp_hmir(x); x += dpp_rmir(x); return x; }
__device__ __forceinline__ float wave_sum(float v) {
    const int s = __builtin_bit_cast(int, sum16(v));
    return (__builtin_bit_cast(float, __builtin_amdgcn_readlane(s, 0)) + __builtin_bit_cast(float, __builtin_amdgcn_readlane(s, 16))) + (__builtin_bit_cast(float, __builtin_amdgcn_readlane(s, 32)) + __builtin_bit_cast(float, __builtin_amdgcn_readlane(s, 48)));
}
__device__ __forceinline__ float sigmoidf_(float x) { return __builtin_amdgcn_rcpf(1.f + __expf(-x)); }
__device__ __forceinline__ float siluf_(float x) { return x * __builtin_amdgcn_rcpf(1.f + __expf(-x)); }
#define XB_TMO      128
#define XB_XCNT(j)  (256  + 64 * (j))
#define XB_XSUB(j)  (1280 + 64 * (j))
#define XB_XGEN(j)  (2304 + 64 * (j))
#define XB_TOP      3328
#define XB_TOPGEN   3392
#define XCD_BAR_WORDS 3456
#define XB_SPIN_CAP (1u << 18)

__device__ __forceinline__ unsigned xb_ld(unsigned* p)              { return __hip_atomic_load(p, __ATOMIC_RELAXED, __HIP_MEMORY_SCOPE_AGENT); }
__device__ __forceinline__ unsigned xb_add(unsigned* p, unsigned v) { return __hip_atomic_fetch_add(p, v, __ATOMIC_RELAXED, __HIP_MEMORY_SCOPE_AGENT); }
__device__ __forceinline__ unsigned xb_xcc_id() { return (unsigned)__builtin_amdgcn_s_getreg((3 << 11) | 20) & 0xFu; }
#define XB_SPIN(cond, bar) do { unsigned _sp = 0; while (cond) { __builtin_amdgcn_s_sleep(1); \
    if ((++_sp & 255u) == 0u) { if (xb_ld(&(bar)[XB_TMO])) break; if (_sp > XB_SPIN_CAP) { atomicAdd(&(bar)[XB_TMO], 1u); break; } } } } while (0)

struct XcdBarrier {
    unsigned* bar; unsigned x; int w;
    volatile LAS unsigned* st;
};

__device__ __forceinline__ XcdBarrier xcd_barrier_post(unsigned* bar, volatile LAS unsigned* st) {
    XcdBarrier b; b.bar = bar; b.x = xb_xcc_id(); b.st = st; b.w = __builtin_amdgcn_readfirstlane((int)threadIdx.x >> 6);
    if (threadIdx.x == 0) (void)xb_add(&bar[XB_XCNT(b.x)], 1u);
    return b;
}
__device__ __forceinline__ void xcd_barrier_complete(unsigned* bar, unsigned x, unsigned& nloc, unsigned& nx) {
    const unsigned G = gridDim.x * gridDim.y * gridDim.z;
    unsigned sum, cnt, mine, sp = 0u;
    for (;;) {
        sum = 0u; cnt = 0u; mine = 0u;
#pragma unroll
        for (unsigned j = 0; j < 16; ++j) { const unsigned c = xb_ld(&bar[XB_XCNT(j)]); sum += c; cnt += (c > 0u) ? 1u : 0u; mine = (j == x) ? c : mine; }
        if (sum == G) break;
        __builtin_amdgcn_s_sleep(1);
        if ((++sp & 255u) == 0u) { if (xb_ld(&bar[XB_TMO])) break; if (sp > XB_SPIN_CAP) { atomicAdd(&bar[XB_TMO], 1u); break; } }
    }
    nloc = mine > 0u ? mine : 1u; nx = cnt > 0u ? cnt : 1u;
}

__device__ __forceinline__ void xcd_barrier(const XcdBarrier& b) {
    asm volatile("s_waitcnt vmcnt(0)" ::: "memory");
    __syncthreads();
    if (b.w == 0 && lane_now() == 0) {
        unsigned* bar = b.bar;
        __builtin_amdgcn_s_waitcnt(0);
        unsigned nloc = b.st[0], nx = b.st[1];
        if (nloc == 0u) { xcd_barrier_complete(bar, b.x, nloc, nx); b.st[0] = nloc; b.st[1] = nx; }
        const unsigned old = xb_add(&bar[XB_XSUB(b.x)], 1u);
        const unsigned gen = old / nloc;
        if (old + 1u == (gen + 1u) * nloc) {
            __builtin_amdgcn_fence(__ATOMIC_RELEASE, "agent");
            asm volatile("s_waitcnt vmcnt(0)" ::: "memory");
            const unsigned og = xb_add(&bar[XB_TOP], 1u);
            const unsigned tg = og / nx;
            if (og + 1u == (tg + 1u) * nx) xb_add(&bar[XB_TOPGEN], 1u);
            else XB_SPIN(xb_ld(&bar[XB_TOPGEN]) == tg, bar);
            __builtin_amdgcn_fence(__ATOMIC_ACQUIRE, "agent");
            xb_add(&bar[XB_XGEN(b.x)], 1u);
            asm volatile("s_waitcnt vmcnt(0)" ::: "memory");
        } else {
            XB_SPIN(xb_ld(&bar[XB_XGEN(b.x)]) == gen, bar);
            __builtin_amdgcn_fence(__ATOMIC_ACQUIRE, "agent");
            asm volatile("s_waitcnt vmcnt(0)" ::: "memory");
        }
    }
    __syncthreads();
}
namespace pg8 {
constexpr int BM = 256, BK = 64, HALF = 128, HTB = HALF * BK * 2  , STAGE_BYTES = 8 * HTB, IDX_OFF = STAGE_BYTES  ,
              TAB_OFF = IDX_OFF + 16384  ;

__host__ __device__ __forceinline__ int lds_byte(int r, int c) { const int st = (r >> 4) * 2 + (c >> 5), rr = r & 15, cc = c & 31, ob = rr * 64 + cc * 2; return st * 1024 + (ob ^ (((ob >> 9) & 1) << 5)); }
__host__ __device__ __forceinline__ void stage_rc(int b, int& R, int& C) { const int st = b / 1024, sb = b % 1024, swz = sb ^ (((sb >> 9) & 1) << 5); R = (st >> 1) * 16 + swz / 64; C = (st & 1) * 32 + (swz % 64) / 2; }
__host__ __device__ __forceinline__ int perm32(int rho) { const int n = rho >> 4, i = rho & 15; return 8 * (i >> 2) + 4 * n + (i & 3); }

struct Unit {
    const char* A; const char* B;
    int lda;
    int K;
    int pm, pn;
    int kind;
    int e;
    int nrows;
    const int* ridx;
};

__device__ __forceinline__ int rfl(int v) { return __builtin_amdgcn_readfirstlane(v); }
template <class T> __device__ __forceinline__ T* rflp(T* p) { const unsigned long long v = (unsigned long long)p; const unsigned lo = __builtin_amdgcn_readfirstlane((unsigned)v), hi = __builtin_amdgcn_readfirstlane((unsigned)(v >> 32));
    return (T*)(((unsigned long long)hi << 32) | lo); }
__device__ __forceinline__ void uniformize(Unit& u) { u.A = rflp(u.A); u.B = rflp(u.B); u.lda = rfl(u.lda); u.K = rfl(u.K); u.pm = rfl(u.pm); u.pn = rfl(u.pn); u.kind = rfl(u.kind); u.e = rfl(u.e); u.nrows = rfl(u.nrows); u.ridx = rflp(u.ridx); }
__device__ __forceinline__ unsigned cvt_pk_bf16(float lo, float hi) { unsigned r; asm volatile("v_cvt_pk_bf16_f32 %0, %1, %2" : "=v"(r) : "v"(lo), "v"(hi)); return r; }

template <class T, class = void> struct epi_has_tab { static constexpr bool value = false; };
template <class T> struct epi_has_tab<T, decltype((void)T::HAS_TAB)> { static constexpr bool value = true; };
template <class Epi, bool PRE = false>
__device__ __forceinline__ void run_epilogue(const Epi& E, const f32x4 (&acc)[2][2][4][2], const Unit& u, int wr, int wc, int fr, int fq, const LAS unsigned char* tab = nullptr) {
    typename Epi::Ctx c;
    const int lrow0 = wr * 64 + fr, lcol0 = wc * 32 + 8 * fq;
    if constexpr (PRE) E.begin_pre(c, u, lrow0, lcol0, tab); else E.begin(c, u, lrow0, lcol0);
#pragma unroll
    for (int ai = 0; ai < 2; ++ai) {
        E.begin_half(c, u, ai, lrow0, lcol0);
#pragma unroll
        for (int m = 0; m < 4; ++m)
#pragma unroll
            for (int bj = 0; bj < 2; ++bj) E.row8(c, u, ai * 4 + m, bj, lrow0 + ai * HALF + m * 16, lcol0 + bj * HALF, acc[ai][bj][m][0], acc[ai][bj][m][1]);
    }
}

template <class Epi, class Sched, int GSH = -1>
__device__ __forceinline__ void gemm_phase(LAS unsigned char* lds, const Sched& S, const Epi& E, int wave_) {
    const int tid = opaque_tid(wave_), wid = __builtin_amdgcn_readfirstlane(tid >> 6), lane = tid & 63, wr = wid >> 2, wc = wid & 3, fr = lane & 15, fq = lane >> 4;
    int R0, C0, R1, C1; stage_rc(tid * 16, R0, C0); stage_rc(tid * 16 + 8192, R1, C1);
    const int Rb0 = (R0 & ~31) + perm32(R0 & 31), Rb1 = (R1 & ~31) + perm32(R1 & 31);
    const unsigned ldsw = (unsigned)wid * 1024u;
    const int aoff = lds_byte(wr * 64 + fr, fq * 8), boff = lds_byte(wc * 32 + fr, fq * 8);
#define PG8_SA(b, h) (((b) * 2 + (h)) * HTB)
#define PG8_SB(b, h) ((4 + (b) * 2 + (h)) * HTB)
#define PG8_STAGE2(bufoff, gbase, o0, o1) do { \
        __builtin_amdgcn_global_load_lds((const unsigned*)((const char*)(gbase) + (o0)), (LAS unsigned*)(lds + (bufoff) + ldsw), 16, 0, 0); \
        __builtin_amdgcn_global_load_lds((const unsigned*)((const char*)(gbase) + (o1)), (LAS unsigned*)(lds + (bufoff) + ldsw + 8192), 16, 0, 0); } while (0)
#define PG8_LDA(dst, b, h) do { _Pragma("unroll") for (int m = 0; m < 4; ++m) _Pragma("unroll") for (int k = 0; k < 2; ++k) dst[m][k] = *(const LAS bf16x8*)(lds + PG8_SA(b, h) + aoff + m * 2048 + k * 1024); } while (0)
#define PG8_LDB(dst, b, h) do { _Pragma("unroll") for (int n = 0; n < 2; ++n) _Pragma("unroll") for (int k = 0; k < 2; ++k) dst[n][k] = *(const LAS bf16x8*)(lds + PG8_SB(b, h) + boff + n * 2048 + k * 1024); } while (0)
#define PG8_MMA(ai, bj, At, Bt) do { __builtin_amdgcn_s_setprio(1); _Pragma("unroll") for (int m = 0; m < 4; ++m) _Pragma("unroll") for (int n = 0; n < 2; ++n) _Pragma("unroll") for (int k = 0; k < 2; ++k) \
        acc[ai][bj][m][n] = __builtin_amdgcn_mfma_f32_16x16x32_bf16(Bt[n][k], At[m][k], acc[ai][bj][m][n], 0, 0, 0); __builtin_amdgcn_s_setprio(0); } while (0)
#define PG8_WAIT_V(n) asm volatile("s_waitcnt vmcnt(" #n ")" ::: "memory")
#define PG8_WAIT_L(n) asm volatile("s_waitcnt lgkmcnt(" #n ")" ::: "memory")
#define PG8_BAR __builtin_amdgcn_s_barrier()
#define PG8_SCHED __builtin_amdgcn_sched_barrier(0)
#define PG8_OFFS(u, a00, a01, a10, a11, b0, b1, hs) do { \
        if constexpr (GSH >= 0) { \
            const int i00 = (R0 < (u).nrows) ? (u).ridx[R0] : 0, i01 = (R1 < (u).nrows) ? (u).ridx[R1] : 0; \
            const int i10 = (HALF + R0 < (u).nrows) ? (u).ridx[HALF + R0] : 0, i11 = (HALF + R1 < (u).nrows) ? (u).ridx[HALF + R1] : 0; \
            a00 = (unsigned)(i00 >> GSH) * (unsigned)(u).lda + C0 * 2; a01 = (unsigned)(i01 >> GSH) * (unsigned)(u).lda + C1 * 2; \
            a10 = (unsigned)(i10 >> GSH) * (unsigned)(u).lda + C0 * 2; a11 = (unsigned)(i11 >> GSH) * (unsigned)(u).lda + C1 * 2; \
        } else { \
            const unsigned rb = (unsigned)((u).pm * BM) * (unsigned)(u).lda; \
            a00 = rb + (unsigned)R0 * (unsigned)(u).lda + C0 * 2; a01 = rb + (unsigned)R1 * (unsigned)(u).lda + C1 * 2; \
            a10 = a00 + (unsigned)HALF * (unsigned)(u).lda; a11 = a01 + (unsigned)HALF * (unsigned)(u).lda; } \
        b0 = (unsigned)(Rb0 * (u).K + C0) * 2u; b1 = (unsigned)(Rb1 * (u).K + C1) * 2u; hs = (unsigned)HALF * (unsigned)(u).K * 2u; } while (0)
    Unit cur, nxt; int ui = 0;
    if (!S.next(0, cur)) return;
    uniformize(cur);
    f32x4 acc[2][2][4][2];
#pragma unroll
    for (int a = 0; a < 2; ++a)
#pragma unroll
        for (int b = 0; b < 2; ++b)
#pragma unroll
            for (int m = 0; m < 4; ++m)
#pragma unroll
                for (int n = 0; n < 2; ++n) acc[a][b][m][n] = (f32x4){0.f, 0.f, 0.f, 0.f};
    bf16x8 At[4][2], B0[2][2], B1[2][2];
    unsigned ca00, ca01, ca10, ca11, cb0, cb1, chs;
    unsigned na00, na01, na10, na11, nb0, nb1, nhs;
    PG8_OFFS(cur, ca00, ca01, ca10, ca11, cb0, cb1, chs);
    const char* cA = cur.A; const char* cB = cur.B;
    constexpr unsigned kstep = BK * 2;
    PG8_STAGE2(PG8_SB(0, 0), cB, cb0, cb1); PG8_STAGE2(PG8_SB(0, 1), cB + chs, cb0, cb1); PG8_STAGE2(PG8_SA(0, 0), cA, ca00, ca01); PG8_STAGE2(PG8_SA(0, 1), cA, ca10, ca11);
    if (wr == 1) PG8_BAR;
    PG8_WAIT_V(2); PG8_BAR;
    PG8_STAGE2(PG8_SB(1, 0), cB + kstep, cb0, cb1); PG8_STAGE2(PG8_SA(1, 0), cA + kstep, ca00, ca01); PG8_STAGE2(PG8_SB(1, 1), cB + chs + kstep, cb0, cb1);
    PG8_WAIT_V(6); PG8_BAR;
    for (;;) {
        if constexpr (GSH >= 0) {
            LAS unsigned char* tb = lds + TAB_OFF + (ui & 1) * 2048;
            if (wid < 4) __builtin_amdgcn_global_load_lds((const unsigned*)(cur.ridx + wid * 64 + lane), (LAS unsigned*)(tb + wid * 256), 4, 0, 0);
            else __builtin_amdgcn_global_load_lds((const unsigned*)(E.bias_of(cur) + (wid - 4) * 64 + lane), (LAS unsigned*)(tb + 1024 + (wid - 4) * 256), 4, 0, 0);
        }
        else if constexpr (epi_has_tab<Epi>::value) {
            if (wid >= 4) __builtin_amdgcn_global_load_lds((const unsigned*)(E.bias_of(cur) + (wid - 4) * 64 + lane), (LAS unsigned*)(lds + TAB_OFF + (ui & 1) * 2048 + 1024 + (wid - 4) * 256), 4, 0, 0);
        }
        const bool has_next = S.next(ui + 1, nxt); uniformize(nxt);
        const char* nA = cA; const char* nB = cB; na00 = ca00; na01 = ca01; na10 = ca10; na11 = ca11; nb0 = cb0; nb1 = cb1; nhs = chs;
        if (has_next) { nA = nxt.A; nB = nxt.B;
            if constexpr (GSH >= 0) {
                nb0 = (unsigned)(Rb0 * nxt.K + C0) * 2u; nb1 = (unsigned)(Rb1 * nxt.K + C1) * 2u; nhs = (unsigned)HALF * (unsigned)nxt.K * 2u;
                LAS unsigned char* ib = lds + IDX_OFF + (ui & 1) * 8192 + wid * 1024;
                __builtin_amdgcn_global_load_lds((const unsigned*)(nxt.ridx + R0), (LAS unsigned*)(ib), 4, 0, 0);
                __builtin_amdgcn_global_load_lds((const unsigned*)(nxt.ridx + R1), (LAS unsigned*)(ib + 256), 4, 0, 0);
                __builtin_amdgcn_global_load_lds((const unsigned*)(nxt.ridx + HALF + R0), (LAS unsigned*)(ib + 512), 4, 0, 0);
                __builtin_amdgcn_global_load_lds((const unsigned*)(nxt.ridx + HALF + R1), (LAS unsigned*)(ib + 768), 4, 0, 0);
            } else { PG8_OFFS(nxt, na00, na01, na10, na11, nb0, nb1, nhs); } }
        const int nt = cur.K / BK;
        for (int t = 0; t < nt; t += 2) {
            const bool last = (t == nt - 2);
            if constexpr (GSH >= 0) { if (last && has_next) {
                const LAS unsigned char* ib = lds + IDX_OFF + (ui & 1) * 8192 + wid * 1024 + lane * 4;
                int i00 = *(const LAS int*)(ib), i01 = *(const LAS int*)(ib + 256), i10 = *(const LAS int*)(ib + 512), i11 = *(const LAS int*)(ib + 768);
                i00 = (R0 < nxt.nrows) ? i00 : 0; i01 = (R1 < nxt.nrows) ? i01 : 0; i10 = (HALF + R0 < nxt.nrows) ? i10 : 0; i11 = (HALF + R1 < nxt.nrows) ? i11 : 0;
                na00 = (unsigned)(i00 >> GSH) * (unsigned)nxt.lda + C0 * 2; na01 = (unsigned)(i01 >> GSH) * (unsigned)nxt.lda + C1 * 2;
                na10 = (unsigned)(i10 >> GSH) * (unsigned)nxt.lda + C0 * 2; na11 = (unsigned)(i11 >> GSH) * (unsigned)nxt.lda + C1 * 2; } }
            const char* a1 = cA + (size_t)(t + 1) * kstep;
            const char* a2 = last ? nA : cA + (size_t)(t + 2) * kstep; const char* b2 = last ? nB : cB + (size_t)(t + 2) * kstep;
            const char* a3 = a2 + kstep; const char* b3 = b2 + kstep;
            const unsigned xa00 = last ? na00 : ca00, xa01 = last ? na01 : ca01, xa10 = last ? na10 : ca10, xa11 = last ? na11 : ca11;
            const unsigned xb0 = last ? nb0 : cb0, xb1 = last ? nb1 : cb1, xhs = last ? nhs : chs;
            PG8_LDB(B0, 0, 0); PG8_LDB(B1, 0, 1); PG8_SCHED; PG8_LDA(At, 0, 0); PG8_STAGE2(PG8_SA(1, 1), a1, ca10, ca11);
            PG8_WAIT_V(8); PG8_WAIT_L(0); PG8_BAR; PG8_MMA(0, 0, At, B0); PG8_MMA(0, 1, At, B1); PG8_BAR; PG8_SCHED;
            PG8_LDA(At, 0, 1); PG8_STAGE2(PG8_SB(0, 0), b2, xb0, xb1); PG8_STAGE2(PG8_SB(0, 1), b2 + xhs, xb0, xb1); PG8_STAGE2(PG8_SA(0, 0), a2, xa00, xa01);
            PG8_WAIT_V(8); PG8_WAIT_L(0); PG8_BAR; PG8_MMA(1, 0, At, B0); PG8_MMA(1, 1, At, B1); PG8_BAR; PG8_SCHED;
            PG8_LDB(B0, 1, 0); PG8_LDB(B1, 1, 1); PG8_SCHED; PG8_LDA(At, 1, 0); PG8_STAGE2(PG8_SA(0, 1), a2, xa10, xa11);
            PG8_WAIT_V(8); PG8_WAIT_L(0); PG8_BAR; PG8_MMA(0, 0, At, B0); PG8_MMA(0, 1, At, B1); PG8_BAR; PG8_SCHED;
            PG8_LDA(At, 1, 1); PG8_STAGE2(PG8_SB(1, 0), b3, xb0, xb1); PG8_STAGE2(PG8_SB(1, 1), b3 + xhs, xb0, xb1); PG8_STAGE2(PG8_SA(1, 0), a3, xa00, xa01);
            PG8_WAIT_V(8); PG8_WAIT_L(0); PG8_BAR; PG8_MMA(1, 0, At, B0); PG8_MMA(1, 1, At, B1); PG8_BAR; PG8_SCHED;
        }
        if (wr == 0) PG8_BAR;
        if constexpr (GSH >= 0 || epi_has_tab<Epi>::value) run_epilogue<Epi, true>(E, acc, cur, wr, wc, fr, fq, lds + TAB_OFF + (ui & 1) * 2048); else run_epilogue(E, acc, cur, wr, wc, fr, fq);
        if (!has_next) break;
#pragma unroll
        for (int a = 0; a < 2; ++a)
#pragma unroll
            for (int b = 0; b < 2; ++b)
#pragma unroll
                for (int m = 0; m < 4; ++m)
#pragma unroll
                    for (int n = 0; n < 2; ++n) acc[a][b][m][n] = (f32x4){0.f, 0.f, 0.f, 0.f};
        cur = nxt; cA = nA; cB = nB; ca00 = na00; ca01 = na01; ca10 = na10; ca11 = na11; cb0 = nb0; cb1 = nb1; chs = nhs; ++ui;
        if (wr == 1) PG8_BAR;
    }
    PG8_WAIT_V(0);
    PG8_BAR;
#undef PG8_SA
#undef PG8_SB
#undef PG8_STAGE2
#undef PG8_LDA
#undef PG8_LDB
#undef PG8_MMA
#undef PG8_WAIT_V
#undef PG8_WAIT_L
#undef PG8_BAR
#undef PG8_SCHED
#undef PG8_OFFS
}
}
namespace att {
constexpr int NW = 8, QBLK = 32, KVBLK = 64;
constexpr float THR = 8.f;
constexpr int SHM_V = KVBLK * 128 * 2, SHM_K = KVBLK * 128 * 2, SHM_R = KVBLK * 64 * 2;
constexpr int OFF_V = 0, OFF_K = 2 * SHM_V, OFF_R = OFF_K + 2 * SHM_K, OFF_WS = OFF_R + 2 * SHM_R, OFF_QR = OFF_WS + NW * 64 * 4, ATTN_LDS_GQA = OFF_QR, QL_MAX = 8, ATTN_LDS = OFF_QR + NW * QL_MAX * 1024;
#define KSWZ(row, colB) ((row) * 256 + ((colB) ^ (((row) & 7) << 4)))
#define RSWZ(row, colB) ((row) * 128 + ((colB) ^ ((((row) >> 1) & 7) << 4)))
#define SBAR() __builtin_amdgcn_sched_barrier(0)
__device__ __forceinline__ int crow(int r, int hi) { return (r & 3) + 8 * (r >> 2) + 4 * hi; }
__device__ __forceinline__ unsigned cvtpk(float lo, float hi) { unsigned r; asm volatile("v_cvt_pk_bf16_f32 %0, %1, %2" : "=v"(r) : "v"(lo), "v"(hi)); return r; }

template <int DK>
__device__ __forceinline__ void partialSM(f32x16& p0, f32x16& p1, float& m_reg, float& mn, float& alpha) {
  constexpr float SCALE = (DK == 192) ? MLA_SCALE : GQA_SCALE;
  constexpr float C = SCALE * 1.4426950408889634f;
  float pmax = p0[0];
#pragma unroll
  for (int r = 1; r < 16; ++r) pmax = fmaxf(pmax, p0[r]);
#pragma unroll
  for (int r = 0; r < 16; ++r) pmax = fmaxf(pmax, p1[r]);
  { auto rr = __builtin_amdgcn_permlane32_swap(__float_as_uint(pmax), __float_as_uint(pmax), false, false);
    pmax = fmaxf(__uint_as_float(rr[0]), __uint_as_float(rr[1])); }
  if (__builtin_expect(__all(pmax - m_reg <= THR / SCALE), 1)) { mn = m_reg; alpha = 1.f; }
  else { mn = fmaxf(m_reg, pmax); alpha = __builtin_amdgcn_exp2f((m_reg - mn) * C); m_reg = mn; }
  float mnC = -mn * C;
#pragma unroll
  for (int r = 0; r < 16; ++r) p0[r] = fmaf(p0[r], C, mnC);
#pragma unroll
  for (int r = 0; r < 16; ++r) p1[r] = fmaf(p1[r], C, mnC);
#pragma unroll
  for (int r = 0; r < 16; ++r) p0[r] = __builtin_amdgcn_exp2f(p0[r]);
}
__device__ __forceinline__ void finishSM(f32x16& p0, f32x16& p1, float alpha, float& l_reg, bf16x8& pa0, bf16x8& pa1, bf16x8& pa2, bf16x8& pa3) {
#pragma unroll
  for (int r = 0; r < 16; ++r) p1[r] = __builtin_amdgcn_exp2f(p1[r]);
  float ps = 0;
#pragma unroll
  for (int r = 0; r < 16; ++r) ps += p0[r];
#pragma unroll
  for (int r = 0; r < 16; ++r) ps += p1[r];
  { auto rr = __builtin_amdgcn_permlane32_swap(__float_as_uint(ps), __float_as_uint(ps), false, false);
    ps = __uint_as_float(rr[0]) + __uint_as_float(rr[1]); }
  l_reg = l_reg * alpha + ps;
#define PK4(P, BASE, OUT) do { unsigned a0 = cvtpk(P[BASE + 0], P[BASE + 1]), a1 = cvtpk(P[BASE + 2], P[BASE + 3]);   \
    unsigned b0 = cvtpk(P[BASE + 4], P[BASE + 5]), b1 = cvtpk(P[BASE + 6], P[BASE + 7]);                              \
    auto r0 = __builtin_amdgcn_permlane32_swap(a0, b0, false, false); auto r1 = __builtin_amdgcn_permlane32_swap(a1, b1, false, false); \
    v4u w = {r0[0], r1[0], r0[1], r1[1]}; OUT = __builtin_bit_cast(bf16x8, w); } while (0)
  PK4(p0, 0, pa0); PK4(p0, 8, pa1); PK4(p1, 0, pa2); PK4(p1, 8, pa3);
#undef PK4
}
template <int DK, int QREG, bool QSB = (DK == 192)>
__device__ __forceinline__ void qkt(f32x16& p0, f32x16& p1, const char* Ks, const char* Rs, const bf16x8* qr, const char* Qrl, int r32, int hi) {
  p0 = f32x16{}; p1 = f32x16{};
#pragma unroll
  for (int d0 = 0; d0 < 8; ++d0) { const int cb = (d0 * 16 + hi * 8) * 2;
    bf16x8 b0 = *reinterpret_cast<const bf16x8*>(Ks + KSWZ(r32, cb));
    bf16x8 b1 = *reinterpret_cast<const bf16x8*>(Ks + KSWZ(32 + r32, cb));
    bf16x8 qf; if constexpr (true) { if (d0 < QREG) qf = qr[d0 < QREG ? d0 : 0]; else qf = *reinterpret_cast<const bf16x8*>(Qrl + (d0 - QREG) * (NW * 1024)); }
    p0 = __builtin_amdgcn_mfma_f32_32x32x16_bf16(b0, qf, p0, 0, 0, 0);
    p1 = __builtin_amdgcn_mfma_f32_32x32x16_bf16(b1, qf, p1, 0, 0, 0);
    if (QSB && (d0 & 3) == 3) SBAR(); }
  if constexpr (DK == 192) {
#pragma unroll
    for (int d0 = 0; d0 < 4; ++d0) { const int cb = (d0 * 16 + hi * 8) * 2;
      bf16x8 b0 = *reinterpret_cast<const bf16x8*>(Rs + RSWZ(r32, cb));
      bf16x8 b1 = *reinterpret_cast<const bf16x8*>(Rs + RSWZ(32 + r32, cb));
      const bf16x8 qf = *reinterpret_cast<const bf16x8*>(Qrl + (8 + d0 - QREG) * (NW * 1024));
      p0 = __builtin_amdgcn_mfma_f32_32x32x16_bf16(b0, qf, p0, 0, 0, 0);
      p1 = __builtin_amdgcn_mfma_f32_32x32x16_bf16(b1, qf, p1, 0, 0, 0); }
  }
}
__device__ __forceinline__ int v_st(int k, int c) { const int kk = (k & ~0xC) | ((k & 4) << 1) | ((k & 8) >> 1); return ((kk >> 3) * 4 + (c >> 5)) * 512 + ((kk & 7) * 32 + (c & 31)) * 2; }
__device__ __forceinline__ int v_rd_base(int lane) { return ((lane & 3) << 3) | (((lane >> 2) & 3) << 6) | (((lane >> 4) & 1) << 5) | (((lane >> 5) & 1) << 8); }
constexpr int v_rd_off(int d0, int ks, int half) { return d0 * 512 + ks * 4096 + half * 2048; }
template <int OFF> __device__ __forceinline__ s16x4 tr_read(int vb) {
  s16x4 r; asm volatile("ds_read_b64_tr_b16 %0, %1 offset:%2" : "=&v"(r) : "v"(vb), "i"(OFF) : "memory"); return r;
}
template <int D0> __device__ __forceinline__ void pv_one(f32x16& od, int vb, bf16x8 pa0, bf16x8 pa1, bf16x8 pa2, bf16x8 pa3) {
  const s16x4 l0 = tr_read<v_rd_off(D0, 0, 0)>(vb), h0 = tr_read<v_rd_off(D0, 0, 1)>(vb), l1 = tr_read<v_rd_off(D0, 1, 0)>(vb), h1 = tr_read<v_rd_off(D0, 1, 1)>(vb);
  const s16x4 l2 = tr_read<v_rd_off(D0, 2, 0)>(vb), h2 = tr_read<v_rd_off(D0, 2, 1)>(vb), l3 = tr_read<v_rd_off(D0, 3, 0)>(vb), h3 = tr_read<v_rd_off(D0, 3, 1)>(vb);
  asm volatile("s_waitcnt lgkmcnt(0)" ::: "memory"); SBAR();
#define PK(L, H) (bf16x8){L[0], L[1], L[2], L[3], H[0], H[1], H[2], H[3]}
  od = __builtin_amdgcn_mfma_f32_32x32x16_bf16(pa0, PK(l0, h0), od, 0, 0, 0);
  od = __builtin_amdgcn_mfma_f32_32x32x16_bf16(pa1, PK(l1, h1), od, 0, 0, 0);
  od = __builtin_amdgcn_mfma_f32_32x32x16_bf16(pa2, PK(l2, h2), od, 0, 0, 0);
  od = __builtin_amdgcn_mfma_f32_32x32x16_bf16(pa3, PK(l3, h3), od, 0, 0, 0);
#undef PK
}
__device__ __forceinline__ void pv_d0(f32x16* o, int vb, bf16x8 pa0, bf16x8 pa1, bf16x8 pa2, bf16x8 pa3) {
  pv_one<0>(o[0], vb, pa0, pa1, pa2, pa3); pv_one<1>(o[1], vb, pa0, pa1, pa2, pa3); pv_one<2>(o[2], vb, pa0, pa1, pa2, pa3); pv_one<3>(o[3], vb, pa0, pa1, pa2, pa3);
}

template <int DK, int SDEPTH, int QREG, int LDQ, int LDK, int LDR, int LDV, int LDO>
__device__ __forceinline__ void attn_unit(const bf16_t* __restrict__ Qb, const bf16_t* __restrict__ Kh, const bf16_t* __restrict__ Rh,
                                          const bf16_t* __restrict__ Vh, bf16_t* __restrict__ Ob, int seq, char* lds, int wave_) {
  const int tid = opaque_tid(wave_), wid = tid >> 6, lane = tid & 63, r32 = lane & 31, hi = lane >> 5;
  char* V_lds = lds + OFF_V; char* K_lds = lds + OFF_K; char* R_lds = lds + OFF_R;
  float* ws = (float*)(lds + OFF_WS) + wid * 64; float* li_l = ws; float* al_l = ws + 32;
  float m_reg = -1e30f, l_reg = 0; f32x16 o[4] = {}; bf16x8 qr[QREG];
  static_assert(DK / 16 - QREG <= QL_MAX, "q fragments in LDS");
  char* Qrl = lds + OFF_QR + wid * 1024 + lane * 16;
  const bf16_t* Qw = Qb + (long)(wid * QBLK + r32) * LDQ + hi * 8;
#pragma unroll
  for (int d0 = 0; d0 < QREG; ++d0) qr[d0] = *reinterpret_cast<const bf16x8*>(Qw + d0 * 16);
#pragma unroll
  for (int d0 = QREG; d0 < DK / 16; ++d0) *reinterpret_cast<bf16x8*>(Qrl + (d0 - QREG) * (NW * 1024)) = *reinterpret_cast<const bf16x8*>(Qw + d0 * 16);
  const int sr = tid >> 4, sc = (tid & 15) * 8, vst0 = v_st(sr, sc), vst1 = v_st(32 + sr, sc);
  const int rr_ = tid >> 3, rc_ = (tid & 7) * 8;
  const int vb0 = (int)(uintptr_t)V_lds + v_rd_base(lane);
  struct { bf16x8 vs0, vs1, ks0, ks1; } sr_[SDEPTH];
  bf16x8 rs_[SDEPTH];
  const unsigned voV = (unsigned)(sr * LDV + sc) * 2u, voK = (unsigned)(sr * LDK + sc) * 2u, voR = (unsigned)(rr_ * LDR + rc_) * 2u;
#define GLD(base, uoff, voff) (*reinterpret_cast<const bf16x8*>((const char*)(base) + (size_t)(uoff) + (voff)))
#define SLOAD(i, k0) do { sr_[i].vs0 = GLD(Vh, (size_t)(k0) * LDV * 2, voV); sr_[i].vs1 = GLD(Vh, (size_t)((k0) + 32) * LDV * 2, voV); \
    sr_[i].ks0 = GLD(Kh, (size_t)(k0) * LDK * 2, voK); sr_[i].ks1 = GLD(Kh, (size_t)((k0) + 32) * LDK * 2, voK); \
    if constexpr (DK == 192) rs_[i] = GLD(Rh, (size_t)(k0) * LDR * 2, voR); } while (0)
#define SWRITE(b, i) do { *(bf16x8*)(V_lds + (b) * SHM_V + vst0) = sr_[i].vs0;          \
    *(bf16x8*)(V_lds + (b) * SHM_V + vst1) = sr_[i].vs1; const int kc = sc * 2;               \
    *(bf16x8*)(K_lds + (b) * SHM_K + KSWZ(sr, kc)) = sr_[i].ks0;                       \
    *(bf16x8*)(K_lds + (b) * SHM_K + KSWZ(32 + sr, kc)) = sr_[i].ks1;                  \
    if constexpr (DK == 192) *(bf16x8*)(R_lds + (b) * SHM_R + RSWZ(rr_, rc_ * 2)) = rs_[i]; } while (0)
#define SWAIT() do { if constexpr (SDEPTH == 2) { if constexpr (DK == 192) asm volatile("s_waitcnt vmcnt(5)" ::: "memory"); else asm volatile("s_waitcnt vmcnt(4)" ::: "memory"); } \
    else asm volatile("s_waitcnt vmcnt(0)" ::: "memory"); } while (0)
#define RESC(a) do { if (__any((a) < 1.f)) { if (hi == 0) al_l[r32] = (a); asm volatile("s_waitcnt lgkmcnt(0)" ::: "memory"); \
    _Pragma("unroll") for (int d = 0; d < 4; ++d) _Pragma("unroll") for (int r = 0; r < 16; ++r) o[d][r] *= al_l[crow(r, hi)]; } } while (0)
  f32x16 pA0, pA1, pB0, pB1; float mnA, mnB, alA, alB; bf16x8 pa0, pa1, pa2, pa3; const int NT = seq / KVBLK;
  constexpr int SE = 0, SO = SDEPTH - 1;
  SLOAD(SE, 0); asm volatile("s_waitcnt vmcnt(0)" ::: "memory"); SWRITE(0, SE); __syncthreads();
  qkt<DK, QREG>(pA0, pA1, K_lds, R_lds, qr, Qrl, r32, hi); partialSM<DK>(pA0, pA1, m_reg, mnA, alA);
  SLOAD(SO, KVBLK); if constexpr (SDEPTH == 2) { if (2 < NT) SLOAD(SE, 2 * KVBLK); }
  SWAIT(); SWRITE(1, SO); __syncthreads();
  for (int j = 1; j + 1 < NT; j += 2) {
    SBAR(); qkt<DK, QREG>(pB0, pB1, K_lds + SHM_K, R_lds + SHM_R, qr, Qrl, r32, hi);
    finishSM(pA0, pA1, alA, l_reg, pa0, pa1, pa2, pa3); SBAR();
    SLOAD(SO, (j + SDEPTH) * KVBLK); SBAR();
    pv_d0(o, vb0, pa0, pa1, pa2, pa3); partialSM<DK>(pB0, pB1, m_reg, mnB, alB);
    __syncthreads(); SWAIT(); SWRITE(0, SE);
    RESC(alB); __syncthreads();
    SBAR(); qkt<DK, QREG>(pA0, pA1, K_lds, R_lds, qr, Qrl, r32, hi);
    finishSM(pB0, pB1, alB, l_reg, pa0, pa1, pa2, pa3); SBAR();
    if (SDEPTH == 1 || j + 3 < NT) SLOAD(SE, (j + 1 + SDEPTH) * KVBLK); SBAR();
    pv_d0(o, vb0 + (int)SHM_V, pa0, pa1, pa2, pa3); partialSM<DK>(pA0, pA1, m_reg, mnA, alA);
    __syncthreads(); SWAIT(); SWRITE(1, SO);
    RESC(alA); __syncthreads();
  }
  SBAR(); qkt<DK, QREG>(pB0, pB1, K_lds + SHM_K, R_lds + SHM_R, qr, Qrl, r32, hi);
  finishSM(pA0, pA1, alA, l_reg, pa0, pa1, pa2, pa3); SBAR();
  pv_d0(o, vb0, pa0, pa1, pa2, pa3); partialSM<DK>(pB0, pB1, m_reg, mnB, alB);
  __syncthreads(); RESC(alB);
  finishSM(pB0, pB1, alB, l_reg, pa0, pa1, pa2, pa3); SBAR();
  pv_d0(o, vb0 + (int)SHM_V, pa0, pa1, pa2, pa3);
  if (hi == 0) li_l[r32] = l_reg; asm volatile("s_waitcnt lgkmcnt(0)" ::: "memory");
  float rli[16];
#pragma unroll
  for (int r = 0; r < 16; ++r) rli[r] = __builtin_amdgcn_rcpf(li_l[crow(r, hi)]);
  bf16_t* Ow = Ob + (long)(wid * QBLK) * LDO;
#pragma unroll
  for (int r = 0; r < 16; ++r) { const int orow = crow(r, hi);
#pragma unroll
    for (int d0 = 0; d0 < 4; ++d0) Ow[(long)orow * LDO + d0 * 32 + r32] = (bf16_t)f2bf(o[d0][r] * rli[r]); }
  __syncthreads();
#undef SLOAD
#undef GLD
#undef SWRITE
#undef SWAIT
#undef RESC
}
#undef KSWZ
#undef RSWZ
#undef SBAR
}
struct Args { const float* in[N_IN]; float* out; unsigned char* ws; int ph_lo, ph_hi, bli, pad; };
struct Frame {
    LAS unsigned char* lds;
    volatile LAS unsigned* MISC;
    gu32* ctl;
    int tid, lane, wave, bid, G, gw, NGW;
    GAS unsigned char* ws;
};
#define WSP(T, off) ((T*)(GAS T*)(F.ws + (off)))
constexpr int PTR_OFF = LDSCTL_OFF + 1024;
__device__ __forceinline__ const float* inp(const Frame& F, int i) {
    int z = 0; asm volatile("" : "+s"(z));
    const LAS unsigned* t = (const LAS unsigned*)(F.lds + PTR_OFF + z) + 2 * i;
    const unsigned lo = __builtin_amdgcn_readfirstlane(t[0]), hi = __builtin_amdgcn_readfirstlane(t[1]);
    return (const float*)(GAS const float*)(((unsigned long long)hi << 32) | lo);
}
#define INP(i) inp(F, (i))
__device__ __forceinline__ bool phase_fence(Frame& F) { asm volatile("" : "+s"(F.ws), "+s"(F.ctl), "+s"(F.G), "+s"(F.bid), "+s"(F.wave));
    F.tid = opaque_tid(F.wave); F.lane = F.tid & 63; F.gw = F.bid * NWAVES + F.wave; F.NGW = F.G * NWAVES; return true; }

__device__ __forceinline__ void row_bj(int r, int& b, int& j) { b = r / TPB; j = r - b * TPB; }
__device__ __forceinline__ const float* mod_ptr(const Frame& F, int layer, int mrow, int which) { return WSP(const float, WS_MOD) + ((size_t)(layer * 9 + mrow) * NMOD + which) * D; }

__device__ __forceinline__ void ld_row_f32(const float* p, int lane, f32x4 (&v)[4]) {
#pragma unroll
    for (int j = 0; j < 4; ++j) v[j] = __builtin_nontemporal_load(&((const f32x4*)p)[lane + 64 * j]);
}
__device__ __forceinline__ void st_row_f32(float* p, int lane, const f32x4 (&v)[4]) {
#pragma unroll
    for (int j = 0; j < 4; ++j) ((f32x4*)p)[lane + 64 * j] = v[j];
}
__device__ __forceinline__ void ld_row_bf16(const bf16_t* p, int lane, f32x4 (&v)[4]) {
#pragma unroll
    for (int j = 0; j < 4; ++j) { const v2u w = ((const v2u*)p)[lane + 64 * j]; v[j] = (f32x4){bflo(w.x), bfhi(w.x), bflo(w.y), bfhi(w.y)}; }
}
__device__ __forceinline__ void st_row_bf16(bf16_t* p, int lane, const f32x4 (&v)[4]) {
#pragma unroll
    for (int j = 0; j < 4; ++j) { v2u w; w.x = pk2(v[j].x, v[j].y); w.y = pk2(v[j].z, v[j].w); ((v2u*)p)[lane + 64 * j] = w; }
}
__device__ __forceinline__ void rms_mod(f32x4 (&v)[4], int lane, const float* gain, const float* shift, const float* scale) {
    float ss = 0.f;
#pragma unroll
    for (int j = 0; j < 4; ++j) ss += (v[j].x * v[j].x + v[j].y * v[j].y) + (v[j].z * v[j].z + v[j].w * v[j].w);
    const float rs = rsqrtf(wave_sum(ss) * (1.f / D) + NORM_EPS);
#pragma unroll
    for (int j = 0; j < 4; ++j) {
        const f32x4 g = ((const f32x4*)gain)[lane + 64 * j], sh = ((const f32x4*)shift)[lane + 64 * j], sc = ((const f32x4*)scale)[lane + 64 * j];
        v[j] = (v[j] * rs) * g * (sc + 1.f) + sh;
    }
}

__device__ __forceinline__ void p0_transpose_item(const float* W, int K, int N, bf16_t* WT, int ld, LAS float* scr, int item, int lane) {
    const int nblk = N / 32, kb = item / nblk, nb = item - kb * nblk, k0 = 64 * kb, n0 = 32 * nb;
#pragma unroll 8
    for (int i = 0; i < 32; ++i) { const int kk = 2 * i + (lane >> 5); scr[kk * 33 + (lane & 31)] = (k0 + kk < K) ? W[(size_t)(k0 + kk) * N + n0 + (lane & 31)] : 0.f; }
    LDS_WAIT(); asm volatile("" ::: "memory");
    const int c = lane & 7;
    if (k0 + 8 * c < K) {
#pragma unroll
        for (int j = 0; j < 4; ++j) { const int n = (lane >> 3) + 8 * j; const LAS float* s = scr + (8 * c) * 33 + n;
            v4u o; o.x = pk2(s[0 * 33], s[1 * 33]); o.y = pk2(s[2 * 33], s[3 * 33]); o.z = pk2(s[4 * 33], s[5 * 33]); o.w = pk2(s[6 * 33], s[7 * 33]);
            *(GAS v4u*)(WT + (size_t)(n0 + n) * ld + k0 + 8 * c) = o; }
    }
    LDS_WAIT(); asm volatile("" ::: "memory");
}
__device__ __forceinline__ void p0_transpose_item64(const float* W, int N, bf16_t* WT, int ld, LAS float* scr, int kb, int nb, int lane) {
    const int k0 = 64 * kb, n0 = 64 * nb, lr = lane >> 4, lc = 4 * (lane & 15);
    const float* src = W + (size_t)(k0 + lr) * N + n0 + lc;
    f32x4 v[16];
#pragma unroll
    for (int q = 0; q < 16; ++q) v[q] = __builtin_nontemporal_load((const f32x4*)(src + (size_t)(4 * q) * N));
#pragma unroll
    for (int q = 0; q < 16; ++q) *(LAS f32x4*)(scr + (4 * q + lr) * 68 + lc) = v[q];
    LDS_WAIT(); asm volatile("" ::: "memory");
    const int ln = lane >> 3, kc = lane & 7;
#pragma unroll
    for (int rr = 0; rr < 8; ++rr) { const int n = 8 * rr + ln; const LAS float* s = scr + (8 * kc) * 68 + n;
        v4u o; o.x = pk2(s[0 * 68], s[1 * 68]); o.y = pk2(s[2 * 68], s[3 * 68]); o.z = pk2(s[4 * 68], s[5 * 68]); o.w = pk2(s[6 * 68], s[7 * 68]);
        *(GAS v4u*)(WT + (size_t)(n0 + n) * ld + k0 + 8 * kc) = o; }
    LDS_WAIT(); asm volatile("" ::: "memory");
}
struct TJob { int in_idx; unsigned src_off; int K, N; unsigned long long dst_off; int ld; int count; unsigned src_stride; unsigned dst_stride; };
constexpr unsigned long long SWE(int e, size_t o) { return WS_SMALLW + SW_EV + (size_t)e * EV_BYTES + o; }
constexpr unsigned long long SWO(int j, size_t o) { return WS_SMALLW + SW_OD + (size_t)j * OD_BYTES + o; }
constexpr int NJOBS = 33;
__device__ const TJob g_jobs[NJOBS] = {
    {I_MOE_W1, 0, 1024, 2048, WS_W1T, 1024, 128, 1024u * 2048u, 2048u * 1024u},
    {I_MOE_W2, 0, 1024, 1024, WS_W2T, 1024, 128, 1024u * 1024u, 1024u * 1024u},
    {I_ATTN_W_IN, 0, 1024, 1728, SWE(0, EV_WIN), 1024, 2, 1024u * 1728u, (unsigned)(EV_BYTES / 2)},
    {I_MLA_W_UQ, 0, 384, 768, SWE(0, EV_WUQ), 384, 2, 384u * 768u, (unsigned)(EV_BYTES / 2)},
    {I_MLA_W_UKV, 0, 256, 1024, SWE(0, EV_WUKV), 256, 2, 256u * 1024u, (unsigned)(EV_BYTES / 2)},
    {I_ATTN_W_OUT, 0, 1024, 1024, SWE(0, EV_WOUT), 1024, 2, 1024u * 1024u, (unsigned)(EV_BYTES / 2)},
    {I_RWKV_W_R, 0, 1024, 1024, SWO(0, OD_WR), 1024, 2, 1024u * 1024u, (unsigned)(OD_BYTES / 2)},
    {I_RWKV_W_K, 0, 1024, 1024, SWO(0, OD_WK), 1024, 2, 1024u * 1024u, (unsigned)(OD_BYTES / 2)},
    {I_RWKV_W_V, 0, 1024, 1024, SWO(0, OD_WV), 1024, 2, 1024u * 1024u, (unsigned)(OD_BYTES / 2)},
    {I_RWKV_W_O, 0, 1024, 1024, SWO(0, OD_WO), 1024, 2, 1024u * 1024u, (unsigned)(OD_BYTES / 2)},
    {I_RWKV_W1, 0 * 65536u, 1024, 64, SWO(0, OD_W1C) + 0 * 64 * 2048, 1024, 1, 0, 0},
    {I_RWKV_W1, 1 * 65536u, 1024, 64, SWO(0, OD_W1C) + 1 * 64 * 2048, 1024, 1, 0, 0},
    {I_RWKV_W1, 2 * 65536u, 1024, 64, SWO(1, OD_W1C) + 0 * 64 * 2048, 1024, 1, 0, 0},
    {I_RWKV_W1, 3 * 65536u, 1024, 64, SWO(1, OD_W1C) + 1 * 64 * 2048, 1024, 1, 0, 0},
    {I_RWKV_A1, 0 * 65536u, 1024, 64, SWO(0, OD_A1C) + 0 * 64 * 2048, 1024, 1, 0, 0},
    {I_RWKV_A1, 1 * 65536u, 1024, 64, SWO(0, OD_A1C) + 1 * 64 * 2048, 1024, 1, 0, 0},
    {I_RWKV_A1, 2 * 65536u, 1024, 64, SWO(1, OD_A1C) + 0 * 64 * 2048, 1024, 1, 0, 0},
    {I_RWKV_A1, 3 * 65536u, 1024, 64, SWO(1, OD_A1C) + 1 * 64 * 2048, 1024, 1, 0, 0},
    {I_RWKV_G1, 0, 1024, 128, SWO(0, OD_G1), 1024, 2, 1024u * 128u, (unsigned)(OD_BYTES / 2)},
    {I_RWKV_V1, 0, 1024, 32, SWO(1, OD_V1), 1024, 1, 0, 0},
    {I_RWKV_W2, 0 * 65536u, 64, 1024, SWO(0, OD_W2C) + (0 * 1024 * 128 + 0 * 64) * 2, 128, 1, 0, 0},
    {I_RWKV_W2, 1 * 65536u, 64, 1024, SWO(0, OD_W2C) + (1 * 1024 * 128 + 1 * 64) * 2, 128, 1, 0, 0},
    {I_RWKV_W2, 2 * 65536u, 64, 1024, SWO(1, OD_W2C) + (0 * 1024 * 128 + 0 * 64) * 2, 128, 1, 0, 0},
    {I_RWKV_W2, 3 * 65536u, 64, 1024, SWO(1, OD_W2C) + (1 * 1024 * 128 + 1 * 64) * 2, 128, 1, 0, 0},
    {I_RWKV_A2, 0 * 65536u, 64, 1024, SWO(0, OD_A2C) + (0 * 1024 * 128 + 0 * 64) * 2, 128, 1, 0, 0},
    {I_RWKV_A2, 1 * 65536u, 64, 1024, SWO(0, OD_A2C) + (1 * 1024 * 128 + 1 * 64) * 2, 128, 1, 0, 0},
    {I_RWKV_A2, 2 * 65536u, 64, 1024, SWO(1, OD_A2C) + (0 * 1024 * 128 + 0 * 64) * 2, 128, 1, 0, 0},
    {I_RWKV_A2, 3 * 65536u, 64, 1024, SWO(1, OD_A2C) + (1 * 1024 * 128 + 1 * 64) * 2, 128, 1, 0, 0},
    {I_RWKV_G2, 0, 128, 1024, SWO(0, OD_G2), 128, 2, 128u * 1024u, (unsigned)(OD_BYTES / 2)},
    {I_RWKV_V2, 0, 32, 1024, SWO(1, OD_V2), 128, 1, 0, 0},
    {I_MOE_ROUTER_W, 0, 1024, 32, WS_SMALLW + SW_RT, 1024, 4, 1024u * 32u, (unsigned)(RT_BYTES / 2)},
    {-1, 0, 64, 32, 0, 0, 0, 0, 0},
    {-1, 0, 64, 32, 0, 0, 0, 0, 0},
};
__device__ __forceinline__ bool job_fast(const TJob& j) { return (j.K % 64 == 0) && (j.N % 64 == 0); }
__device__ __forceinline__ int job_per(const TJob& j) { return job_fast(j) ? (j.K / 64) * (j.N / 64) : ((j.K + 63) / 64) * (j.N / 32); }
__device__ __forceinline__ int job_items(const TJob& j) { return j.count * job_per(j); }

struct TItem { const float* W; bf16_t* WT; int K, N, ld, item; bool fast; };
__device__ __forceinline__ TItem p0_decode(const Frame& F, int jlo, int it) {
    int r = it, j = jlo;
    for (;; ++j) { if (g_jobs[j].in_idx < 0) continue; const int n = job_items(g_jobs[j]); if (r < n) break; r -= n; }
    const TJob jb = g_jobs[j];
    const int per = job_per(jb), mi = r / per;
    TItem t; t.W = INP(jb.in_idx) + jb.src_off + (size_t)mi * jb.src_stride; t.WT = (bf16_t*)(GAS bf16_t*)(F.ws + jb.dst_off) + (size_t)mi * jb.dst_stride; t.K = jb.K; t.N = jb.N; t.ld = jb.ld; t.item = r - mi * per; t.fast = job_fast(jb);
    return t;
}
__device__ __forceinline__ void p0_load64(const TItem& t, int lane, f32x4 (&v)[16]) {
    const int nblk = t.N / 64, kb = t.item / nblk, nb = t.item - kb * nblk;
    const float* src = t.W + (size_t)(64 * kb + (lane >> 4)) * t.N + 64 * nb + 4 * (lane & 15);
#pragma unroll
    for (int q = 0; q < 16; ++q) v[q] = __builtin_nontemporal_load((const f32x4*)(src + (size_t)(4 * q) * t.N));
}
__device__ __forceinline__ void p0_finish64(const TItem& t, int lane, const f32x4 (&v)[16], LAS float* scr) {
    const int nblk = t.N / 64, kb = t.item / nblk, nb = t.item - kb * nblk, k0 = 64 * kb, n0 = 64 * nb, lr = lane >> 4, lc = 4 * (lane & 15);
#pragma unroll
    for (int q = 0; q < 16; ++q) *(LAS f32x4*)(scr + (4 * q + lr) * 68 + lc) = v[q];
    LDS_WAIT(); asm volatile("" ::: "memory");
    const int ln = lane >> 3, kc = lane & 7;
#pragma unroll
    for (int rr = 0; rr < 8; ++rr) { const int n = 8 * rr + ln; const LAS float* s = scr + (8 * kc) * 68 + n;
        v4u o; o.x = pk2(s[0 * 68], s[1 * 68]); o.y = pk2(s[2 * 68], s[3 * 68]); o.z = pk2(s[4 * 68], s[5 * 68]); o.w = pk2(s[6 * 68], s[7 * 68]);
        __builtin_nontemporal_store(o, (GAS v4u*)(t.WT + (size_t)(n0 + n) * t.ld + k0 + 8 * kc)); }
    LDS_WAIT(); asm volatile("" ::: "memory");
}
__device__ __forceinline__ void p0_transposes_fast(Frame& F, int jlo, int jhi, int first, int stride) {
    LAS float* scr = (LAS float*)(F.lds + RING_OFF + F.wave * 17408);
    int total = 0;
    for (int j = jlo; j < jhi; ++j) if (g_jobs[j].in_idx >= 0) total += job_items(g_jobs[j]);
    if (first >= total) return;
    f32x4 va[16], vb[16];
    TItem ta = p0_decode(F, jlo, first), tb = ta; p0_load64(ta, F.lane, va);
    for (int it = first; it < total; it += 2 * stride) {
        const bool hb = it + stride < total, ha2 = it + 2 * stride < total;
        if (hb) { tb = p0_decode(F, jlo, it + stride); p0_load64(tb, F.lane, vb); }
        p0_finish64(ta, F.lane, va, scr);
        if (ha2) { ta = p0_decode(F, jlo, it + 2 * stride); p0_load64(ta, F.lane, va); }
        if (hb) p0_finish64(tb, F.lane, vb, scr);
    }
}
__device__ __forceinline__ void p0_transposes(Frame& F, int jlo, int jhi, int first, int stride) {
    LAS float* scr = (LAS float*)(F.lds + RING_OFF + F.wave * 17408);
    int total = 0;
    for (int j = jlo; j < jhi; ++j) if (g_jobs[j].in_idx >= 0) total += job_items(g_jobs[j]);
    for (int it = first; it < total; it += stride) {
        const TItem t = p0_decode(F, jlo, it);
        if (t.fast) { const int nblk = t.N / 64; p0_transpose_item64(t.W, t.N, t.WT, t.ld, scr, t.item / nblk, t.item % nblk, F.lane); }
        else p0_transpose_item(t.W, t.K, t.N, t.WT, t.ld, scr, t.item, F.lane);
    }
}
__device__ __forceinline__ void p0_prologue(Frame& F, const Args& args) {
    {
        LAS float* Ssil = (LAS float*)(F.lds + RING_OFF);
        LAS float* Part = (LAS float*)(F.lds + RING_OFF + 40960);
        bool have = false;
        for (int it = F.bid; it < 96; it += F.G) {
            if (!have) {
                for (int idx = F.tid; idx < 9 * 1024; idx += NTHREADS) { const int r = idx >> 10, k = idx & 1023; const float cv = (r < 8) ? INP(I_C)[r * 1024 + k] : INP(I_CCTX)[k]; Ssil[idx] = siluf_(cv); }
                __syncthreads(); have = true;
            }
            const int l = it / 24, n0 = (it % 24) * 256;
            const float* Wb = INP(I_ADA_W) + (size_t)l * 1024 * 6144 + n0 + 4 * F.lane;
            f32x4 acc[9];
#pragma unroll
            for (int r = 0; r < 9; ++r) acc[r] = (f32x4){0.f, 0.f, 0.f, 0.f};
            const int kb = F.wave * 128;
            for (int k = 0; k < 128; k += 8) {
                f32x4 wv[8];
#pragma unroll
                for (int u = 0; u < 8; ++u) wv[u] = *(const f32x4*)(Wb + (size_t)(kb + k + u) * 6144);
#pragma unroll
                for (int u = 0; u < 8; ++u)
#pragma unroll
                    for (int r = 0; r < 9; ++r) acc[r] = acc[r] + wv[u] * Ssil[r * 1024 + kb + k + u];
            }
#pragma unroll
            for (int r = 0; r < 9; ++r) *(LAS f32x4*)(Part + (F.wave * 9 + r) * 256 + 4 * F.lane) = acc[r];
            __syncthreads();
            for (int idx = F.tid; idx < 9 * 256; idx += NTHREADS) {
                const int r = idx >> 8, n = idx & 255; float s = INP(I_ADA_B)[l * 6144 + n0 + n];
#pragma unroll
                for (int w = 0; w < 8; ++w) s += Part[(w * 9 + r) * 256 + n];
                WSP(float, WS_MOD)[(size_t)(l * 9 + r) * 6144 + n0 + n] = s;
            }
            __syncthreads();
        }
        __syncthreads();
    }
    if (F.G > 2 * 96) { if (F.bid >= 96) p0_transposes(F, 2, NJOBS, (F.bid - 96) * NWAVES + F.wave, (F.G - 96) * NWAVES); }
    else p0_transposes(F, 2, NJOBS, F.gw, F.NGW);
}
__device__ __forceinline__ void p1_init(Frame& F, const Args& args) {
    const float* gain = INP(I_NORM_MIX);
    f32x4 raw[4];
#define P1_LOAD(r_) do { int b_, j_; row_bj((r_), b_, j_); const float* src_ = (j_ < CTXL) ? INP(I_CTX) + ((size_t)b_ * CTXL + j_) * D : INP(I_X) + ((size_t)b_ * SEQ + (j_ - CTXL)) * D; ld_row_f32(src_, F.lane, raw); } while (0)
    if (F.gw < M) P1_LOAD(F.gw);
    for (int r = F.gw; r < M; r += F.NGW) {
        int b, j; row_bj(r, b, j);
        f32x4 v[4];
#pragma unroll
        for (int q = 0; q < 4; ++q) v[q] = raw[q];
        asm volatile("" : "+v"(v[0]), "+v"(v[1]), "+v"(v[2]), "+v"(v[3]));
        if (r + F.NGW < M) P1_LOAD(r + F.NGW);
        st_row_bf16(WSP(bf16_t, WS_XR) + (size_t)r * D, F.lane, v);
        const int mrow = (j < CTXL) ? 8 : b;
        rms_mod(v, F.lane, gain, mod_ptr(F, 0, mrow, 0), mod_ptr(F, 0, mrow, 1));
        st_row_bf16(WSP(bf16_t, WS_HB) + (size_t)r * D, F.lane, v);
    }
#undef P1_LOAD
}
__device__ __forceinline__ void p_copy_out(Frame& F, const Args& args) {
    for (int r = F.gw; r < M; r += F.NGW) {
        int b, j; row_bj(r, b, j); if (j < CTXL) continue;
        f32x4 v[4]; ld_row_bf16(WSP(const bf16_t, WS_XR) + (size_t)r * D, F.lane, v);
        st_row_f32(((float*)INP(N_IN)) + ((size_t)b * SEQ + (j - CTXL)) * D, F.lane, v);
    }
}
struct SubGemm { const char* A; const char* Bt; int lda; int K; int ntn; int kind; };
template <int NS>
struct MultiOrder {
    SubGemm s[NS]; int ntn_total, nwg, G, c, submajor;
    __device__ __forceinline__ void init(int G_, int c_, int submajor_ = 0) { ntn_total = 0; submajor = submajor_;
#pragma unroll
        for (int i = 0; i < NS; ++i) ntn_total += s[i].ntn;
        nwg = NPANEL * ntn_total; G = G_; c = c_; }
    __device__ __forceinline__ bool next(int i, pg8::Unit& u) const {
        const long L = (long)i * G + c; if (L >= nwg) return false;
        int wgid = (int)L; { const int q = nwg / 8, r = nwg % 8, xcd = wgid % 8, off = wgid / 8; wgid = (xcd < r ? xcd * (q + 1) : r * (q + 1) + (xcd - r) * q) + off; }
        const char* A = s[0].A; const char* Bt = s[0].Bt; int lda = s[0].lda, K = s[0].K, kind = s[0].kind; int pm, pn;
        if (submajor) {
            int nN = s[0].ntn, base = 0, acc = NPANEL * s[0].ntn;
#pragma unroll
            for (int k = 1; k < NS; ++k) { const bool ge = wgid >= acc; A = ge ? s[k].A : A; Bt = ge ? s[k].Bt : Bt; lda = ge ? s[k].lda : lda; K = ge ? s[k].K : K; kind = ge ? s[k].kind : kind; nN = ge ? s[k].ntn : nN; base = ge ? acc : base; acc += NPANEL * s[k].ntn; }
            const int lid = wgid - base, nig = 8 * nN, gid = lid / nig, fm = gid * 8, gsz = (NPANEL - fm) < 8 ? (NPANEL - fm) : 8;
            pm = fm + ((lid % nig) % gsz); pn = (lid % nig) / gsz;
        } else {
            const int nig = 8 * ntn_total, gid = wgid / nig, fm = gid * 8, gsz = (NPANEL - fm) < 8 ? (NPANEL - fm) : 8;
            pm = fm + ((wgid % nig) % gsz); const int vpn = (wgid % nig) / gsz; pn = vpn; int base = 0;
#pragma unroll
            for (int k = 1; k < NS; ++k) { base += s[k - 1].ntn; const bool ge = vpn >= base; A = ge ? s[k].A : A; Bt = ge ? s[k].Bt : Bt; lda = ge ? s[k].lda : lda; K = ge ? s[k].K : K; kind = ge ? s[k].kind : kind; pn = ge ? vpn - base : pn; }
        }
        u.A = A; u.B = Bt + (size_t)pn * 256 * K * 2; u.lda = lda; u.K = K; u.pm = pm; u.pn = pn; u.kind = kind; u.e = 0; u.nrows = 256; u.ridx = nullptr;
        return true;
    }
};

__device__ __forceinline__ v4u pack8(f32x4 v0, f32x4 v1) { v4u w; w.x = pk2(v0[0], v0[1]); w.y = pk2(v0[2], v0[3]); w.z = pk2(v1[0], v1[1]); w.w = pk2(v1[2], v1[3]); return w; }
struct NoCtx {};
struct EpiStoreBf16 {
    typedef NoCtx Ctx;
    bf16_t* O; int ldc; int ncols;
    __device__ __forceinline__ void begin(Ctx&, const pg8::Unit&, int, int) const {}
    __device__ __forceinline__ void begin_half(Ctx&, const pg8::Unit&, int, int, int) const {}
    __device__ __forceinline__ void row8(const Ctx&, const pg8::Unit& u, int, int, int lrow, int lcol, f32x4 v0, f32x4 v1) const {
        const int col = u.pn * 256 + lcol; if (col >= ncols) return;
        *(v4u*)(O + (size_t)(u.pm * 256 + lrow) * ldc + col) = pack8(v0, v1);
    }
};
struct EpiStore2 {
    typedef NoCtx Ctx;
    bf16_t* O0; int ld0; bf16_t* O1; int ld1;
    __device__ __forceinline__ void begin(Ctx&, const pg8::Unit&, int, int) const {}
    __device__ __forceinline__ void begin_half(Ctx&, const pg8::Unit&, int, int, int) const {}
    __device__ __forceinline__ void row8(const Ctx&, const pg8::Unit& u, int, int, int lrow, int lcol, f32x4 v0, f32x4 v1) const {
        bf16_t* O = u.kind ? O1 : O0; const int ld = u.kind ? ld1 : ld0;
        *(v4u*)(O + (size_t)(u.pm * 256 + lrow) * ld + u.pn * 256 + lcol) = pack8(v0, v1);
    }
};
struct EpiResidual {
    struct Ctx { f32x4 g[2][2]; v4u x[8][2]; };
    bf16_t* XR; const float* mod_base;
    __device__ __forceinline__ void begin(Ctx& c, const pg8::Unit& u, int lrow0, int lcol0) const {
        const int b = u.pm / 17, mrow = (u.pm - b * 17 == 0) ? 8 : b;
        const float* g = mod_base + (size_t)mrow * 6144 + u.pn * 256 + lcol0;
#pragma unroll
        for (int bj = 0; bj < 2; ++bj) { c.g[bj][0] = *(const f32x4*)(g + bj * 128); c.g[bj][1] = *(const f32x4*)(g + bj * 128 + 4); }
#pragma unroll
        for (int ai = 0; ai < 2; ++ai) {
            const bf16_t* x = XR + (size_t)(u.pm * 256 + lrow0 + ai * 128) * D + u.pn * 256 + lcol0;
#pragma unroll
            for (int m = 0; m < 4; ++m)
#pragma unroll
                for (int bj = 0; bj < 2; ++bj) c.x[ai * 4 + m][bj] = *(const v4u*)(x + (size_t)m * 16 * D + bj * 128); }
    }
    __device__ __forceinline__ void begin_half(Ctx&, const pg8::Unit&, int, int, int) const {}
    __device__ __forceinline__ void row8(const Ctx& c, const pg8::Unit& u, int slot, int bj, int lrow, int lcol, f32x4 v0, f32x4 v1) const {
        bf16_t* x = XR + (size_t)(u.pm * 256 + lrow) * D + u.pn * 256 + lcol; const v4u xo = c.x[slot][bj];
        const f32x4 x0 = (f32x4){bflo(xo.x), bfhi(xo.x), bflo(xo.y), bfhi(xo.y)}, x1 = (f32x4){bflo(xo.z), bfhi(xo.z), bflo(xo.w), bfhi(xo.w)};
        const f32x4 r0 = x0 + c.g[bj][0] * v0, r1 = x1 + c.g[bj][1] * v1;
        v4u w; w.x = pk2(r0[0], r0[1]); w.y = pk2(r0[2], r0[3]); w.z = pk2(r1[0], r1[1]); w.w = pk2(r1[2], r1[3]);
        *(v4u*)x = w;
    }
};
struct EpiRouter {
    struct Ctx { f32x4 b0, b1; };
    float* L; const float* bias;
    __device__ __forceinline__ void begin(Ctx& c, const pg8::Unit&, int, int lcol0) const { const int lc = lcol0 < 32 ? lcol0 : 0; c.b0 = *(const f32x4*)(bias + lc); c.b1 = *(const f32x4*)(bias + lc + 4); }
    __device__ __forceinline__ void begin_half(Ctx&, const pg8::Unit&, int, int, int) const {}
    __device__ __forceinline__ void row8(const Ctx& c, const pg8::Unit& u, int, int, int lrow, int lcol, f32x4 v0, f32x4 v1) const {
        if (lcol >= 32) return;
        float* o = L + (size_t)(u.pm * 256 + lrow) * 32 + lcol;
        *(f32x4*)o = v0 + c.b0; *(f32x4*)(o + 4) = v1 + c.b1;
    }
};
struct MoeCtx { int orow[8]; f32x4 b[2][2]; };
__device__ __forceinline__ void moe_begin(MoeCtx& c, const pg8::Unit& u, int lrow0, int lcol0, const float* bias_e) {
#pragma unroll
    for (int s = 0; s < 8; ++s) { const int lr = lrow0 + (s >> 2) * 128 + (s & 3) * 16; c.orow[s] = (lr < u.nrows) ? u.ridx[lr] : -1; }
    const float* bb = bias_e + u.pn * 256 + lcol0;
#pragma unroll
    for (int bj = 0; bj < 2; ++bj) { c.b[bj][0] = *(const f32x4*)(bb + bj * 128); c.b[bj][1] = *(const f32x4*)(bb + bj * 128 + 4); }
}
__device__ __forceinline__ void moe_begin_pre(MoeCtx& c, const pg8::Unit& u, int lrow0, int lcol0, const LAS unsigned char* tab) {
#pragma unroll
    for (int s = 0; s < 8; ++s) { const int lr = lrow0 + (s >> 2) * 128 + (s & 3) * 16; const int v = ((const LAS int*)tab)[lr]; c.orow[s] = (lr < u.nrows) ? v : -1; }
    const LAS float* bb = (const LAS float*)(tab + 1024) + lcol0;
#pragma unroll
    for (int bj = 0; bj < 2; ++bj) { c.b[bj][0] = *(const LAS f32x4*)(bb + bj * 128); c.b[bj][1] = *(const LAS f32x4*)(bb + bj * 128 + 4); }
}
struct EpiSwiglu {
    typedef MoeCtx Ctx;
    bf16_t* ACT; const float* b1;
    __device__ __forceinline__ void begin(Ctx& c, const pg8::Unit& u, int lrow0, int lcol0) const { moe_begin(c, u, lrow0, lcol0, b1 + (size_t)u.e * 2048); }
    __device__ __forceinline__ const float* bias_of(const pg8::Unit& u) const { return b1 + (size_t)u.e * 2048 + u.pn * 256; }
    __device__ __forceinline__ void begin_pre(Ctx& c, const pg8::Unit& u, int lrow0, int lcol0, const LAS unsigned char* tab) const { moe_begin_pre(c, u, lrow0, lcol0, tab); }
    __device__ __forceinline__ void begin_half(Ctx&, const pg8::Unit&, int, int, int) const {}
    __device__ __forceinline__ void row8(const Ctx& c, const pg8::Unit& u, int slot, int bj, int, int lcol, f32x4 v0, f32x4 v1) const {
        const int orow = c.orow[slot]; if (orow < 0) return;
        const int col = u.pn * 256 + lcol;
        v0 = v0 + c.b[bj][0]; v1 = v1 + c.b[bj][1];
        float o[4];
#pragma unroll
        for (int p = 0; p < 4; ++p) {
            float g = (p < 2) ? v0[2 * p] : v1[2 * (p - 2)], l = (p < 2) ? v0[2 * p + 1] : v1[2 * (p - 2) + 1];
            g = fminf(g, 7.f); l = fminf(fmaxf(l, -7.f), 7.f);
            o[p] = g * sigmoidf_(1.702f * g) * (l + 1.f);
        }
        v2u w; w.x = pk2(o[0], o[1]); w.y = pk2(o[2], o[3]);
        *(v2u*)(ACT + (size_t)orow * FF + (col >> 1)) = w;
    }
};
struct EpiMoeDown {
    typedef MoeCtx Ctx;
    bf16_t* Y; const float* b2;
    __device__ __forceinline__ void begin(Ctx& c, const pg8::Unit& u, int lrow0, int lcol0) const { moe_begin(c, u, lrow0, lcol0, b2 + (size_t)u.e * 1024); }
    __device__ __forceinline__ const float* bias_of(const pg8::Unit& u) const { return b2 + (size_t)u.e * 1024 + u.pn * 256; }
    __device__ __forceinline__ void begin_pre(Ctx& c, const pg8::Unit& u, int lrow0, int lcol0, const LAS unsigned char* tab) const { moe_begin_pre(c, u, lrow0, lcol0, tab); }
    __device__ __forceinline__ void begin_half(Ctx&, const pg8::Unit&, int, int, int) const {}
    __device__ __forceinline__ void row8(const Ctx& c, const pg8::Unit& u, int slot, int bj, int, int lcol, f32x4 v0, f32x4 v1) const {
        const int orow = c.orow[slot]; if (orow < 0) return;
        *(v4u*)(Y + (size_t)orow * D + u.pn * 256 + lcol) = pack8(v0 + c.b[bj][0], v1 + c.b[bj][1]);
    }
};

__device__ __forceinline__ void rope_pair(float& v, int lane, int half  , float cs, float sn) {
    const unsigned x_ = __builtin_bit_cast(unsigned, v);
    float p;
    if (half == 16) { const auto r_ = __builtin_amdgcn_permlane16_swap(x_, x_, false, false); p = __builtin_bit_cast(float, (unsigned)((lane & 16) ? r_[0] : r_[1])); }
    else { const auto r_ = __builtin_amdgcn_permlane32_swap(x_, x_, false, false); p = __builtin_bit_cast(float, (unsigned)((lane & 32) ? r_[0] : r_[1])); }
    v = ((lane & half) == 0) ? (v * cs - p * sn) : (v * cs + p * sn);
}
__device__ __forceinline__ void pA2_proj_norms(Frame& F, const Args& args, int e) {
    const float* q_norm = INP(I_MLA_Q_NORM) + e * 384; const float* kv_norm = INP(I_MLA_KV_NORM) + e * 256; const float* kr_g = INP(I_MLA_KR_G) + e * 64;
    const float* gq_g = INP(I_GQA_Q_G) + e * 128; const float* gk_g = INP(I_GQA_K_G) + e * 128;
    const int lane = F.lane;
    float gqn[6], gkvn[4];
#pragma unroll
    for (int g = 0; g < 6; ++g) gqn[g] = q_norm[64 * g + lane];
#pragma unroll
    for (int g = 0; g < 4; ++g) gkvn[g] = kv_norm[64 * g + lane];
    const float gkr = kr_g[lane], gq0 = gq_g[lane], gq1 = gq_g[64 + lane], gk0 = gk_g[lane], gk1 = gk_g[64 + lane];
    const float LOG2_THETA = 13.287712379549449f;
    const float ifm = __builtin_amdgcn_exp2f(-(float)(2 * (lane & 15)) * (1.f / 32.f) * LOG2_THETA);
    const float ifg = __builtin_amdgcn_exp2f(-(float)(2 * (lane & 31)) * (1.f / 64.f) * LOG2_THETA);
    unsigned short raw[23];
#define A2_LOAD(r_) do { const bf16_t* p_ = WSP(const bf16_t, WS_PROJ) + (size_t)(r_) * PROJ_LD; _Pragma("unroll") for (int g = 0; g < 23; ++g) raw[g] = __builtin_nontemporal_load(&p_[64 * g + lane]); } while (0)
    if (F.gw < M) A2_LOAD(F.gw);
    for (int r = F.gw; r < M; r += F.NGW) {
        int b, j; row_bj(r, b, j);
        bf16_t* p = WSP(bf16_t, WS_PROJ) + (size_t)r * PROJ_LD;
        float v[23];
#pragma unroll
        for (int g = 0; g < 23; ++g) v[g] = bf2f(raw[g]);
        if (r + F.NGW < M) A2_LOAD(r + F.NGW);
        const bool lat = j >= CTXL; const int t = j - CTXL; const float prow = (float)(t >> 6), pcol = (float)(t & 63);
        { float ss = 0.f;
#pragma unroll
          for (int g = 0; g < 6; ++g) ss += v[g] * v[g];
          const float rs = rsqrtf(wave_sum(ss) * (1.f / 384.f) + NORM_EPS);
#pragma unroll
          for (int g = 0; g < 6; ++g) v[g] = v[g] * rs * gqn[g]; }
        { float ss = 0.f;
#pragma unroll
          for (int g = 0; g < 4; ++g) ss += v[6 + g] * v[6 + g];
          const float rs = rsqrtf(wave_sum(ss) * (1.f / 256.f) + NORM_EPS);
#pragma unroll
          for (int g = 0; g < 4; ++g) v[6 + g] = v[6 + g] * rs * gkvn[g]; }
        { const float rs = rsqrtf(wave_sum(v[10] * v[10]) * (1.f / 64.f) + NORM_EPS); v[10] = v[10] * rs * gkr;
          if (lat) { const float ang = ((lane < 32) ? prow : pcol) * ifm; rope_pair(v[10], lane, 16, __cosf(ang), __sinf(ang)); } }
        float c0 = 1.f, s0 = 0.f, c1 = 1.f, s1 = 0.f;
        if (lat) { const float a0 = prow * ifg, a1 = pcol * ifg; c0 = __cosf(a0); s0 = __sinf(a0); c1 = __cosf(a1); s1 = __sinf(a1); }
#pragma unroll
        for (int h = 0; h < 6; ++h) {
            const int g0 = 11 + 2 * h; const float w0 = (h < 4) ? gq0 : gk0, w1 = (h < 4) ? gq1 : gk1;
            const float rs = rsqrtf(wave_sum(v[g0] * v[g0] + v[g0 + 1] * v[g0 + 1]) * (1.f / 128.f) + NORM_EPS);
            v[g0] = v[g0] * rs * w0; v[g0 + 1] = v[g0 + 1] * rs * w1;
            if (lat) { rope_pair(v[g0], lane, 32, c0, s0); rope_pair(v[g0 + 1], lane, 32, c1, s1); }
        }
#pragma unroll
        for (int g = 0; g < 23; ++g) p[64 * g + lane] = (bf16_t)f2bf(v[g]);
    }
#undef A2_LOAD
}
__device__ __forceinline__ void pA4_mla_norms(Frame& F, const Args& args, int e) {
    const float* qn_g = INP(I_MLA_QN_G) + e * 128; const float* qr_g = INP(I_MLA_QR_G) + e * 64; const float* kn_g = INP(I_MLA_KN_G) + e * 128;
    const int lane = F.lane;
    const float qn0 = qn_g[lane], qn1 = qn_g[64 + lane], qr = qr_g[lane], kn0 = kn_g[lane], kn1 = kn_g[64 + lane];
    const float LOG2_THETA = 13.287712379549449f;
    const float ifm = __builtin_amdgcn_exp2f(-(float)(2 * (lane & 15)) * (1.f / 32.f) * LOG2_THETA);
    unsigned short rq[12], rk[8];
#define A4_LOAD(r_) do { const bf16_t* q_ = WSP(const bf16_t, WS_QM) + (size_t)(r_) * 768; const bf16_t* kv_ = WSP(const bf16_t, WS_KVM) + (size_t)(r_) * 1024; \
        _Pragma("unroll") for (int g = 0; g < 12; ++g) rq[g] = __builtin_nontemporal_load(&q_[64 * g + lane]); _Pragma("unroll") for (int h = 0; h < 4; ++h) { rk[2 * h] = __builtin_nontemporal_load(&kv_[256 * h + lane]); rk[2 * h + 1] = __builtin_nontemporal_load(&kv_[256 * h + 64 + lane]); } } while (0)
    if (F.gw < M) A4_LOAD(F.gw);
    for (int r = F.gw; r < M; r += F.NGW) {
        int b, j; row_bj(r, b, j);
        const bool lat = j >= CTXL; const int t = j - CTXL;
        float cs = 1.f, sn = 0.f;
        if (lat) { const float ang = ((lane < 32) ? (float)(t >> 6) : (float)(t & 63)) * ifm; cs = __cosf(ang); sn = __sinf(ang); }
        bf16_t* q = WSP(bf16_t, WS_QM) + (size_t)r * 768;
        bf16_t* kv = WSP(bf16_t, WS_KVM) + (size_t)r * 1024;
        float vq[12], vk[8];
#pragma unroll
        for (int g = 0; g < 12; ++g) vq[g] = bf2f(rq[g]);
#pragma unroll
        for (int h = 0; h < 8; ++h) vk[h] = bf2f(rk[h]);
        if (r + F.NGW < M) A4_LOAD(r + F.NGW);
#pragma unroll
        for (int h = 0; h < 4; ++h) {
            float rs = rsqrtf(wave_sum(vq[3 * h] * vq[3 * h] + vq[3 * h + 1] * vq[3 * h + 1]) * (1.f / 128.f) + NORM_EPS);
            vq[3 * h] = vq[3 * h] * rs * qn0; vq[3 * h + 1] = vq[3 * h + 1] * rs * qn1;
            rs = rsqrtf(wave_sum(vq[3 * h + 2] * vq[3 * h + 2]) * (1.f / 64.f) + NORM_EPS);
            vq[3 * h + 2] = vq[3 * h + 2] * rs * qr;
            if (lat) rope_pair(vq[3 * h + 2], lane, 16, cs, sn);
            rs = rsqrtf(wave_sum(vk[2 * h] * vk[2 * h] + vk[2 * h + 1] * vk[2 * h + 1]) * (1.f / 128.f) + NORM_EPS);
            vk[2 * h] = vk[2 * h] * rs * kn0; vk[2 * h + 1] = vk[2 * h + 1] * rs * kn1;
        }
#pragma unroll
        for (int g = 0; g < 12; ++g) q[64 * g + lane] = (bf16_t)f2bf(vq[g]);
#pragma unroll
        for (int h = 0; h < 4; ++h) { kv[256 * h + lane] = (bf16_t)f2bf(vk[2 * h]); kv[256 * h + 64 + lane] = (bf16_t)f2bf(vk[2 * h + 1]); }
    }
#undef A4_LOAD
}
template <bool MLA>
__device__ __forceinline__ void attn_one(Frame& F, int b, int h, int qb) {
    static_assert(att::ATTN_LDS <= RING_BYTES, "attention LDS");
    char* lds = (char*)(F.lds + RING_OFF);
    const bf16_t* PROJ = WSP(const bf16_t, WS_PROJ); bf16_t* OB = WSP(bf16_t, WS_OB);
    const size_t row0 = (size_t)b * TPB + (size_t)qb * 256, krow0 = (size_t)b * TPB; const int seq = qb ? TPB : CTXL;
    if constexpr (MLA) { const bf16_t* QM = WSP(const bf16_t, WS_QM); const bf16_t* KVM = WSP(const bf16_t, WS_KVM);
        att::attn_unit<192, 1, 8, 768, 1024, PROJ_LD, 1024, D>(QM + row0 * 768 + 192 * h, KVM + krow0 * 1024 + 256 * h, PROJ + krow0 * PROJ_LD + C_ZR,
                                          KVM + krow0 * 1024 + 256 * h + 128, OB + row0 * D + 128 * h, seq, lds, F.wave);
    } else { const int g = h - 4, kvh = g >> 1;
        att::attn_unit<128, 1, 8, PROJ_LD, PROJ_LD, PROJ_LD, PROJ_LD, D>(PROJ + row0 * PROJ_LD + C_GQ + 128 * g, PROJ + krow0 * PROJ_LD + C_GK + 128 * kvh, nullptr,
                                      PROJ + krow0 * PROJ_LD + C_GV + 128 * kvh, OB + row0 * D + 512 + 128 * g, seq, lds, F.wave); }
}
__device__ __forceinline__ void moe_convert_share(Frame& F, bool doit) {
    if (!doit) return;
    p0_transposes_fast(F, 0, 2, F.gw, F.NGW);
    __syncthreads();
}
template <bool MLA>
__device__ __forceinline__ void pA5_attention_half(Frame& F, int conv_phase  ) {
    const int x = F.bid & 7, lc = F.bid >> 3;
    const int nunits = NB * 4 * 17, niter = (F.G == 256) ? 3 : (nunits + F.G - 1) / F.G;
#pragma unroll 1
    for (int i = 0; i < niter; ++i) {
        if (i < 2) moe_convert_share(F, conv_phase == (MLA ? 0 : 3) + i);
        int b, h, qb;
        if (F.G == 256) { b = x; if (i < 2) { h = 2 * i + (lc >> 4); qb = 1 + (lc & 15); } else { if (lc >= 4) break; h = lc; qb = 0; } }
        else { const int u = i * F.G + F.bid; if (u >= nunits) break; b = u / (4 * 17); h = (u / 17) % 4; qb = u % 17; }
        attn_one<MLA>(F, b, (MLA ? 0 : 4) + h, qb);
    }
}
__device__ __forceinline__ void pA5_attention(Frame& F, bool convert) {
    const int cp = convert ? (F.bid % 5) : -1;
    pA5_attention_half<true>(F, cp); moe_convert_share(F, cp == 2); pA5_attention_half<false>(F, cp);
#ifdef MK_PROBE_REP_MLA
    pA5_attention_half<true>(F, -1);
#endif
#ifdef MK_PROBE_REP_GQA
    pA5_attention_half<false>(F, -1);
#endif
}
__device__ __forceinline__ void pF1_ffn_norm(Frame& F, const Args& args, int layer) {
    const float* gain = INP(I_NORM_FFN) + layer * D;
    for (int r = F.gw; r < M; r += F.NGW) {
        int b, j; row_bj(r, b, j); const int mrow = (j < CTXL) ? 8 : b;
        f32x4 v[4]; ld_row_bf16(WSP(const bf16_t, WS_XR) + (size_t)r * D, F.lane, v);
        rms_mod(v, F.lane, gain, mod_ptr(F, layer, mrow, 3), mod_ptr(F, layer, mrow, 4));
        st_row_bf16(WSP(bf16_t, WS_HB) + (size_t)r * D, F.lane, v);
    }
}
__device__ __forceinline__ void route_lane_tokens(Frame& F, int layer, int r, bool valid, const float (&l)[32]);
__device__ __forceinline__ void pF1R_norm_router(Frame& F, const Args& args, int layer) {
    constexpr int RP = 2048 + 16;
    const LAS unsigned char* WR = F.lds + RING_OFF;
    LAS unsigned char* SL = F.lds + RING_OFF + 32 * RP + F.wave * (4 * RP);
    constexpr int RPW = 17;
    LAS float* LT = (LAS float*)(F.lds + RING_OFF + 32 * RP + NWAVES * 4 * RP);
    static_assert(32 * RP + NWAVES * 4 * RP + NWAVES * RPW * 32 * 4 <= RING_BYTES, "F1R LDS");
    const bool fused = (F.G * NWAVES * RPW >= M);
    { const bf16_t* wr = (const bf16_t*)(F.ws + WS_SMALLW + SW_RT + (size_t)layer * RT_BYTES);
      __syncthreads();
      for (int i = F.tid; i < 32 * 128; i += NTHREADS) { const int row = i >> 7, ch = i & 127; *(LAS v4u*)((LAS unsigned char*)WR + row * RP + ch * 16) = *(const v4u*)(wr + (size_t)row * 1024 + ch * 8); }
      __syncthreads(); }
    const float* gain = INP(I_NORM_FFN) + layer * D; const float* rb = INP(I_MOE_ROUTER_B) + layer * 32; float* LG = WSP(float, WS_LOGITS);
    const int lane = F.lane, l15 = lane & 15, g = lane >> 4;
    const float rb0 = rb[l15], rb1 = rb[16 + l15];
    int grp = 0;
    v2u raw[4][4];
#define F1R_LOAD(rb_) do { _Pragma("unroll") for (int i = 0; i < 4; ++i) { const int r = (rb_) + i * F.NGW; if (r < M) { _Pragma("unroll") for (int q = 0; q < 4; ++q) raw[i][q] = __builtin_nontemporal_load(&((const v2u*)(WSP(const bf16_t, WS_XR) + (size_t)r * D))[lane + 64 * q]); } } } while (0)
    F1R_LOAD(F.gw);
    for (int r0 = F.gw; r0 < M; r0 += 4 * F.NGW, ++grp) {
        f32x4 v[4][4];
#pragma unroll
        for (int i = 0; i < 4; ++i)
#pragma unroll
            for (int q = 0; q < 4; ++q) v[i][q] = (f32x4){bflo(raw[i][q].x), bfhi(raw[i][q].x), bflo(raw[i][q].y), bfhi(raw[i][q].y)};
#pragma unroll
        for (int i = 0; i < 4; ++i) { const int r = r0 + i * F.NGW; if (r < M) {
            int b, j; row_bj(r, b, j); const int mrow = (j < CTXL) ? 8 : b;
            rms_mod(v[i], lane, gain, mod_ptr(F, layer, mrow, 3), mod_ptr(F, layer, mrow, 4));
#pragma unroll
            for (int q = 0; q < 4; ++q) { v2u w; w.x = pk2(v[i][q].x, v[i][q].y); w.y = pk2(v[i][q].z, v[i][q].w);
                ((v2u*)(WSP(bf16_t, WS_HB) + (size_t)r * D))[lane + 64 * q] = w; *(LAS v2u*)(SL + i * RP + (lane + 64 * q) * 8) = w; } } }
        if (r0 + 4 * F.NGW < M) F1R_LOAD(r0 + 4 * F.NGW);
        f32x4 acc0 = (f32x4){0.f, 0.f, 0.f, 0.f}, acc1 = acc0;
        const LAS unsigned char* ap = SL + (l15 & 3) * RP + g * 16; const LAS unsigned char* bp = WR + l15 * RP + g * 16;
#pragma unroll 8
        for (int s2 = 0; s2 < 32; ++s2) { const bf16x8 a = *(const LAS bf16x8*)(ap + s2 * 64), b0 = *(const LAS bf16x8*)(bp + s2 * 64), b1 = *(const LAS bf16x8*)(bp + 16 * RP + s2 * 64);
            acc0 = __builtin_amdgcn_mfma_f32_16x16x32_bf16(a, b0, acc0, 0, 0, 0); acc1 = __builtin_amdgcn_mfma_f32_16x16x32_bf16(a, b1, acc1, 0, 0, 0); }
        if (g == 0) {
#pragma unroll
            for (int i = 0; i < 4; ++i) { const int r = r0 + i * F.NGW; if (r < M) {
                if (fused) { LAS float* lt = LT + (F.wave * RPW + grp * 4 + i) * 32; lt[l15] = acc0[i] + rb0; lt[16 + l15] = acc1[i] + rb1; }
                else { LG[(size_t)r * 32 + l15] = acc0[i] + rb0; LG[(size_t)r * 32 + 16 + l15] = acc1[i] + rb1; } } } }
    }
#undef F1R_LOAD
    if (fused) {
        __syncthreads();
        if (F.wave < (NWAVES * RPW + 63) / 64) {
            const int t = F.wave * 64 + lane, w = t / RPW, idx = t - w * RPW, r = F.bid * NWAVES + w + idx * F.NGW;
            bool valid = (t < NWAVES * RPW) && (r < M);
            if (valid) { int b, j; row_bj(r, b, j); valid = !((layer == DEPTH - 1) && j < CTXL); }
            const LAS float* lt = LT + ((t < NWAVES * RPW) ? t : 0) * 32;
            float l[32];
#pragma unroll
            for (int q = 0; q < 8; ++q) { const f32x4 x = ((const LAS f32x4*)lt)[q]; l[4 * q] = x[0]; l[4 * q + 1] = x[1]; l[4 * q + 2] = x[2]; l[4 * q + 3] = x[3]; }
            route_lane_tokens(F, layer, r, valid, l);
        }
    }
}
__device__ __forceinline__ void route_lane_tokens(Frame& F, int layer, int r, bool valid, const float (&l)[32]) {
    float* TG = WSP(float, WS_TOPG); int* RI = WSP(int, WS_ROWIDX);
    unsigned* cnt = (unsigned*)(F.ctl + CW_ECNT + layer * 32 * 64);
    const int lane = F.lane;
    int sel[4]; float val[4]; unsigned used = 0u;
#pragma unroll
    for (int k = 0; k < 4; ++k) { float best = -3.0e38f; int bi = 0;
#pragma unroll
        for (int e = 0; e < 32; ++e) { const bool ok = !((used >> e) & 1u) && (l[e] > best); best = ok ? l[e] : best; bi = ok ? e : bi; }
        sel[k] = bi; val[k] = best; used |= 1u << bi; }
    float p[4], ps = 0.f;
#pragma unroll
    for (int k = 0; k < 4; ++k) { p[k] = __expf(val[k] - val[0]); ps += p[k]; }
    const float inv = 1.f / ps;
    int pre[4] = {0, 0, 0, 0}; unsigned mycnt = 0u;
    const unsigned long long below = (lane == 0) ? 0ull : (~0ull >> (64 - lane));
#pragma unroll
    for (int e = 0; e < 32; ++e) {
        const bool has = valid && ((used >> e) & 1u);
        const unsigned long long m = __ballot(has);
        const int c = __popcll(m), pf = __popcll(m & below);
        if (lane == e) mycnt = (unsigned)c;
#pragma unroll
        for (int k = 0; k < 4; ++k) if (sel[k] == e) pre[k] = pf;
    }
    unsigned base = 0u;
    if (lane < 32 && mycnt) base = __hip_atomic_fetch_add(cnt + lane * 64, mycnt, RLX_AGENT);
    unsigned be[4];
#pragma unroll
    for (int k = 0; k < 4; ++k) be[k] = (unsigned)lanes_get((int)base, sel[k]);
    if (valid) {
#pragma unroll
        for (int k = 0; k < 4; ++k) RI[(size_t)sel[k] * CAP + be[k] + pre[k]] = r * 4 + k;
        *(f32x4*)(TG + (size_t)r * 4) = (f32x4){p[0] * inv, p[1] * inv, p[2] * inv, p[3] * inv};
    }
}
__device__ __forceinline__ void pF3_route(Frame& F, int layer) {
    const float* LG = WSP(const float, WS_LOGITS);
    const int lane = F.lane; const bool lastl = (layer == DEPTH - 1);
    for (int t0 = F.gw * 64; t0 < M; t0 += F.NGW * 64) {
        const int r = t0 + lane; int b, j; row_bj(r, b, j);
        const bool valid = !(lastl && j < CTXL);
        float l[32];
#pragma unroll
        for (int q = 0; q < 8; ++q) { const f32x4 x = ((const f32x4*)(LG + (size_t)r * 32))[q]; l[4 * q] = x[0]; l[4 * q + 1] = x[1]; l[4 * q + 2] = x[2]; l[4 * q + 3] = x[3]; }
        route_lane_tokens(F, layer, r, valid, l);
    }
}
template <int NPN, int GM, int GSH>
struct MoeOrder {
    const LAS int* tb;
    const char* A; const char* W; const int* RI; int G, c, nwg;
    __device__ __forceinline__ bool next(int i, pg8::Unit& u) const {
        const long L = (long)i * G + c;
        int wgid = (int)L;
        if ((G & 7) == 0) {
            const int ng = nwg / (GM * NPN), qg = ng / 8, rg = ng % 8, xcd = wgid % 8, off = wgid / 8;
            const int ngx = qg + (xcd < rg ? 1 : 0), gs = (xcd < rg) ? xcd * (qg + 1) : rg * (qg + 1) + (xcd - rg) * qg;
            if (off >= ngx * (GM * NPN)) return false;
            wgid = gs * (GM * NPN) + off;
        } else {
            if (L >= nwg) return false;
            const int q = nwg / 8, r = nwg % 8, xcd = wgid % 8, off = wgid / 8; wgid = (xcd < r ? xcd * (q + 1) : r * (q + 1) + (xcd - r) * q) + off;
        }
        const int grp = wgid / (GM * NPN), l = wgid % (GM * NPN), mt = grp * GM + (l % GM), pn = l / GM;
        const int ln = lane_now() & 31;
        const int e = __popcll(__ballot(mt >= tb[ln]) & 0xffffffffull) - 1;
        const int total = tb[32];
        const int lt = mt - tb[e], cnt = tb[33 + e];
        u.A = A; u.B = W + ((size_t)e * NPN * 256 + (size_t)pn * 256) * 1024 * 2; u.lda = 2048; u.K = 1024; u.pm = mt; u.pn = pn; u.kind = 0; u.e = e;
        int nr = (mt < total) ? cnt - lt * 256 : 0; nr = nr > 256 ? 256 : nr; u.nrows = nr;
        u.ridx = RI + (size_t)e * CAP + (size_t)lt * 256;
        return true;
    }
};
__device__ __forceinline__ int moe_table(Frame& F, int layer) {
    int z = 0; asm volatile("" : "+s"(z));
    LAS int* tb = (LAS int*)(F.lds + LDSCTL_OFF + z);
    __syncthreads();
    if (F.wave == 0) {
        const int e = F.lane & 31;
        const int c = (int)__hip_atomic_load((unsigned*)(F.ctl + CW_ECNT + (layer * 32 + e) * 64), RLX_AGENT);
        const int t = (c + 255) >> 8; int incl = t;
#pragma unroll
        for (int o = 1; o < 32; o <<= 1) { const int v = lanes_get(incl, (lane_now() - o) & 63); if (e >= o) incl += v; }
        if (F.lane < 32) { tb[e] = incl - t; tb[33 + e] = c; if (e == 31) tb[32] = incl; }
    }
    __syncthreads();
    return tb[32];
}
__device__ __forceinline__ void pF6_combine(Frame& F, const Args& args, int layer) {
    const bool lastl = (layer == DEPTH - 1);
    const bf16_t* Y = WSP(const bf16_t, WS_YB); const float* TG = WSP(const float, WS_TOPG);
    v2u rx[4], ry[4][4]; f32x4 rg;
#define F6_LOAD(r_) do { _Pragma("unroll") for (int q = 0; q < 4; ++q) rx[q] = ((const v2u*)(WSP(const bf16_t, WS_XR) + (size_t)(r_) * D))[F.lane + 64 * q]; rg = *(const f32x4*)(TG + (size_t)(r_) * 4);     \
        _Pragma("unroll") for (int k = 0; k < 4; ++k) _Pragma("unroll") for (int q = 0; q < 4; ++q) ry[k][q] = __builtin_nontemporal_load(&((const v2u*)(Y + ((size_t)(r_) * 4 + k) * D))[F.lane + 64 * q]); } while (0)
    if (F.gw < M) F6_LOAD(F.gw);
    for (int r = F.gw; r < M; r += F.NGW) {
        int b, j; row_bj(r, b, j);
        const int mrow = (j < CTXL) ? 8 : b;
        f32x4 x[4], acc[4]; const f32x4 g = rg;
#pragma unroll
        for (int q = 0; q < 4; ++q) { x[q] = (f32x4){bflo(rx[q].x), bfhi(rx[q].x), bflo(rx[q].y), bfhi(rx[q].y)}; acc[q] = (f32x4){0.f, 0.f, 0.f, 0.f}; }
#pragma unroll
        for (int k = 0; k < 4; ++k)
#pragma unroll
            for (int q = 0; q < 4; ++q) acc[q] = acc[q] + (f32x4){bflo(ry[k][q].x), bfhi(ry[k][q].x), bflo(ry[k][q].y), bfhi(ry[k][q].y)} * g[k];
        if (r + F.NGW < M) F6_LOAD(r + F.NGW);
        if (lastl && j < CTXL) continue;
        const float* m5 = mod_ptr(F, layer, mrow, 5);
#pragma unroll
        for (int q = 0; q < 4; ++q) x[q] = x[q] + ((const f32x4*)m5)[F.lane + 64 * q] * acc[q];
        if (lastl) { st_row_f32(((float*)INP(N_IN)) + ((size_t)b * SEQ + (j - CTXL)) * D, F.lane, x); continue; }
        st_row_bf16(WSP(bf16_t, WS_XR) + (size_t)r * D, F.lane, x);
        rms_mod(x, F.lane, INP(I_NORM_MIX) + (layer + 1) * D, mod_ptr(F, layer + 1, mrow, 0), mod_ptr(F, layer + 1, mrow, 1));
        st_row_bf16(WSP(bf16_t, WS_HB) + (size_t)r * D, F.lane, x);
    }
#undef F6_LOAD
}
__device__ __forceinline__ void pR1_mix(Frame& F, int jj) {
    const float* mix = INP(I_RWKV_MIX) + (size_t)jj * 6 * D;
    const bf16_t* HB = WSP(const bf16_t, WS_HB);
    v2u rh[4], rp[4], rn[4];
#define R1_LOAD(r_) do { int b_, j_; row_bj((r_), b_, j_); const bool hp_ = (j_ != 0) && (j_ != CTXL), hn_ = (j_ != CTXL - 1) && (j_ != TPB - 1); \
        _Pragma("unroll") for (int q = 0; q < 4; ++q) { rh[q] = ((const v2u*)(HB + (size_t)(r_) * D))[F.lane + 64 * q]; \
            rp[q] = hp_ ? ((const v2u*)(HB + (size_t)((r_) - 1) * D))[F.lane + 64 * q] : (v2u){0u, 0u}; rn[q] = hn_ ? ((const v2u*)(HB + (size_t)((r_) + 1) * D))[F.lane + 64 * q] : (v2u){0u, 0u}; } } while (0)
#define R1_UNP(w_) ((f32x4){bflo((w_).x), bfhi((w_).x), bflo((w_).y), bfhi((w_).y)})
    if (F.gw < M) R1_LOAD(F.gw);
    for (int r = F.gw; r < M; r += F.NGW) {
        f32x4 h[4], xx[4];
#pragma unroll
        for (int q = 0; q < 4; ++q) { h[q] = R1_UNP(rh[q]); xx[q] = (R1_UNP(rp[q]) + R1_UNP(rn[q])) * 0.5f - h[q]; }
        if (r + F.NGW < M) R1_LOAD(r + F.NGW);
#pragma unroll
        for (int m = 0; m < 6; ++m) {
            f32x4 o[4];
#pragma unroll
            for (int q = 0; q < 4; ++q) o[q] = h[q] + xx[q] * ((const f32x4*)(mix + m * D))[F.lane + 64 * q];
            st_row_bf16(WSP(bf16_t, WS_XMIX) + ((size_t)m * M + r) * D, F.lane, o);
        }
    }
#undef R1_LOAD
#undef R1_UNP
}
#ifndef MK_SCAN_SEQ
#define MK_SCAN_SEQ 0
#endif
#if MK_SCAN_SEQ
#define SC_DECAY(z) __expf(-0.6065306597126334f * sigmoidf_(z))
#else
#define SC_DECAY(z) (-0.6065306597126334f * sigmoidf_(z))
#endif
struct EpiR2 {
    typedef NoCtx Ctx;
    bf16_t* dst[7];
    __device__ __forceinline__ void begin(Ctx&, const pg8::Unit&, int, int) const {}
    __device__ __forceinline__ void begin_half(Ctx&, const pg8::Unit&, int, int, int) const {}
    __device__ __forceinline__ void row8(const Ctx&, const pg8::Unit& u, int, int, int lrow, int lcol, f32x4 v0, f32x4 v1) const {
        const int row = u.pm * 256 + lrow;
        if (u.kind < 3) { bf16_t* O = (u.kind == 0) ? dst[0] : (u.kind == 1) ? dst[1] : dst[2]; *(v4u*)(O + (size_t)row * D + u.pn * 256 + lcol) = pack8(v0, v1); return; }
        if (lcol >= 128) return;
        bf16_t* O = (u.kind == 3) ? dst[3] : (u.kind == 4) ? dst[4] : (u.kind == 5) ? dst[5] : dst[6];
        if (u.kind == 3) {
#pragma unroll
            for (int q = 0; q < 4; ++q) { v0[q] = 1.f - 2.f * __builtin_amdgcn_rcpf(1.f + __expf(2.f * v0[q])); v1[q] = 1.f - 2.f * __builtin_amdgcn_rcpf(1.f + __expf(2.f * v1[q])); } }
        else if (u.kind == 5) {
#pragma unroll
            for (int q = 0; q < 4; ++q) { v0[q] = sigmoidf_(v0[q]); v1[q] = sigmoidf_(v1[q]); } }
        *(v4u*)(O + (size_t)row * 128 + lcol) = pack8(v0, v1);
    }
};
struct EpiR3 {
    struct Ctx { f32x4 b00, b01, b10, b11; };
    bf16_t* WDEC; bf16_t* AD; bf16_t* GB; bf16_t* VGT; const float* w0; const float* a0; const float* v0b;
    __device__ __forceinline__ void begin(Ctx& c, const pg8::Unit& u, int, int lcol0) const {
        const float* p0 = w0; const float* p1 = a0; const float* p2 = v0b; asm volatile("" : "+s"(p0), "+s"(p1), "+s"(p2));
        const float* bp = (u.kind == 0) ? p0 : (u.kind == 1) ? p1 : p2; const int col = u.pn * 256 + lcol0;
        const float* bb = bp + ((u.kind == 2) ? 0 : col);
        c.b00 = *(const f32x4*)(bb); c.b01 = *(const f32x4*)(bb + 4); c.b10 = *(const f32x4*)(bb + 128); c.b11 = *(const f32x4*)(bb + 132);
    }
    static constexpr bool HAS_TAB = true;
    __device__ __forceinline__ const float* bias_of(const pg8::Unit& u) const {
        const float* p0 = w0; const float* p1 = a0; const float* p2 = v0b; asm volatile("" : "+s"(p0), "+s"(p1), "+s"(p2));
        const float* bp = (u.kind == 0) ? p0 : (u.kind == 1) ? p1 : p2; return bp + ((u.kind == 2) ? 0 : u.pn * 256); }
    __device__ __forceinline__ void begin_pre(Ctx& c, const pg8::Unit&, int, int lcol0, const LAS unsigned char* tab) const {
        const LAS float* bb = (const LAS float*)(tab + 1024) + lcol0;
        c.b00 = *(const LAS f32x4*)(bb); c.b01 = *(const LAS f32x4*)(bb + 4); c.b10 = *(const LAS f32x4*)(bb + 128); c.b11 = *(const LAS f32x4*)(bb + 132); }
    __device__ __forceinline__ void begin_half(Ctx&, const pg8::Unit&, int, int, int) const {}
    __device__ __forceinline__ void row8(const Ctx& c, const pg8::Unit& u, int, int bj, int lrow, int lcol, f32x4 v0, f32x4 v1) const {
        const int row = u.pm * 256 + lrow, col = u.pn * 256 + lcol;
        const f32x4 cb0 = bj ? c.b10 : c.b00, cb1 = bj ? c.b11 : c.b01;
        if (u.kind == 0) {
            bf16_t* o = WDEC + ((size_t)(col >> 10) * M + row) * D + (col & 1023);
            f32x4 z0 = v0 + cb0, z1 = v1 + cb1;
#pragma unroll
            for (int q = 0; q < 4; ++q) { z0[q] = SC_DECAY(z0[q]); z1[q] = SC_DECAY(z1[q]); }
            *(v4u*)o = pack8(z0, z1);
        } else if (u.kind == 1) {
            f32x4 z0 = v0 + cb0, z1 = v1 + cb1;
#pragma unroll
            for (int q = 0; q < 4; ++q) { z0[q] = sigmoidf_(z0[q]); z1[q] = sigmoidf_(z1[q]); }
            *(v4u*)(AD + ((size_t)(col >> 10) * M + row) * D + (col & 1023)) = pack8(z0, z1);
        } else if (u.kind == 2) {
            *(v4u*)(GB + (size_t)row * D + col) = pack8(v0, v1);
        } else {
            f32x4 z0 = v0 + cb0, z1 = v1 + cb1;
#pragma unroll
            for (int q = 0; q < 4; ++q) { z0[q] = sigmoidf_(z0[q]); z1[q] = sigmoidf_(z1[q]); }
            *(v4u*)(VGT + (size_t)row * D + col) = pack8(z0, z1);
        }
    }
};
__device__ __forceinline__ float head_sum(float v) { return sum16(v); }
__device__ __forceinline__ void pR4_scan_prep(Frame& F, int jj) {
    const float* k_k = INP(I_RWKV_K_K) + jj * D; const float* k_a = INP(I_RWKV_K_A) + jj * D;
    for (int r = F.gw; r < M; r += F.NGW) {
        f32x4 k[4], kk[4];
        ld_row_bf16(WSP(const bf16_t, WS_KB) + (size_t)r * D, F.lane, k);
#pragma unroll
        for (int q = 0; q < 4; ++q) {
            kk[q] = k[q] * ((const f32x4*)k_k)[F.lane + 64 * q];
            const float ss = head_sum((kk[q].x * kk[q].x + kk[q].y * kk[q].y) + (kk[q].z * kk[q].z + kk[q].w * kk[q].w));
            kk[q] = kk[q] * rsqrtf(fmaxf(ss, 1e-24f));
        }
        st_row_bf16(WSP(bf16_t, WS_KK) + (size_t)r * D, F.lane, kk);
#pragma unroll
        for (int d = 0; d < 2; ++d) {
            f32x4 a[4], o[4];
            ld_row_bf16(WSP(const bf16_t, WS_AD) + ((size_t)d * M + r) * D, F.lane, a);
#pragma unroll
            for (int q = 0; q < 4; ++q) o[q] = k[q] * ((a[q] - 1.f) * ((const f32x4*)k_a)[F.lane + 64 * q] + 1.f);
            st_row_bf16(WSP(bf16_t, WS_KD) + ((size_t)d * M + r) * D, F.lane, o);
#pragma unroll
            for (int q = 0; q < 4; ++q) o[q] = kk[q] * a[q];
            st_row_bf16(WSP(bf16_t, WS_BD) + ((size_t)d * M + r) * D, F.lane, o);
        }
        if (jj > 0) {
            f32x4 v[4], vf[4], vg[4];
            ld_row_bf16(WSP(const bf16_t, WS_VB) + (size_t)r * D, F.lane, v);
            ld_row_bf16(WSP(const bf16_t, WS_VFIRST) + (size_t)r * D, F.lane, vf);
            ld_row_bf16(WSP(const bf16_t, WS_VGT) + (size_t)r * D, F.lane, vg);
#pragma unroll
            for (int q = 0; q < 4; ++q) v[q] = v[q] + (vf[q] - v[q]) * vg[q];
            st_row_bf16(WSP(bf16_t, WS_V2) + (size_t)r * D, F.lane, v);
        }
    }
}
constexpr int SC_CH = 32;
constexpr int SC_STEP_F = 6 * 64;
constexpr int SC_BUF_F = SC_CH * SC_STEP_F;
constexpr int SC_YOFF = 2 * SC_BUF_F * 4;
static_assert(SC_YOFF + 2 * SC_CH * 64 * 4 <= RING_BYTES, "scan LDS");
#if MK_SCAN_SEQ
struct ScanOps { f32x4 w0, w1, k0, k1, b0, b1, q0, q1, r0, r1; float v; };
__device__ __forceinline__ float fma_s(float a, float b, float c) { float d; asm("v_fma_f32 %0, %1, %2, %3" : "=v"(d) : "v"(a), "v"(b), "v"(c)); return d; }
__device__ __forceinline__ float mul_s(float a, float b) { float d; asm("v_mul_f32_e32 %0, %1, %2" : "=v"(d) : "v"(a), "v"(b)); return d; }
__device__ __forceinline__ float add_s(float a, float b) { float d; asm("v_add_f32_e32 %0, %1, %2" : "=v"(d) : "v"(a), "v"(b)); return d; }
__device__ __forceinline__ float fnma_s(float a, float b, float c) { float d; asm("v_fma_f32 %0, -%1, %2, %3" : "=v"(d) : "v"(a), "v"(b), "v"(c)); return d; }
__device__ __forceinline__ void scan_step(f32x4& Sa, f32x4& Sb, const ScanOps& o, float& y) {
    float a0 = mul_s(Sa[0], o.q0[0]), a1 = mul_s(Sb[0], o.q1[0]);
    a0 = fma_s(Sa[1], o.q0[1], a0); a1 = fma_s(Sb[1], o.q1[1], a1); a0 = fma_s(Sa[2], o.q0[2], a0); a1 = fma_s(Sb[2], o.q1[2], a1); a0 = fma_s(Sa[3], o.q0[3], a0); a1 = fma_s(Sb[3], o.q1[3], a1);
    float sa = add_s(a0, a1);
    f32x4 pa, pb;
#pragma unroll
    for (int j = 0; j < 4; ++j) { pa[j] = mul_s(o.v, o.k0[j]); pb[j] = mul_s(o.v, o.k1[j]); }
#pragma unroll
    for (int j = 0; j < 4; ++j) { pa[j] = fma_s(Sa[j], o.w0[j], pa[j]); pb[j] = fma_s(Sb[j], o.w1[j], pb[j]); }
    sa += dpp_xor1(sa); sa += dpp_xor2(sa); sa += dpp_hmir(sa);
#pragma unroll
    for (int j = 0; j < 4; ++j) { Sa[j] = fnma_s(sa, o.b0[j], pa[j]); Sb[j] = fnma_s(sa, o.b1[j], pb[j]); }
    a0 = mul_s(Sa[0], o.r0[0]); a1 = mul_s(Sb[0], o.r1[0]);
    a0 = fma_s(Sa[1], o.r0[1], a0); a1 = fma_s(Sb[1], o.r1[1], a1); a0 = fma_s(Sa[2], o.r0[2], a0); a1 = fma_s(Sb[2], o.r1[2], a1); a0 = fma_s(Sa[3], o.r0[3], a0); a1 = fma_s(Sb[3], o.r1[3], a1);
    y = add_s(a0, a1);
    y += dpp_xor1(y); y += dpp_xor2(y); y += dpp_hmir(y);
}
__device__ __forceinline__ void pR5_scan(Frame& F, int jj) {
    LAS float* lbuf = (LAS float*)(F.lds + RING_OFF);
    LAS float* ybuf = (LAS float*)(F.lds + RING_OFF + SC_YOFF);
    const int tid = F.tid, vrow = tid >> 3, kq = tid & 7;
    const int sstep = tid >> 4, spart = tid & 15;
    const bf16_t* Vsrc = WSP(const bf16_t, (jj == 0) ? WS_VFIRST : WS_V2);
    for (int u = F.bid; u < NB * 16 * 2; u += F.G) {
        const int dir = u & 1, hh = (u >> 1) & 15, b = u >> 5;
        const size_t rowb = (size_t)b * TPB; const int colh = hh * 64 + 4 * spart;
        const float* Wd = WSP(const float, WS_WDEC) + (size_t)dir * M * D; const bf16_t* Kd = WSP(const bf16_t, WS_KD) + (size_t)dir * M * D; const bf16_t* Bd = WSP(const bf16_t, WS_BD) + (size_t)dir * M * D;
        const bf16_t* Kk = WSP(const bf16_t, WS_KK); const bf16_t* Rb = WSP(const bf16_t, WS_RB);
        float* Yd = WSP(float, WS_YS) + (size_t)dir * M * D;
        f32x4 Sa = (f32x4){0.f, 0.f, 0.f, 0.f}, Sb = (f32x4){0.f, 0.f, 0.f, 0.f};
        constexpr int NCH = TPB / SC_CH;
        f32x4 gw_; v2u gk_, gb_, gkk_, gr_, gv_;
#define SC_ROW(c, s) ((dir == 0) ? ((c) * SC_CH + (s)) : (((c) < CTXL / SC_CH) ? (CTXL - 1 - ((c) * SC_CH + (s))) : (TPB - 1 - ((c) * SC_CH + (s) - CTXL))))
#define SC_GLOAD(c) do { const size_t ro = (rowb + (size_t)SC_ROW(c, sstep)) * D + colh; gw_ = *(const f32x4*)(Wd + ro); gk_ = *(const v2u*)(Kd + ro); gb_ = *(const v2u*)(Bd + ro); \
        gkk_ = *(const v2u*)(Kk + ro); gr_ = *(const v2u*)(Rb + ro); gv_ = *(const v2u*)(Vsrc + ro); } while (0)
#define SC_BF4(w) (f32x4){bflo((w).x), bfhi((w).x), bflo((w).y), bfhi((w).y)}
#define SC_LWRITE(bufi) do { LAS float* d_ = lbuf + (bufi) * SC_BUF_F + sstep * SC_STEP_F + 4 * spart; *(LAS f32x4*)(d_) = gw_; *(LAS f32x4*)(d_ + 64) = SC_BF4(gk_); *(LAS f32x4*)(d_ + 128) = SC_BF4(gb_); \
        *(LAS f32x4*)(d_ + 192) = SC_BF4(gkk_); *(LAS f32x4*)(d_ + 256) = SC_BF4(gr_); *(LAS f32x4*)(d_ + 320) = SC_BF4(gv_); } while (0)
#define SC_LDOPS(o, sb) do { (o).w0 = *(const LAS f32x4*)(sb); (o).w1 = *(const LAS f32x4*)((sb) + 4); (o).k0 = *(const LAS f32x4*)((sb) + 64); (o).k1 = *(const LAS f32x4*)((sb) + 68); \
        (o).b0 = *(const LAS f32x4*)((sb) + 128); (o).b1 = *(const LAS f32x4*)((sb) + 132); (o).q0 = *(const LAS f32x4*)((sb) + 192); (o).q1 = *(const LAS f32x4*)((sb) + 196); \
        (o).r0 = *(const LAS f32x4*)((sb) + 256); (o).r1 = *(const LAS f32x4*)((sb) + 260); (o).v = (sb)[320 - 8 * kq + vrow]; } while (0)
        __syncthreads();
        SC_GLOAD(0); SC_LWRITE(0); __syncthreads();
        for (int c = 0; c < NCH; ++c) {
            if (c + 1 < NCH) SC_GLOAD(c + 1);
            if (c > 0) {
                const f32x4 yv = *(const LAS f32x4*)(ybuf + ((c - 1) & 1) * (SC_CH * 64) + sstep * 64 + 4 * spart);
                *(f32x4*)(Yd + (rowb + (size_t)SC_ROW(c - 1, sstep)) * D + colh) = yv;
            }
            const LAS float* cb = lbuf + (c & 1) * SC_BUF_F + 8 * kq;
            LAS float* yb = ybuf + (c & 1) * (SC_CH * 64) + vrow;
            ScanOps cur, nxt; SC_LDOPS(cur, cb);
#pragma unroll
            for (int s = 0; s < SC_CH; ++s) {
                if (s + 1 < SC_CH) SC_LDOPS(nxt, cb + (s + 1) * SC_STEP_F);
                float y; scan_step(Sa, Sb, cur, y);
                if (kq == 0) yb[s * 64] = y;
                cur = nxt;
            }
            if (c + 1 < NCH) SC_LWRITE((c + 1) & 1);
            __syncthreads();
        }
        {
            const f32x4 yv = *(const LAS f32x4*)(ybuf + ((NCH - 1) & 1) * (SC_CH * 64) + sstep * 64 + 4 * spart);
            *(f32x4*)(Yd + (rowb + (size_t)SC_ROW(NCH - 1, sstep)) * D + colh) = yv;
        }
#undef SC_ROW
#undef SC_GLOAD
#undef SC_BF4
#undef SC_LWRITE
#undef SC_LDOPS
    }
}
#else
constexpr int CK_P = 72, CK_MB = 64 * CK_P * 2;
enum { CB_RM = 0, CB_AT, CB_LAK, CB_LRB, CB_LRK, CB_SB, CB_N0, CB_N1, CB_N2, CB_NBUF };
constexpr int CK_PT = 80, CK_TB = 64 * CK_PT * 2, CK_TOFF = CB_NBUF * CK_MB;
enum { CT_VM = 0, CT_BM, CT_KM, CT_NBUF };
constexpr int CK_CW = CB_N0 * CK_MB;
constexpr int CK_SEG = CK_TOFF + CT_NBUF * CK_TB, CK_WC = CK_SEG + 8 * 64 * 4;
static_assert(CK_WC + 64 * 4 <= RING_BYTES && 2 * CK_MB >= 64 * 64 * 4, "chunked scan LDS");
typedef LAS unsigned char* lptr;
struct CkFrag { bf16x8 lo, hi; };
template <int PITCHB = CK_P * 2>
__device__ __forceinline__ CkFrag ck_ld(lptr Mb, int row0, int l15, int g) { const lptr p = Mb + (row0 + l15) * PITCHB + g * 16; CkFrag f; f.lo = *(const LAS bf16x8*)p; f.hi = *(const LAS bf16x8*)(p + 64); return f; }
typedef short ck_v4i16 __attribute__((ext_vector_type(4))); typedef short ck_v8i16 __attribute__((ext_vector_type(8)));
__device__ __forceinline__ CkFrag ck_ld_tr(lptr Mb, int n0, int l15, int g) {
    const lptr p = Mb + (8 * g + (l15 >> 2)) * (CK_PT * 2) + n0 * 2 + (l15 & 3) * 8;
    const ck_v4i16 a = __builtin_amdgcn_ds_read_tr16_b64_v4i16((LAS ck_v4i16*)(p)), b = __builtin_amdgcn_ds_read_tr16_b64_v4i16((LAS ck_v4i16*)(p + 4 * (CK_PT * 2)));
    const ck_v4i16 c = __builtin_amdgcn_ds_read_tr16_b64_v4i16((LAS ck_v4i16*)(p + 32 * (CK_PT * 2))), d = __builtin_amdgcn_ds_read_tr16_b64_v4i16((LAS ck_v4i16*)(p + 36 * (CK_PT * 2)));
    CkFrag f; f.lo = __builtin_bit_cast(bf16x8, (ck_v8i16)__builtin_shufflevector(a, b, 0, 1, 2, 3, 4, 5, 6, 7)); f.hi = __builtin_bit_cast(bf16x8, (ck_v8i16)__builtin_shufflevector(c, d, 0, 1, 2, 3, 4, 5, 6, 7)); return f; }
__device__ __forceinline__ f32x4 ck_mm(f32x4 acc, const CkFrag& a, const CkFrag& b) {
    acc = __builtin_amdgcn_mfma_f32_16x16x32_bf16(a.lo, b.lo, acc, 0, 0, 0); return __builtin_amdgcn_mfma_f32_16x16x32_bf16(a.hi, b.hi, acc, 0, 0, 0); }
__device__ __forceinline__ void ck_st_t(lptr Mb, int row0, int col0, int l15, int g, f32x4 v) {
    v2u w; w.x = pk2(v[0], v[1]); w.y = pk2(v[2], v[3]);
    *(LAS v2u*)(Mb + (col0 + l15) * (CK_P * 2) + (row0 + 4 * g) * 2) = w;
}
__device__ __forceinline__ bf16x8 sm_ld(lptr img, int l15, int g) { return *(const LAS bf16x8*)(img + l15 * 64 + g * 16); }
__device__ __forceinline__ f32x4 mm16(f32x4 acc, bf16x8 a, bf16x8 b) { return __builtin_amdgcn_mfma_f32_16x16x32_bf16(a, b, acc, 0, 0, 0); }
__device__ __forceinline__ void sm_st_t(lptr img, int l15, int g, f32x4 v) {
    v2u w; w.x = pk2(v[0], v[1]); w.y = pk2(v[2], v[3]);
    *(LAS v2u*)(img + l15 * 64 + g * 8) = w; { unsigned zz = 0u; asm volatile("" : "+v"(zz)); *(LAS v2u*)(img + l15 * 64 + 32 + g * 8) = (v2u){zz, zz}; }
}
#ifdef MK_SCANVAR
__device__ __forceinline__ void pR5_scan(Frame& F, int jj, int var = 0) {
    const bool HM = (var & 64) != 0;
#else
__device__ __forceinline__ void pR5_scan(Frame& F, int jj) {
    constexpr bool HM = false;
#endif
    const lptr L0 = F.lds + RING_OFF;
#define CKB(i) (L0 + (i) * CK_MB)
#define CKT(i) (L0 + CK_TOFF + (i) * CK_TB)
    LAS float* CW = (LAS float*)(L0 + CK_CW); LAS float* SEG = (LAS float*)(L0 + CK_SEG); LAS float* WC = (LAS float*)(L0 + CK_WC);
    const int tid = F.tid, lane = tid & 63, wv = F.wave, l15 = lane & 15, g = lane >> 4;
    const int tr16 = (wv >> 1) * 16, tc0 = (wv & 1) * 32;
    const int pk = tid & 63, pseg = tid >> 6;
    const int pt = tid >> 3, pkg = tid & 7;
    const bf16_t* Vsrc = WSP(const bf16_t, (jj == 0) ? WS_VFIRST : WS_VB);
    const f32x4 z4 = (f32x4){0.f, 0.f, 0.f, 0.f};
    for (int u = F.bid; u < NB * 16 * 2; u += F.G) {
        const int dir = u & 1, hh = (u >> 1) & 15, b = u >> 5;
        const int RS = HM ? 64 : D;
        const size_t ub = HM ? (size_t)(b * 16 + hh) * TPB * 64 : (size_t)b * TPB * D + hh * 64;
        const bf16_t* Wd = WSP(const bf16_t, WS_WDEC) + (size_t)dir * M * D + ub; const bf16_t* Kb = WSP(const bf16_t, WS_KB) + ub;
        const bf16_t* Ad = WSP(const bf16_t, WS_AD) + (size_t)dir * M * D + ub; const bf16_t* Rb = WSP(const bf16_t, WS_RB) + ub;
        const bf16_t* Vs = Vsrc + ub; const bf16_t* Vf = WSP(const bf16_t, WS_VFIRST) + ub; const bf16_t* Vg = WSP(const bf16_t, WS_VGT) + ub; bf16_t* Yd = WSP(bf16_t, WS_YS) + (size_t)dir * M * D + ub;
        float kkv[8], kav[8], rkv[8];
        { const float* pkk = INP(I_RWKV_K_K) + jj * D + hh * 64 + 8 * pkg; const float* pka = INP(I_RWKV_K_A) + jj * D + hh * 64 + 8 * pkg; const float* prk = INP(I_RWKV_R_K) + jj * D + hh * 64 + 8 * pkg;
#pragma unroll
          for (int j = 0; j < 8; ++j) { kkv[j] = pkk[j]; kav[j] = pka[j]; rkv[j] = prk[j]; } }
        float* Bon = WSP(float, WS_LOGITS) + ((size_t)dir * M + (size_t)b * TPB) * 16 + hh;
        constexpr int NCK = TPB / 64;
#define CK_ROW(st) ((dir == 0) ? (st) : (((st) < CTXL) ? (CTXL - 1 - (st)) : (TPB - 1 - ((st) - CTXL))))
        unsigned glw[8]; v4u gk, ga, gr, gv, gvf, gvg;
#define CK_GLOADW(c) do { const int rb_ = CK_ROW((c) * 64), sg_ = (dir == 0) ? RS : -RS;        \
        const bf16_t* wl_ = Wd + (size_t)rb_ * RS + (pk & ~1) + (long)sg_ * (8 * pseg); _Pragma("unroll") for (int j = 0; j < 8; ++j) glw[j] = __builtin_nontemporal_load((const unsigned*)(wl_ + (long)sg_ * j)); } while (0)
#define CK_GLOAD(c) do { const int rb_ = CK_ROW((c) * 64), sg_ = (dir == 0) ? RS : -RS; \
        const size_t ro = (size_t)((long)rb_ * RS + (long)sg_ * pt) + 8 * pkg; gk = __builtin_nontemporal_load((const v4u*)(Kb + ro)); ga = __builtin_nontemporal_load((const v4u*)(Ad + ro)); gr = __builtin_nontemporal_load((const v4u*)(Rb + ro)); gv = __builtin_nontemporal_load((const v4u*)(Vs + ro)); \
        if (jj > 0) { gvf = __builtin_nontemporal_load((const v4u*)(Vf + ro)); gvg = __builtin_nontemporal_load((const v4u*)(Vg + ro)); } } while (0)
        f32x4 SaccT[2] = {z4, z4};
        __syncthreads();
        CK_GLOADW(0); CK_GLOAD(0);
        float cl[8];
#define CK_LW(j) ((pk & 1) ? bfhi(glw[j]) : bflo(glw[j]))
#define CK_CUMSEG() do { cl[0] = CK_LW(0); _Pragma("unroll") for (int j = 1; j < 8; ++j) cl[j] = cl[j - 1] + CK_LW(j); SEG[pseg * 64 + pk] = cl[7]; } while (0)
        CK_CUMSEG();
        __syncthreads();
        for (int c = 0; c < NCK; ++c) {
            if (c + 1 < NCK) CK_GLOADW(c + 1);
            const v4u yprev = *(const LAS v4u*)(CKB(CB_N2) + pt * (CK_P * 2) + 16 * pkg);
#pragma unroll
            for (int q = 0; q < 2; ++q) ck_st_t(CKB(CB_SB), tr16, tc0 + 16 * q, l15, g, SaccT[q]);
            { float pre = 0.f;
#pragma unroll
              for (int s2 = 0; s2 < 7; ++s2) pre += (s2 < pseg) ? SEG[s2 * 64 + pk] : 0.f;
#pragma unroll
              for (int j = 0; j < 8; ++j) CW[(8 * pseg + j) * 64 + pk] = __expf(cl[j] + pre);
              if (pseg == 7) WC[pk] = __expf(cl[7] + pre); }
            __syncthreads();
            { const f32x4 c0 = *(const LAS f32x4*)(CW + pt * 64 + 8 * pkg), c1 = *(const LAS f32x4*)(CW + pt * 64 + 8 * pkg + 4);
              f32x4 p0 = (f32x4){1.f, 1.f, 1.f, 1.f}, p1 = p0;
              if (pt > 0) { p0 = *(const LAS f32x4*)(CW + (pt - 1) * 64 + 8 * pkg); p1 = *(const LAS f32x4*)(CW + (pt - 1) * 64 + 8 * pkg + 4); }
              float fa[8], fb[8], fk[8], fr[8], xk[8], xa[8], kkj[8];
              const unsigned wk_[4] = {gk.x, gk.y, gk.z, gk.w}, wa_[4] = {ga.x, ga.y, ga.z, ga.w}, wr[4] = {gr.x, gr.y, gr.z, gr.w};
              float ss = 0.f;
#pragma unroll
              for (int j = 0; j < 8; ++j) { xk[j] = (j & 1) ? bfhi(wk_[j >> 1]) : bflo(wk_[j >> 1]); xa[j] = (j & 1) ? bfhi(wa_[j >> 1]) : bflo(wa_[j >> 1]); kkj[j] = xk[j] * kkv[j]; ss += kkj[j] * kkj[j]; }
              ss += dpp_xor1(ss); ss += dpp_xor2(ss); ss += dpp_hmir(ss);
              const float rn = rsqrtf(fmaxf(ss, 1e-24f)); float bs = 0.f;
#pragma unroll
              for (int j = 0; j < 8; ++j) { const float cwj = (j < 4) ? c0[j & 3] : c1[j & 3], cpj = (j < 4) ? p0[j & 3] : p1[j & 3];
                  const float Wt = cwj, Wi = __builtin_amdgcn_rcpf(Wt), Wp = cpj;
                  const float xr = (j & 1) ? bfhi(wr[j >> 1]) : bflo(wr[j >> 1]), kn = kkj[j] * rn;
                  const float kd = xk[j] * ((xa[j] - 1.f) * kav[j] + 1.f);
                  fa[j] = -kn * Wp; fb[j] = kn * xa[j] * Wi; fk[j] = kd * Wi; fr[j] = xr * Wt; bs += xr * kd * rkv[j]; }
              bs += dpp_xor1(bs); bs += dpp_xor2(bs); bs += dpp_hmir(bs);
              if (pkg == 0) Bon[(size_t)CK_ROW(c * 64 + pt) * 16] = bs;
              if (jj > 0) {
                  const unsigned wv_[4] = {gv.x, gv.y, gv.z, gv.w}, wf_[4] = {gvf.x, gvf.y, gvf.z, gvf.w}, wg_[4] = {gvg.x, gvg.y, gvg.z, gvg.w}; float vm[8];
#pragma unroll
                  for (int j = 0; j < 8; ++j) { const float a_ = (j & 1) ? bfhi(wv_[j >> 1]) : bflo(wv_[j >> 1]), f_ = (j & 1) ? bfhi(wf_[j >> 1]) : bflo(wf_[j >> 1]), g_ = (j & 1) ? bfhi(wg_[j >> 1]) : bflo(wg_[j >> 1]); vm[j] = a_ + (f_ - a_) * g_; }
                  gv.x = pk2(vm[0], vm[1]); gv.y = pk2(vm[2], vm[3]); gv.z = pk2(vm[4], vm[5]); gv.w = pk2(vm[6], vm[7]); }
              v4u oa, ob, ok, orr;
              oa.x = pk2(fa[0], fa[1]); oa.y = pk2(fa[2], fa[3]); oa.z = pk2(fa[4], fa[5]); oa.w = pk2(fa[6], fa[7]);
              ob.x = pk2(fb[0], fb[1]); ob.y = pk2(fb[2], fb[3]); ob.z = pk2(fb[4], fb[5]); ob.w = pk2(fb[6], fb[7]);
              ok.x = pk2(fk[0], fk[1]); ok.y = pk2(fk[2], fk[3]); ok.z = pk2(fk[4], fk[5]); ok.w = pk2(fk[6], fk[7]);
              orr.x = pk2(fr[0], fr[1]); orr.y = pk2(fr[2], fr[3]); orr.z = pk2(fr[4], fr[5]); orr.w = pk2(fr[6], fr[7]);
              const int ro = pt * (CK_P * 2) + 16 * pkg;
              const int rt = pt * (CK_PT * 2) + 16 * pkg;
              *(LAS v4u*)(CKB(CB_AT) + ro) = oa; *(LAS v4u*)(CKT(CT_BM) + rt) = ob; *(LAS v4u*)(CKT(CT_KM) + rt) = ok; *(LAS v4u*)(CKB(CB_RM) + ro) = orr; *(LAS v4u*)(CKT(CT_VM) + rt) = gv; }
            if (c > 0) *(v4u*)(Yd + (size_t)CK_ROW((c - 1) * 64 + pt) * RS + 8 * pkg) = yprev;
            if (c + 1 < NCK) CK_GLOAD(c + 1);
            __syncthreads();
            { const CkFrag aBM = ck_ld<CK_PT * 2>(CKT(CT_BM), tr16, l15, g), aKM = ck_ld<CK_PT * 2>(CKT(CT_KM), tr16, l15, g);
#pragma unroll
              for (int q = 0; q < 2; ++q) { const int tc16 = tc0 + 16 * q; const bool dg = (tr16 == tc16);
                const CkFrag bAT = ck_ld(CKB(CB_AT), tc16, l15, g), bRM = ck_ld(CKB(CB_RM), tc16, l15, g);
                f32x4 pq = ck_mm(z4, aBM, bAT);
                f32x4 lak = ck_mm(z4, aKM, bAT), lrb = ck_mm(z4, aBM, bRM), lrk = ck_mm(z4, aKM, bRM);
#pragma unroll
                for (int r = 0; r < 4; ++r) { const int i = tr16 + 4 * g + r, t = tc16 + l15; if (!(i < t)) { pq[r] = 0.f; lak[r] = 0.f; } if (!(i <= t)) { lrb[r] = 0.f; lrk[r] = 0.f; } }
                if (dg) {
                    const CkFrag aAT = ck_ld(CKB(CB_AT), tr16, l15, g), bBM = ck_ld<CK_PT * 2>(CKT(CT_BM), tc16, l15, g);
                    f32x4 cn = ck_mm(z4, aAT, bBM);
#pragma unroll
                    for (int r = 0; r < 4; ++r) { const int t = tr16 + 4 * g + r, i = tc16 + l15; if (!(i < t)) cn[r] = 0.f; }
                    f32x4 cq = pq, Tt;
#pragma unroll
                    for (int r = 0; r < 4; ++r) Tt[r] = cq[r] + ((4 * g + r == l15) ? 1.f : 0.f);
                    unsigned zz = 0u; asm volatile("" : "+v"(zz));
#define CK_PACK(x) __builtin_bit_cast(bf16x8, (v4u){pk2((x)[0], (x)[1]), pk2((x)[2], (x)[3]), zz, zz})
#pragma unroll
                    for (int lv = 1; lv <= 3; ++lv) {
                        const bf16x8 on = CK_PACK(cn), oq = CK_PACK(cq);
                        cn = mm16(z4, oq, on);
                        if (lv < 3) cq = mm16(z4, on, oq);
                        Tt = mm16(Tt, CK_PACK(cn), CK_PACK(Tt));
                    }
#undef CK_PACK
                    sm_st_t(CKB(CB_N2) + (tr16 >> 4) * 1024, l15, g, Tt);
                    pq = z4;
                }
                ck_st_t(CKB(CB_N1), tr16, tc16, l15, g, pq);
                ck_st_t(CKB(CB_LAK), tr16, tc16, l15, g, lak); ck_st_t(CKB(CB_LRB), tr16, tc16, l15, g, lrb); ck_st_t(CKB(CB_LRK), tr16, tc16, l15, g, lrk);
                } }
            __syncthreads();
            if (wv < 4) {
                const int vb = 16 * wv; unsigned zz = 0u; asm volatile("" : "+v"(zz));
                const CkFrag bSB = ck_ld(CKB(CB_SB), vb, l15, g), bVT = ck_ld_tr(CKT(CT_VM), vb, l15, g);
                CkFrag aAT[4], aLAK[4]; v2u lw_[6], tw[4];
#pragma unroll
                for (int b2 = 0; b2 < 4; ++b2) { aAT[b2] = ck_ld(CKB(CB_AT), 16 * b2, l15, g); aLAK[b2] = ck_ld(CKB(CB_LAK), 16 * b2, l15, g); tw[b2] = *(const LAS v2u*)(CKB(CB_N2) + b2 * 1024 + l15 * 64 + g * 8); }
#pragma unroll
                for (int b2 = 1; b2 < 4; ++b2)
#pragma unroll
                    for (int j2 = 0; j2 < b2; ++j2) lw_[b2 * (b2 - 1) / 2 + j2] = *(const LAS v2u*)(CKB(CB_N1) + (16 * b2 + l15) * (CK_P * 2) + (16 * j2 + 4 * g) * 2);
                f32x4 R[4];
#pragma unroll
                for (int b2 = 0; b2 < 4; ++b2) { R[b2] = ck_mm(z4, aAT[b2], bSB); R[b2] = ck_mm(R[b2], aLAK[b2], bVT); }
#pragma unroll
                for (int b2 = 0; b2 < 4; ++b2) {
                    const f32x4 U = mm16(z4, __builtin_bit_cast(bf16x8, (v4u){tw[b2].x, tw[b2].y, zz, zz}), __builtin_bit_cast(bf16x8, (v4u){pk2(R[b2][0], R[b2][1]), pk2(R[b2][2], R[b2][3]), zz, zz}));
                    const bf16x8 Up = __builtin_bit_cast(bf16x8, (v4u){pk2(U[0], U[1]), pk2(U[2], U[3]), zz, zz});
                    ck_st_t(CKB(CB_N0), 16 * b2, vb, l15, g, U);
#pragma unroll
                    for (int b3 = b2 + 1; b3 < 4; ++b3) R[b3] = mm16(R[b3], __builtin_bit_cast(bf16x8, (v4u){lw_[b3 * (b3 - 1) / 2 + b2].x, lw_[b3 * (b3 - 1) / 2 + b2].y, zz, zz}), Up);
                }
            }
            __syncthreads();
            { const CkFrag aSB = ck_ld(CKB(CB_SB), tr16, l15, g), aUT = ck_ld(CKB(CB_N0), tr16, l15, g), aVT = ck_ld_tr(CKT(CT_VM), tr16, l15, g), aBMT = ck_ld_tr(CKT(CT_BM), tr16, l15, g), aKMT = ck_ld_tr(CKT(CT_KM), tr16, l15, g);
              const f32x4 wc = *(const LAS f32x4*)(WC + tr16 + 4 * g);
#pragma unroll
              for (int q = 0; q < 2; ++q) { const int tc16 = tc0 + 16 * q;
                const CkFrag bRM = ck_ld(CKB(CB_RM), tc16, l15, g), bLRB = ck_ld(CKB(CB_LRB), tc16, l15, g), bLRK = ck_ld(CKB(CB_LRK), tc16, l15, g), bUT = ck_ld(CKB(CB_N0), tc16, l15, g), bVT = ck_ld_tr(CKT(CT_VM), tc16, l15, g);
                f32x4 yt = ck_mm(z4, aSB, bRM); yt = ck_mm(yt, aUT, bLRB); yt = ck_mm(yt, aVT, bLRK);
                ck_st_t(CKB(CB_N2), tr16, tc16, l15, g, yt);
                SaccT[q] = ck_mm(SaccT[q], aBMT, bUT); SaccT[q] = ck_mm(SaccT[q], aKMT, bVT); SaccT[q] = SaccT[q] * wc; } }
            if (c + 1 < NCK) CK_CUMSEG();
            __syncthreads();
        }
        *(v4u*)(Yd + (size_t)CK_ROW((NCK - 1) * 64 + pt) * RS + 8 * pkg) = *(const LAS v4u*)(CKB(CB_N2) + pt * (CK_P * 2) + 16 * pkg);
#undef CK_CUMSEG
#undef CK_LW
#undef CK_ROW
#undef CK_GLOAD
#undef CK_GLOADW
    }
#undef CKB
#undef CKT
}
#endif
__device__ __forceinline__ void pR6_out(Frame& F, int jj) {
    const float* ln_w = INP(I_RWKV_LN_W) + jj * D; const float* ln_b = INP(I_RWKV_LN_B) + jj * D;
    v2u ry[4], ry1[4], rg[4], rv[4], rvf[4], rvg[4]; float rb0[4], rb1[4];
#define R6_ROW(P_, r_, dst_) do { _Pragma("unroll") for (int q = 0; q < 4; ++q) dst_[q] = __builtin_nontemporal_load(&((const v2u*)(WSP(const bf16_t, P_) + (size_t)(r_) * D))[F.lane + 64 * q]); } while (0)
#define R6_LOAD(r_) do { R6_ROW(WS_YS, (r_), ry); R6_ROW(WS_YS, (size_t)M + (r_), ry1); R6_ROW(WS_GB, (r_), rg); \
        if (jj == 0) R6_ROW(WS_VFIRST, (r_), rv); else { R6_ROW(WS_VB, (r_), rv); R6_ROW(WS_VFIRST, (r_), rvf); R6_ROW(WS_VGT, (r_), rvg); } \
        const float* bon_ = WSP(const float, WS_LOGITS) + (size_t)(r_) * 16 + (F.lane >> 4);        \
        _Pragma("unroll") for (int q = 0; q < 4; ++q) { rb0[q] = bon_[4 * q]; rb1[q] = bon_[(size_t)M * 16 + 4 * q]; } } while (0)
#define R6_UNP(w_) ((f32x4){bflo((w_).x), bfhi((w_).x), bflo((w_).y), bfhi((w_).y)})
    if (F.gw < M) R6_LOAD(F.gw);
    for (int r = F.gw; r < M; r += F.NGW) {
        f32x4 yy[4], v[4], g[4]; float bonus[4];
#pragma unroll
        for (int q = 0; q < 4; ++q) { yy[q] = R6_UNP(ry[q]) + R6_UNP(ry1[q]); g[q] = R6_UNP(rg[q]); v[q] = R6_UNP(rv[q]); bonus[q] = rb0[q] + rb1[q];
            if (jj != 0) { const f32x4 vf = R6_UNP(rvf[q]), vg = R6_UNP(rvg[q]); v[q] = v[q] + (vf - v[q]) * vg; } }
        if (r + F.NGW < M) R6_LOAD(r + F.NGW);
        f32x4 o[4];
#pragma unroll
        for (int q = 0; q < 4; ++q) {
            const float mu = head_sum((yy[q].x + yy[q].y) + (yy[q].z + yy[q].w)) * (1.f / 64.f);
            const f32x4 dlt = yy[q] - mu;
            const float var = head_sum((dlt.x * dlt.x + dlt.y * dlt.y) + (dlt.z * dlt.z + dlt.w * dlt.w)) * (1.f / 64.f);
            const f32x4 yn = dlt * rsqrtf(var + GN_EPS) * ((const f32x4*)ln_w)[F.lane + 64 * q] + ((const f32x4*)ln_b)[F.lane + 64 * q];
            o[q] = (yn + v[q] * bonus[q]) * g[q];
        }
        st_row_bf16(WSP(bf16_t, WS_OB) + (size_t)r * D, F.lane, o);
    }
#undef R6_ROW
#undef R6_LOAD
#undef R6_UNP
}
#define RWKV_PHASES(p0, L, J) \
    { const unsigned char* swo = (const unsigned char*)F.ws + WS_SMALLW + SW_OD + (size_t)(J) * OD_BYTES; \
    if (IN((p0) + 0)) { pR1_mix(F, (J)); SEAM((p0) + 0); } \
    if (IN((p0) + 1)) { MultiOrder<7> S; const char* xm = (const char*)(F.ws + WS_XMIX); \
        S.s[0] = SubGemm{xm + 0 * ROWB2, (const char*)(swo + OD_WR), 2048, 1024, 4, 0}; S.s[1] = SubGemm{xm + 2 * ROWB2, (const char*)(swo + OD_WK), 2048, 1024, 4, 1}; \
        S.s[2] = SubGemm{xm + 3 * ROWB2, (const char*)(swo + OD_WV), 2048, 1024, 4, 2}; S.s[3] = SubGemm{xm + 1 * ROWB2, (const char*)(swo + OD_W1C), 2048, 1024, 1, 3}; \
        S.s[4] = SubGemm{xm + 4 * ROWB2, (const char*)(swo + OD_A1C), 2048, 1024, 1, 4}; S.s[5] = SubGemm{xm + 5 * ROWB2, (const char*)(swo + OD_G1), 2048, 1024, 1, 5}; \
        S.s[6] = SubGemm{xm + 3 * ROWB2, (const char*)(swo + OD_V1), 2048, 1024, ((J) > 0) ? 1 : 0, 6}; S.init(F.G, F.bid, 1); \
        EpiR2 E; E.dst[0] = WSP(bf16_t, WS_RB); E.dst[1] = WSP(bf16_t, WS_KB); E.dst[2] = WSP(bf16_t, ((J) == 0) ? WS_VFIRST : WS_VB); E.dst[3] = WSP(bf16_t, WS_LW); E.dst[4] = WSP(bf16_t, WS_LA); \
        E.dst[5] = WSP(bf16_t, WS_LG); E.dst[6] = WSP(bf16_t, WS_LV); pg8::gemm_phase(ring, S, E, F.wave); SEAM((p0) + 1); } \
    if (IN((p0) + 2)) { MultiOrder<4> S; \
        S.s[0] = SubGemm{(const char*)(F.ws + WS_LW), (const char*)(swo + OD_W2C), 256, 128, 8, 0}; S.s[1] = SubGemm{(const char*)(F.ws + WS_LA), (const char*)(swo + OD_A2C), 256, 128, 8, 1}; \
        S.s[2] = SubGemm{(const char*)(F.ws + WS_LG), (const char*)(swo + OD_G2), 256, 128, 4, 2}; S.s[3] = SubGemm{(const char*)(F.ws + WS_LV), (const char*)(swo + OD_V2), 256, 128, ((J) > 0) ? 4 : 0, 3}; S.init(F.G, F.bid); \
        EpiR3 E{WSP(bf16_t, WS_WDEC), WSP(bf16_t, WS_AD), WSP(bf16_t, WS_GB), WSP(bf16_t, WS_VGT), INP(I_RWKV_W0) + (size_t)(J) * 2 * D, INP(I_RWKV_A0) + (size_t)(J) * 2 * D, INP(I_RWKV_V0)}; \
        pg8::gemm_phase(ring, S, E, F.wave); SEAM((p0) + 2); } \
      \
    if (IN((p0) + 4)) { pR5_scan(F, (J)); SEAM((p0) + 4); } \
    if (IN((p0) + 5)) { pR6_out(F, (J)); SEAM((p0) + 5); } \
    if (IN((p0) + 6)) { MultiOrder<1> S; S.s[0] = SubGemm{(const char*)(F.ws + WS_OB), (const char*)(swo + OD_WO), 2048, 1024, 4, 0}; S.init(F.G, F.bid); \
        EpiResidual E{WSP(bf16_t, WS_XR), WSP(const float, WS_MOD) + (size_t)(L) * 9 * 6144 + 2 * 1024}; pg8::gemm_phase(ring, S, E, F.wave); SEAM((p0) + 6); } }
#define MOE_PHASES(p0, L) \
    if (IN((p0) + 0)) { pF1R_norm_router(F, args, (L)); SEAM((p0) + 0); } \
      \
    if (IN((p0) + 2) && F.G * NWAVES * 17 < M) { pF3_route(F, (L)); SEAM((p0) + 2); }     \
    if (IN((p0) + 3)) { const int tt = moe_table(F, (L)); MoeOrder<8, 4, 2> S; int z_ = 0; asm volatile("" : "+s"(z_)); S.tb = (const LAS int*)(F.lds + LDSCTL_OFF + z_); S.A = (const char*)(F.ws + WS_HB); \
        S.W = (const char*)(F.ws + WS_W1T) + (size_t)(L) * 32 * 2048 * 1024 * 2; S.RI = WSP(const int, WS_ROWIDX); S.G = F.G; S.c = F.bid; S.nwg = ((tt + 3) / 4) * 4 * 8; \
        EpiSwiglu E{WSP(bf16_t, WS_ACT), INP(I_MOE_B1) + (size_t)(L) * 32 * 2048}; pg8::gemm_phase<EpiSwiglu, MoeOrder<8, 4, 2>, 2>(ring, S, E, F.wave); SEAM((p0) + 3); } \
    if (IN((p0) + 4)) { const int tt = moe_table(F, (L)); MoeOrder<4, 8, 0> S; int z_ = 0; asm volatile("" : "+s"(z_)); S.tb = (const LAS int*)(F.lds + LDSCTL_OFF + z_); S.A = (const char*)(F.ws + WS_ACT); \
        S.W = (const char*)(F.ws + WS_W2T) + (size_t)(L) * 32 * 1024 * 1024 * 2; S.RI = WSP(const int, WS_ROWIDX); S.G = F.G; S.c = F.bid; S.nwg = ((tt + 7) / 8) * 8 * 4; \
        EpiMoeDown E{WSP(bf16_t, WS_YB), INP(I_MOE_B2) + (size_t)(L) * 32 * 1024}; pg8::gemm_phase<EpiMoeDown, MoeOrder<4, 8, 0>, 0>(ring, S, E, F.wave); SEAM((p0) + 4); } \
    if (IN((p0) + 5)) { pF6_combine(F, args, (L)); SEAM((p0) + 5); }
constexpr int PH_P0 = 0, PH_P1 = 1, PH_LAYER0 = 2, PH_PER_PAIR = 25, PH_COPY = PH_LAYER0 + 2 * PH_PER_PAIR, PH_TOTAL = PH_COPY + 1;
__global__ void __launch_bounds__(NTHREADS, 2) fwd(Args args) {
    extern __shared__ __attribute__((aligned(16))) unsigned char lds_raw[];
    Frame F;
    F.lds = (LAS unsigned char*)lds_raw;
    F.MISC = (volatile LAS unsigned*)(F.lds + MISC_OFF);
    F.tid = threadIdx.x; F.lane = F.tid & 63; F.wave = __builtin_amdgcn_readfirstlane(F.tid >> 6);
    F.G = gridDim.x; F.bid = blockIdx.x; F.gw = F.bid * NWAVES + F.wave; F.NGW = F.G * NWAVES;
    F.ws = (GAS unsigned char*)args.ws; F.ctl = (gu32*)(args.ws + WS_CTL);
    for (int u = F.tid; u < (LDS_BYTES - LDSCTL_OFF) / 4; u += NTHREADS) ((LAS unsigned*)(F.lds + LDSCTL_OFF))[u] = 0u;
    __syncthreads();
    if (F.tid <= N_IN) { const unsigned long long pv = (F.tid < N_IN) ? (unsigned long long)args.in[F.tid] : (unsigned long long)args.out; *(LAS unsigned long long*)(F.lds + PTR_OFF + 8 * F.tid) = pv; }
    __syncthreads();
    XcdBarrier bar = xcd_barrier_post((unsigned*)(F.ctl + CW_BAR) + args.bli * XCD_BAR_WORDS, F.MISC + 8);
    const int lo = args.ph_lo, hi = args.ph_hi;
#define IN(k) (lo <= (k) && (k) < hi && phase_fence(F))
#define SEAM(k) do { if (lo <= (k) + 1 && (k) + 1 < hi) { XcdBarrier b2_ = bar; asm volatile("" : "+s"(b2_.bar), "+s"(b2_.x), "+s"(b2_.w)); xcd_barrier(b2_); } } while (0)
    if (IN(PH_P0)) { p0_prologue(F, args); SEAM(PH_P0); }
    if (IN(PH_P1)) { p1_init(F, args); SEAM(PH_P1); }
    LAS unsigned char* ring = F.lds + RING_OFF;
    for (int lp = 0; lp < 2; ++lp) {
        const int pb = PH_LAYER0 + lp * PH_PER_PAIR;
        if (hi <= pb) break;
        {
            const int layer = 2 * lp, e = lp;
            const unsigned char* swe = (const unsigned char*)F.ws + WS_SMALLW + SW_EV + (size_t)e * EV_BYTES;
            if (IN(pb + 0)) {
                MultiOrder<1> S; S.s[0] = SubGemm{(const char*)(F.ws + WS_HB), (const char*)(swe + EV_WIN), 2048, 1024, 7, 0}; S.init(F.G, F.bid);
                EpiStoreBf16 E{WSP(bf16_t, WS_PROJ), PROJ_LD, PROJ_LD};
                pg8::gemm_phase(ring, S, E, F.wave); SEAM(pb + 0); }
            if (IN(pb + 1)) { pA2_proj_norms(F, args, e); SEAM(pb + 1); }
            if (IN(pb + 2)) {
                MultiOrder<2> S; S.s[0] = SubGemm{(const char*)(F.ws + WS_PROJ) + C_ZQ * 2, (const char*)(swe + EV_WUQ), PROJ_LD * 2, 384, 3, 0};
                S.s[1] = SubGemm{(const char*)(F.ws + WS_PROJ) + C_ZKV * 2, (const char*)(swe + EV_WUKV), PROJ_LD * 2, 256, 4, 1}; S.init(F.G, F.bid);
                EpiStore2 E{WSP(bf16_t, WS_QM), 768, WSP(bf16_t, WS_KVM), 1024};
                pg8::gemm_phase(ring, S, E, F.wave); SEAM(pb + 2); }
            if (IN(pb + 3)) { pA4_mla_norms(F, args, e); SEAM(pb + 3); }
            if (IN(pb + 4)) { pA5_attention(F, lp == 0); SEAM(pb + 4); }
            if (IN(pb + 5)) {
                MultiOrder<1> S; S.s[0] = SubGemm{(const char*)(F.ws + WS_OB), (const char*)(swe + EV_WOUT), 2048, 1024, 4, 0}; S.init(F.G, F.bid);
                EpiResidual E{WSP(bf16_t, WS_XR), WSP(const float, WS_MOD) + (size_t)layer * 9 * 6144 + 2 * 1024};
                pg8::gemm_phase(ring, S, E, F.wave); SEAM(pb + 5); }
            MOE_PHASES(pb + 6, layer)
        }
        {
            const int layer = 2 * lp + 1, jj = lp;
            RWKV_PHASES(pb + 12, layer, jj)
            MOE_PHASES(pb + 19, layer)
        }
    }
    if (IN(PH_COPY)) { p_copy_out(F, args); }
#ifdef MK_SCANVAR
    for (int v_ = 0; v_ < 128; v_ += 64) if (IN(60 + v_)) pR5_scan(F, 1, v_);
#endif
#undef IN
#undef SEAM
}

extern "C" void kernel_launch(void* const* d_in, const int* in_sizes, int n_in, void* d_out, int out_size, void* d_ws, size_t ws_size, hipStream_t stream) {
    static int grid = 0;
    if (grid == 0) {
        if (n_in != N_IN || out_size != NB * SEQ * D || ws_size < WS_END) { fprintf(stderr, "kernel_launch: unexpected shapes: n_in %d out %d ws %zu (need %zu)\n", n_in, out_size, ws_size, (size_t)WS_END); grid = -1; return; }
        int dev = 0, cus = 0, per_cu = 0;
        if (hipGetDevice(&dev) != hipSuccess || hipDeviceGetAttribute(&cus, hipDeviceAttributeMultiprocessorCount, dev) != hipSuccess) { grid = -1; return; }
        if (hipFuncSetAttribute((const void*)fwd, hipFuncAttributeMaxDynamicSharedMemorySize, LDS_BYTES) != hipSuccess) { fprintf(stderr, "kernel_launch: hipFuncSetAttribute failed\n"); grid = -1; return; }
        if (hipOccupancyMaxActiveBlocksPerMultiprocessor(&per_cu, (const void*)fwd, NTHREADS, LDS_BYTES) != hipSuccess || per_cu < 1) { fprintf(stderr, "kernel_launch: occupancy query says %d\n", per_cu); }
        (void)hipGetLastError();
        grid = cus;
        if (grid > 256) grid = 256;
    }
    if (grid < 0) return;
    (void)hipMemsetAsync((char*)d_ws + WS_CTL, 0, CTL_BYTES, stream);
    (void)hipMemsetAsync((char*)d_ws + WS_SMALLW, 0, SMALLW_BYTES, stream);
    Args a{};
    for (int i = 0; i < N_IN; ++i) a.in[i] = (const float*)d_in[i];
    a.out = (float*)d_out; a.ws = (unsigned char*)d_ws;
#ifdef MK_RANGES
    { static const int ranges[][2] = { MK_RANGES };
      for (unsigned i = 0; i < sizeof(ranges) / sizeof(ranges[0]); ++i) { a.ph_lo = ranges[i][0]; a.ph_hi = ranges[i][1]; a.bli = (int)i; hipLaunchKernelGGL(fwd, dim3(grid), dim3(NTHREADS), LDS_BYTES, stream, a); } }
#elif MK_PER_PHASE
    for (int p = 0; p < PH_COPY; ++p) { a.ph_lo = p; a.ph_hi = p + 1; hipLaunchKernelGGL(fwd, dim3(grid), dim3(NTHREADS), LDS_BYTES, stream, a); }
#else
    a.ph_lo = 0; a.ph_hi = PH_COPY;
    hipLaunchKernelGGL(fwd, dim3(grid), dim3(NTHREADS), LDS_BYTES, stream, a);
#endif
}
```
